# Optimizing an MI355X kernel written in HIP

```python
import functools
import jax
import jax.numpy as jnp
from jax import lax
import numpy as np

D_MODEL = 1024
BATCH = 8
SEQ = 2048
DEPTH = 2

GRID_W = 64
CTX_LEN = 256
N_MIXERS = 2
RECURRENT_MIXER = 0
HEAD_SIZE = 64
N_HEADS = D_MODEL // HEAD_SIZE
LORA_DECAY = 64
LORA_ICLR = 64
LORA_GATE = 160
CONV_WIDTH = 3
D_FF = 3584
N_EXPERTS = 8
TOP_K = 2
MOE_BLOCK = 128
NORM_EPS = 1e-6
GN_EPS = 64e-5
N_RWKV = (DEPTH + 1) // 2
N_CONV = DEPTH // 2
N_DENSE = (DEPTH + 1) // 2
N_MOE = DEPTH // 2

kernel_name = "hybrid_rwkv7_shortconv_moe_dit"


def rms_norm(x, g):
    xf = x.astype(jnp.float32)
    y = xf * lax.rsqrt(jnp.mean(xf * xf, axis=-1, keepdims=True) + NORM_EPS)
    return (y * g.astype(jnp.float32)).astype(x.dtype)


def modulate(h, shift, scale):
    return h * (1.0 + scale) + shift


def _heads(z):
    return z.reshape(z.shape[:-1] + (N_HEADS, HEAD_SIZE))


def grid_shift(x):
    b, t, d = x.shape
    rows = t // GRID_W
    g = x.reshape(b, rows, GRID_W, d)
    q = d // 4
    left = jnp.pad(g[:, :, :-1, :q], ((0, 0), (0, 0), (1, 0), (0, 0)))
    right = jnp.pad(g[:, :, 1:, q:2 * q], ((0, 0), (0, 0), (0, 1), (0, 0)))
    up = jnp.pad(g[:, :-1, :, 2 * q:3 * q], ((0, 0), (1, 0), (0, 0), (0, 0)))
    down = jnp.pad(g[:, 1:, :, 3 * q:], ((0, 0), (0, 1), (0, 0), (0, 0)))
    return jnp.concatenate([left, right, up, down], axis=-1).reshape(b, t, d)


def seq_shift(x):
    h = x.shape[-1] // 2
    prev = jnp.pad(x[:, :-1, :h], ((0, 0), (1, 0), (0, 0)))
    nxt = jnp.pad(x[:, 1:, h:], ((0, 0), (0, 1), (0, 0)))
    return jnp.concatenate([prev, nxt], axis=-1)


def rwkv7_tokenwise(h, h_shift, p):
    mu, w_rkv, w0, w1, w2, a0, a1, a2, g1, g2, k_k, k_a = p
    f32 = jnp.float32
    dx = h_shift - h
    xr, xw, xk, xv, xa, xg = (h + dx * mu[n] for n in range(6))
    r = xr @ w_rkv[0]
    k = xk @ w_rkv[1]
    v = xv @ w_rkv[2]
    w_pre = jnp.einsum("zbtr,zrd->zbtd", jnp.tanh(jnp.einsum("btd,zdr->zbtr", xw, w1)), w2) + w0[:, None, None, :]
    decay = jnp.exp(-jnp.exp(-jax.nn.softplus(-w_pre.astype(f32)) - 0.5))
    iclr = jax.nn.sigmoid((jnp.einsum("zbtr,zrd->zbtd", jnp.einsum("btd,zdr->zbtr", xa, a1), a2)
                           + a0[:, None, None, :]).astype(f32))
    gate = jax.nn.sigmoid(xg @ g1) @ g2
    kk = _heads((k * k_k).astype(f32))
    kk = kk * lax.rsqrt(jnp.maximum(jnp.sum(kk * kk, axis=-1, keepdims=True), 1e-24))
    k_dir = k.astype(f32)[None] * (1.0 + (iclr - 1.0) * k_a.astype(f32))
    return (_heads(r.astype(f32)), _heads(k_dir), _heads(v.astype(f32)), _heads(decay),
            -kk, kk[None] * _heads(iclr), gate)


def rwkv7_scan(s0, r, w, k, v, a, b, reverse):
    def step(s, inp):
        r_t, w_t, k_t, v_t, a_t, b_t = inp
        sa = jnp.einsum("bhij,bhj->bhi", s, a_t)
        s = s * w_t[:, :, None, :] + sa[..., None] * b_t[:, :, None, :] + v_t[..., None] * k_t[:, :, None, :]
        return s, jnp.einsum("bhij,bhj->bhi", s, r_t)
    xs = tuple(jnp.moveaxis(z, 1, 0) for z in (r, w, k, v, a, b))
    s_final, ys = lax.scan(step, s0, xs, reverse=reverse)
    return jnp.moveaxis(ys, 0, 1), s_final


def rwkv7_bidir(p, s_fwd, s_bwd):
    r, k2, v, w2, a, b2 = p[:6]
    y_f, s_f = rwkv7_scan(s_fwd, r, w2[0], k2[0], v, a, b2[0], reverse=False)
    y_b, s_b = rwkv7_scan(s_bwd, r, w2[1], k2[1], v, a, b2[1], reverse=True)
    return y_f + y_b, s_f, s_b


def rwkv7_readout(y, p, r_k, ln_w, ln_b, w_out, dtype):
    r, k2, v, gate = p[0], p[1], p[2], p[6]
    mean = jnp.mean(y, axis=-1, keepdims=True)
    var = jnp.mean(jnp.square(y - mean), axis=-1, keepdims=True)
    yn = (y - mean) * lax.rsqrt(var + GN_EPS)
    bonus = jnp.sum(r * (0.5 * (k2[0] + k2[1])) * r_k.astype(jnp.float32), axis=-1, keepdims=True) * v
    b, t = y.shape[:2]
    o = yn.reshape(b, t, -1) * ln_w + ln_b + bonus.reshape(b, t, -1)
    return (o.astype(dtype) * gate) @ w_out


def short_conv(h, w_in, w_conv, w_out):
    bg, cg, u = jnp.split(h @ w_in, 3, axis=-1)
    z = cg * u
    t = z.shape[1]
    half = CONV_WIDTH // 2
    zp = jnp.pad(z, ((0, 0), (half, half), (0, 0)))
    conv = sum(zp[:, n:n + t] * w_conv[n] for n in range(CONV_WIDTH))
    return (bg * conv) @ w_out


def swiglu(h, w_gu, w_down):
    g, u = jnp.split(h @ w_gu, 2, axis=-1)
    return (jax.nn.silu(g) * u) @ w_down


def moe_swiglu(h, w_router, w_gu, w_down):
    shp = h.shape
    tok = h.reshape(-1, shp[-1])
    n = tok.shape[0]
    nk = n * TOP_K
    logits = (tok @ w_router).astype(jnp.float32)
    top_v, top_e = lax.top_k(logits, TOP_K)
    gates = jax.nn.softmax(top_v, axis=-1)
    flat_e = top_e.reshape(-1)
    flat_t = jnp.arange(nk, dtype=jnp.int32) // TOP_K
    flat_g = gates.reshape(-1)
    order = jnp.argsort(flat_e)
    se = flat_e[order]
    counts = jax.ops.segment_sum(jnp.ones_like(flat_e), flat_e, num_segments=N_EXPERTS)
    padded = (counts + MOE_BLOCK - 1) // MOE_BLOCK * MOE_BLOCK
    start = jnp.cumsum(counts) - counts
    pend = jnp.cumsum(padded)
    pstart = pend - padded
    dest = pstart[se] + jnp.arange(nk, dtype=jnp.int32) - start[se]
    n_slots = -(-nk // MOE_BLOCK) * MOE_BLOCK + N_EXPERTS * MOE_BLOCK
    n_blocks = n_slots // MOE_BLOCK
    slot_tok = jnp.zeros((n_slots,), jnp.int32).at[dest].set(flat_t[order])
    slot_gate = jnp.zeros((n_slots,), jnp.float32).at[dest].set(flat_g[order])
    blk_start = jnp.arange(n_blocks, dtype=jnp.int32) * MOE_BLOCK
    blk_e = jnp.minimum(jnp.searchsorted(pend, blk_start, side="right"), N_EXPERTS - 1)
    xs = tok[slot_tok].reshape(n_blocks, MOE_BLOCK, -1)

    def expert_block(args):
        xb, e = args
        return swiglu(xb, w_gu[e], w_down[e])

    ys = lax.map(expert_block, (xs, blk_e)).reshape(n_slots, -1)
    ys = ys * slot_gate[:, None].astype(ys.dtype)
    out = jnp.zeros_like(tok).at[slot_tok].add(ys)
    return out.reshape(shp)


def setup_inputs(seed: int = 0) -> dict:
    key = jax.random.key(seed)

    def nrm(n, shape, scale=1.0):
        return jax.random.normal(jax.random.fold_in(key, n), shape, jnp.float32) * scale

    def unif(n, shape, lo, hi):
        return jax.random.uniform(jax.random.fold_in(key, n), shape, jnp.float32, lo, hi)

    D, F, E = D_MODEL, D_FF, N_EXPERTS
    return {
        "x": nrm(0, (BATCH, SEQ, D)),
        "c": nrm(1, (BATCH, D)),
        "ctx": nrm(2, (BATCH, CTX_LEN, D)),
        "c_ctx": nrm(3, (D,)),
        "mod_w": nrm(4, (DEPTH, D, 6 * D), 0.5 * D ** -0.5),
        "mod_b": nrm(5, (DEPTH, 6 * D), 0.02),
        "norm_g": 1.0 + nrm(6, (DEPTH, 4, D), 0.02),
        "rwkv_mu": unif(7, (N_RWKV, 6, D), 0.0, 1.0),
        "rwkv_w_rkv": nrm(8, (N_RWKV, 3, D, D), D ** -0.5),
        "rwkv_w0": unif(9, (N_RWKV, 2, D), -6.0, -1.0),
        "rwkv_w1": nrm(10, (N_RWKV, 2, D, LORA_DECAY), D ** -0.5),
        "rwkv_w2": nrm(11, (N_RWKV, 2, LORA_DECAY, D), 0.1 * LORA_DECAY ** -0.5),
        "rwkv_a0": nrm(12, (N_RWKV, 2, D), 0.2),
        "rwkv_a1": nrm(13, (N_RWKV, 2, D, LORA_ICLR), D ** -0.5),
        "rwkv_a2": nrm(14, (N_RWKV, 2, LORA_ICLR, D), 0.1 * LORA_ICLR ** -0.5),
        "rwkv_g1": nrm(15, (N_RWKV, D, LORA_GATE), D ** -0.5),
        "rwkv_g2": nrm(16, (N_RWKV, LORA_GATE, D), LORA_GATE ** -0.5),
        "rwkv_k_k": 0.85 + nrm(17, (N_RWKV, D), 0.05),
        "rwkv_k_a": 1.0 + nrm(18, (N_RWKV, D), 0.05),
        "rwkv_r_k": nrm(19, (N_RWKV, N_HEADS, HEAD_SIZE), 0.1),
        "rwkv_ln_w": 1.0 + nrm(20, (N_RWKV, D), 0.02),
        "rwkv_ln_b": nrm(21, (N_RWKV, D), 0.02),
        "rwkv_w_out": nrm(22, (N_RWKV, D, D), D ** -0.5),
        "conv_w_in": nrm(23, (N_CONV, D, 3 * D), D ** -0.5),
        "conv_w": nrm(24, (N_CONV, CONV_WIDTH, D), CONV_WIDTH ** -0.5),
        "conv_w_out": nrm(25, (N_CONV, D, D), D ** -0.5),
        "ffn_w_gu": nrm(26, (N_DENSE, D, 2 * F), D ** -0.5),
        "ffn_w_down": nrm(27, (N_DENSE, F, D), F ** -0.5),
        "moe_router": nrm(28, (N_MOE, D, E), D ** -0.5),
        "moe_w_gu": nrm(29, (N_MOE, E, D, 2 * F), D ** -0.5),
        "moe_w_down": nrm(30, (N_MOE, E, F, D), F ** -0.5),
    }


def reference(x, c, ctx, c_ctx, mod_w, mod_b, norm_g, rwkv_mu, rwkv_w_rkv, rwkv_w0, rwkv_w1, rwkv_w2,
              rwkv_a0, rwkv_a1, rwkv_a2, rwkv_g1, rwkv_g2, rwkv_k_k, rwkv_k_a, rwkv_r_k, rwkv_ln_w,
              rwkv_ln_b, rwkv_w_out, conv_w_in, conv_w, conv_w_out, ffn_w_gu, ffn_w_down,
              moe_router, moe_w_gu, moe_w_down):
    silu_c = jax.nn.silu(c)
    silu_cc = jax.nn.silu(c_ctx)
    for i in range(DEPTH):
        kind = i % N_MIXERS
        jm = i // N_MIXERS
        jf = i // 2
        ctx_live = any(l % N_MIXERS == RECURRENT_MIXER for l in range(i + 1, DEPTH))
        m = jnp.split(silu_c @ mod_w[i] + mod_b[i], 6, axis=-1)
        sh_a, sc_a, gt_a, sh_f, sc_f, gt_f = (z[:, None, :] for z in m)
        h = modulate(rms_norm(x, norm_g[i, 0]), sh_a, sc_a)
        if kind == RECURRENT_MIXER or ctx_live:
            cm = jnp.split(silu_cc @ mod_w[i] + mod_b[i], 6, axis=-1)
            hc = modulate(rms_norm(ctx, norm_g[i, 0]), cm[0], cm[1])
        if kind == RECURRENT_MIXER:
            p_tok = (rwkv_mu[jm], rwkv_w_rkv[jm], rwkv_w0[jm], rwkv_w1[jm], rwkv_w2[jm], rwkv_a0[jm],
                     rwkv_a1[jm], rwkv_a2[jm], rwkv_g1[jm], rwkv_g2[jm], rwkv_k_k[jm], rwkv_k_a[jm])
            readout = functools.partial(rwkv7_readout, r_k=rwkv_r_k[jm], ln_w=rwkv_ln_w[jm],
                                        ln_b=rwkv_ln_b[jm], w_out=rwkv_w_out[jm])
            pc = rwkv7_tokenwise(hc, seq_shift(hc), p_tok)
            pl = rwkv7_tokenwise(h, grid_shift(h), p_tok)
            s0 = jnp.zeros((ctx.shape[0], N_HEADS, HEAD_SIZE, HEAD_SIZE), jnp.float32)
            yc, s_f, s_b = rwkv7_bidir(pc, s0, s0)
            yl, _, _ = rwkv7_bidir(pl, s_f, s_b)
            y = readout(yl, pl, dtype=x.dtype)
            if ctx_live:
                y_ctx = readout(yc, pc, dtype=ctx.dtype)
        else:
            y = short_conv(h, conv_w_in[jm], conv_w[jm], conv_w_out[jm])
            if ctx_live:
                y_ctx = short_conv(hc, conv_w_in[jm], conv_w[jm], conv_w_out[jm])
        x = x + gt_a * rms_norm(y, norm_g[i, 1])
        if ctx_live:
            ctx = ctx + cm[2] * rms_norm(y_ctx, norm_g[i, 1])
        if i % 2 == 0:
            ffn = functools.partial(swiglu, w_gu=ffn_w_gu[jf], w_down=ffn_w_down[jf])
        else:
            ffn = functools.partial(moe_swiglu, w_router=moe_router[jf], w_gu=moe_w_gu[jf],
                                    w_down=moe_w_down[jf])
        h = modulate(rms_norm(x, norm_g[i, 2]), sh_f, sc_f)
        x = x + gt_f * rms_norm(ffn(h), norm_g[i, 3])
        if ctx_live:
            hcf = modulate(rms_norm(ctx, norm_g[i, 2]), cm[3], cm[4])
            ctx = ctx + cm[5] * rms_norm(ffn(hcf), norm_g[i, 3])
    return x
```

```cpp
#include <hip/hip_runtime.h>
#include <hip/hip_cooperative_groups.h>
#include <cstdio>
#include <cstdint>
namespace cg = cooperative_groups;

#ifndef MK_ONE_LAUNCH
#define MK_ONE_LAUNCH 0
#endif

#define LAS __attribute__((address_space(3)))
typedef unsigned short bf16_t;
typedef short bf16x8 __attribute__((ext_vector_type(8)));
typedef float f32x4 __attribute__((ext_vector_type(4)));
typedef float f32x2 __attribute__((ext_vector_type(2)));
typedef unsigned u32x4 __attribute__((ext_vector_type(4)));
typedef unsigned u32x2 __attribute__((ext_vector_type(2)));

constexpr int D = 1024, NB = 8, T = 2048, TCX = 256, M = NB * T, MC = NB * TCX, MT = M + MC, NH = 16, HS = 64, FF = 3584, NE = 8;
constexpr float NORM_EPS = 1e-6f, GN_EPS = 64e-5f;
constexpr int NPH = 19;

constexpr size_t MiB = 1u << 20;
constexpr size_t WS_WR = 0, WS_WK = 2 * MiB, WS_WV = 4 * MiB, WS_WW1 = 6 * MiB, WS_WA1 = 6 * MiB + 512 * 1024, WS_WG1 = 7 * MiB;
constexpr size_t WS_W2W = 7 * MiB + 512 * 1024, WS_W2A = WS_W2W + 256 * 1024, WS_W2G = 8 * MiB;
constexpr size_t WS_WOUT = 9 * MiB, WS_WGU = 11 * MiB, WS_WDN = 25 * MiB, WS_WCI = 32 * MiB, WS_WCO = 38 * MiB, WS_MGU = 40 * MiB, WS_MDN = 152 * MiB;
constexpr size_t WS_MODS = 208 * MiB, WS_RSTD = 209 * MiB, WS_BONUS = 210 * MiB, WS_TOPE = 211 * MiB, WS_TOPG = WS_TOPE + 128 * 1024, WS_TPOS = WS_TOPG + 128 * 1024;
constexpr size_t WS_SLOT = 211 * MiB + 512 * 1024, WS_CTL = 212 * MiB;
constexpr size_t WS_XR = 214 * MiB, WS_HB = 278 * MiB, WS_GATE = 310 * MiB, WS_OG = 342 * MiB, WS_YF = 374 * MiB, WS_YB = 406 * MiB, WS_Y0 = 374 * MiB;
constexpr size_t WS_S2 = 438 * MiB, WS_R = WS_S2, WS_KRAW = WS_S2 + 36 * MiB, WS_V = WS_S2 + 72 * MiB, WS_L1W = WS_S2 + 108 * MiB, WS_L1A = WS_S2 + 117 * MiB, WS_L1G = WS_S2 + 126 * MiB;
constexpr size_t WS_BG = WS_S2, WS_Z = WS_S2 + 32 * MiB, WS_CV = WS_S2 + 64 * MiB, WS_XS = WS_S2, WS_YS = WS_S2;
constexpr size_t WS_S1 = 574 * MiB, WS_XN = WS_S1, WS_DEC = WS_S1, WS_ICL = WS_S1 + 72 * MiB, WS_KKN = WS_S1 + 144 * MiB, WS_ACT = WS_S1, WS_MACT = WS_S1;
constexpr size_t WS_END = 812 * MiB;
constexpr int MAXSLOT = 2 * M + NE * 256;

constexpr int LDS_BYTES = 147456;
constexpr int CTL_OFF = 139264;
constexpr int NTHREADS = 512, NWAVES = 8;

struct Args { const float* in[31]; float* out; unsigned char* ws; int ph_lo, ph_hi; };

__device__ __forceinline__ float bf2f(unsigned h) { return __uint_as_float(h << 16); }
__device__ __forceinline__ unsigned cvt_pk_bf16(float lo, float hi) { unsigned r; asm volatile("v_cvt_pk_bf16_f32 %0, %1, %2" : "=v"(r) : "v"(lo), "v"(hi)); return r; }
__device__ __forceinline__ float sigmoidf_(float x) { return __builtin_amdgcn_rcpf(1.0f + __expf(-x)); }
__device__ __forceinline__ float siluf_(float x) { return x * sigmoidf_(x); }
__device__ __forceinline__ float tanhf_(float x) { return 2.0f * sigmoidf_(2.0f * x) - 1.0f; }
__device__ __forceinline__ float wave_sum(float v) {
#pragma unroll
    for (int o = 1; o < 64; o <<= 1) v += __shfl_xor(v, o);
    return v;
}
__device__ __forceinline__ int rfl(int v) { return __builtin_amdgcn_readfirstlane(v); }
__device__ __forceinline__ f32x4 ld4(const float* p) { return *(const f32x4*)p; }
__device__ __forceinline__ void unpack4(u32x2 w, float* o) { o[0] = bf2f(w.x & 0xffffu); o[1] = bf2f(w.x >> 16); o[2] = bf2f(w.y & 0xffffu); o[3] = bf2f(w.y >> 16); }
__device__ __forceinline__ void unpack8(u32x4 w, float* o) {
    o[0] = bf2f(w.x & 0xffffu); o[1] = bf2f(w.x >> 16); o[2] = bf2f(w.y & 0xffffu); o[3] = bf2f(w.y >> 16);
    o[4] = bf2f(w.z & 0xffffu); o[5] = bf2f(w.z >> 16); o[6] = bf2f(w.w & 0xffffu); o[7] = bf2f(w.w >> 16);
}
__device__ __forceinline__ u32x4 pack8(const float* v) { u32x4 w; w.x = cvt_pk_bf16(v[0], v[1]); w.y = cvt_pk_bf16(v[2], v[3]); w.z = cvt_pk_bf16(v[4], v[5]); w.w = cvt_pk_bf16(v[6], v[7]); return w; }
__device__ __forceinline__ float red8(float v) {
    v += __builtin_bit_cast(float, __builtin_amdgcn_update_dpp(0, __builtin_bit_cast(int, v), 0xB1, 0xF, 0xF, true));
    v += __builtin_bit_cast(float, __builtin_amdgcn_update_dpp(0, __builtin_bit_cast(int, v), 0x4E, 0xF, 0xF, true));
    v += __builtin_bit_cast(float, __builtin_amdgcn_update_dpp(0, __builtin_bit_cast(int, v), 0x141, 0xF, 0xF, true));
    return v;
}

namespace pg8 {
constexpr int BM = 256, BK = 64, HALF = 128, HTB = HALF * BK * 2, STAGE_BYTES = 8 * HTB, NXCD = 8, WGM = 8;
__device__ __forceinline__ int lds_byte(int r, int c) { const int st = (r >> 4) * 2 + (c >> 5), rr = r & 15, cc = c & 31, ob = rr * 64 + cc * 2; return st * 1024 + (ob ^ (((ob >> 9) & 1) << 5)); }
__device__ __forceinline__ void stage_rc(int b, int& R, int& C) { const int st = b / 1024, sb = b % 1024, swz = sb ^ (((sb >> 9) & 1) << 5); R = (st >> 1) * 16 + swz / 64; C = (st & 1) * 32 + (swz % 64) / 2; }
__device__ __forceinline__ int perm32(int rho) { const int n = rho >> 4, i = rho & 15; return 8 * (i >> 2) + 4 * n + (i & 3); }

enum { EPI_BF16 = 0, EPI_F32 = 1, EPI_SWIGLU = 2, EPI_MUL = 3 };
struct Unit { const char* A; const char* B; int pm, pn, job; };

__device__ __forceinline__ void set_job(LAS int* ctl, int j, const void* A, const void* B, void* O, int nM, int nN, int mode, int ldo, int act) {
    LAS int* jd = ctl + 16 + 16 * j;
    const unsigned long long a = (unsigned long long)A, b = (unsigned long long)B, o = (unsigned long long)O;
    jd[0] = (int)(unsigned)a; jd[1] = (int)(unsigned)(a >> 32); jd[2] = (int)(unsigned)b; jd[3] = (int)(unsigned)(b >> 32); jd[4] = (int)(unsigned)o; jd[5] = (int)(unsigned)(o >> 32);
    jd[6] = nM; jd[7] = nN; jd[9] = mode; jd[10] = ldo; jd[11] = act;
    const int u0 = (j == 0) ? 0 : ctl[16 + 16 * (j - 1) + 8] + ctl[16 + 16 * (j - 1) + 6] * ctl[16 + 16 * (j - 1) + 7];
    jd[8] = u0; ctl[0] = j + 1; ctl[1] = u0 + nM * nN;
}

__device__ __forceinline__ bool sched_next(LAS const int* ctl, int i, int G, int c, size_t tstepA, size_t tstepB, Unit& u) {
    const int total = rfl(ctl[1]), nj = rfl(ctl[0]);
    const long L = (long)i * G + c; if (L >= total) return false;
    int j = 0;
    for (int q = 1; q < nj; ++q) if ((int)L >= rfl(ctl[16 + 16 * q + 8])) j = q;
    LAS const int* jd = ctl + 16 + 16 * j;
    const int nM = rfl(jd[6]), nN = rfl(jd[7]); int wgid = (int)L - rfl(jd[8]);
    const int nwg = nM * nN;
    { const int q = nwg / NXCD, r = nwg % NXCD, xcd = wgid % NXCD, off = wgid / NXCD; wgid = (xcd < r ? xcd * (q + 1) : r * (q + 1) + (xcd - r) * q) + off; }
    const int nig = WGM * nN, gid = wgid / nig, fm = gid * WGM, gsz = (nM - fm) < WGM ? (nM - fm) : WGM;
    u.pm = fm + ((wgid % nig) % gsz); u.pn = (wgid % nig) / gsz; u.job = j;
    const unsigned long long a = ((unsigned long long)(unsigned)rfl(jd[1]) << 32) | (unsigned)rfl(jd[0]);
    const unsigned long long b = ((unsigned long long)(unsigned)rfl(jd[3]) << 32) | (unsigned)rfl(jd[2]);
    u.A = (const char*)a + (size_t)u.pm * tstepA; u.B = (const char*)b + (size_t)u.pn * tstepB;
    return true;
}

__device__ __forceinline__ void epilogue(const f32x4 (&acc)[2][2][4][2], LAS const int* ctl, const Unit& u, int wr, int wc, int fr, int fq) {
    LAS const int* jd = ctl + 16 + 16 * u.job;
    const int mode = rfl(jd[9]), ldo = rfl(jd[10]), act = rfl(jd[11]);
    char* O = (char*)(((unsigned long long)(unsigned)rfl(jd[5]) << 32) | (unsigned)rfl(jd[4]));
    const int row0 = u.pm * BM + wr * 64 + fr;
    if (mode == EPI_BF16) {
        bf16_t* base = (bf16_t*)O; const int col0 = u.pn * BM + wc * 32 + 8 * fq;
#pragma unroll
        for (int ai = 0; ai < 2; ++ai)
#pragma unroll
            for (int m = 0; m < 4; ++m) { bf16_t* rowp = base + (size_t)(row0 + ai * HALF + m * 16) * ldo + col0;
#pragma unroll
                for (int bj = 0; bj < 2; ++bj) { f32x4 v0 = acc[ai][bj][m][0], v1 = acc[ai][bj][m][1];
                    if (act == 1) { _Pragma("unroll") for (int e = 0; e < 4; ++e) { v0[e] = tanhf_(v0[e]); v1[e] = tanhf_(v1[e]); } }
                    else if (act == 2) { _Pragma("unroll") for (int e = 0; e < 4; ++e) { v0[e] = sigmoidf_(v0[e]); v1[e] = sigmoidf_(v1[e]); } }
                    u32x4 w; w.x = cvt_pk_bf16(v0[0], v0[1]); w.y = cvt_pk_bf16(v0[2], v0[3]); w.z = cvt_pk_bf16(v1[0], v1[1]); w.w = cvt_pk_bf16(v1[2], v1[3]);
                    *(u32x4*)(rowp + bj * HALF) = w; } }
    } else if (mode == EPI_F32) {
        float* base = (float*)O; const int col0 = u.pn * BM + wc * 32 + 8 * fq;
#pragma unroll
        for (int ai = 0; ai < 2; ++ai)
#pragma unroll
            for (int m = 0; m < 4; ++m) { float* rowp = base + (size_t)(row0 + ai * HALF + m * 16) * ldo + col0;
#pragma unroll
                for (int bj = 0; bj < 2; ++bj) { *(f32x4*)(rowp + bj * HALF) = acc[ai][bj][m][0]; *(f32x4*)(rowp + bj * HALF + 4) = acc[ai][bj][m][1]; } }
    } else {
        bf16_t* base = (bf16_t*)O; const int col0 = u.pn * HALF + wc * 16 + 4 * fq;
#pragma unroll
        for (int ai = 0; ai < 2; ++ai)
#pragma unroll
            for (int m = 0; m < 4; ++m) { bf16_t* rowp = base + (size_t)(row0 + ai * HALF + m * 16) * ldo + col0;
#pragma unroll
                for (int bj = 0; bj < 2; ++bj) { const f32x4 g = acc[ai][bj][m][0], uu = acc[ai][bj][m][1]; f32x4 r;
                    if (mode == EPI_SWIGLU) { _Pragma("unroll") for (int e = 0; e < 4; ++e) r[e] = siluf_(g[e]) * uu[e]; } else { r = g * uu; }
                    u32x2 w; w.x = cvt_pk_bf16(r[0], r[1]); w.y = cvt_pk_bf16(r[2], r[3]);
                    *(u32x2*)(rowp + bj * 64) = w; } }
    }
}

__device__ __forceinline__ void gemm_phase(LAS unsigned char* lds, LAS const int* ctl, int K, int lda, int ldb, int G, int c) {
    const int tid = threadIdx.x, wid = __builtin_amdgcn_readfirstlane(tid >> 6), lane = tid & 63, wr = wid >> 2, wc = wid & 3, fr = lane & 15, fq = lane >> 4;
    const int nt = K / BK;
    unsigned voffA[2], voffB[2];
#pragma unroll
    for (int i = 0; i < 2; ++i) { int R, C; stage_rc(tid * 16 + i * 8192, R, C); const int Rb = (R & ~31) + perm32(R & 31);
        voffA[i] = (unsigned)(R * lda + C) * 2u; voffB[i] = (unsigned)(Rb * ldb + C) * 2u; }
    const size_t kstep = (size_t)(BK * 2);
    const size_t hsA = (size_t)HALF * lda * 2, hsB = (size_t)HALF * ldb * 2;
    const size_t tsA = 2 * hsA, tsB = 2 * hsB;
    const unsigned ldsw = (unsigned)wid * 1024u;
    const int aoff = lds_byte(wr * 64 + fr, fq * 8), boff = lds_byte(wc * 32 + fr, fq * 8);
#define PG8_SA(b, h) (((b) * 2 + (h)) * HTB)
#define PG8_SB(b, h) ((4 + (b) * 2 + (h)) * HTB)
#define PG8_STAGE(bufoff, gbase, voff) do { _Pragma("unroll") for (int _i = 0; _i < 2; ++_i) \
        __builtin_amdgcn_global_load_lds((const unsigned*)((const char*)(gbase) + (voff)[_i]), (LAS unsigned*)(lds + (bufoff) + ldsw + _i * 8192), 16, 0, 0); } while (0)
#define PG8_LDA(dst, b, h) do { _Pragma("unroll") for (int m = 0; m < 4; ++m) _Pragma("unroll") for (int k = 0; k < 2; ++k) dst[m][k] = *(const LAS bf16x8*)(lds + PG8_SA(b, h) + aoff + m * 2048 + k * 1024); } while (0)
#define PG8_LDB(dst, b, h) do { _Pragma("unroll") for (int n = 0; n < 2; ++n) _Pragma("unroll") for (int k = 0; k < 2; ++k) dst[n][k] = *(const LAS bf16x8*)(lds + PG8_SB(b, h) + boff + n * 2048 + k * 1024); } while (0)
#define PG8_MMA(ai, bj, At, Bt) do { __builtin_amdgcn_s_setprio(1); _Pragma("unroll") for (int m = 0; m < 4; ++m) _Pragma("unroll") for (int n = 0; n < 2; ++n) _Pragma("unroll") for (int k = 0; k < 2; ++k) \
        acc[ai][bj][m][n] = __builtin_amdgcn_mfma_f32_16x16x32_bf16(Bt[n][k], At[m][k], acc[ai][bj][m][n], 0, 0, 0); __builtin_amdgcn_s_setprio(0); } while (0)
#define PG8_WAIT_V(n) asm volatile("s_waitcnt vmcnt(" #n ")" ::: "memory")
#define PG8_WAIT_L(n) asm volatile("s_waitcnt lgkmcnt(" #n ")" ::: "memory")
#define PG8_BAR __builtin_amdgcn_s_barrier()
#define PG8_SCHED __builtin_amdgcn_sched_barrier(0)
    Unit cur, nxt; int ui = 0;
    if (!sched_next(ctl, 0, G, c, tsA, tsB, cur)) return;
    f32x4 acc[2][2][4][2];
#pragma unroll
    for (int a = 0; a < 2; ++a)
#pragma unroll
        for (int b = 0; b < 2; ++b)
#pragma unroll
            for (int m = 0; m < 4; ++m)
#pragma unroll
                for (int n = 0; n < 2; ++n) acc[a][b][m][n] = (f32x4){0.f, 0.f, 0.f, 0.f};
    bf16x8 At[4][2], B0[2][2], B1[2][2];
    const char* cA = cur.A; const char* cB = cur.B;
    PG8_STAGE(PG8_SB(0, 0), cB, voffB); PG8_STAGE(PG8_SB(0, 1), cB + hsB, voffB); PG8_STAGE(PG8_SA(0, 0), cA, voffA); PG8_STAGE(PG8_SA(0, 1), cA + hsA, voffA);
    if (wr == 1) PG8_BAR;
    PG8_WAIT_V(2); PG8_BAR;
    PG8_STAGE(PG8_SB(1, 0), cB + kstep, voffB); PG8_STAGE(PG8_SA(1, 0), cA + kstep, voffA); PG8_STAGE(PG8_SB(1, 1), cB + hsB + kstep, voffB);
    PG8_WAIT_V(6); PG8_BAR;
    for (;;) {
        const bool has_next = sched_next(ctl, ui + 1, G, c, tsA, tsB, nxt);
        const char* nA = has_next ? nxt.A : cA; const char* nB = has_next ? nxt.B : cB;
        for (int t = 0; t < nt; t += 2) {
            const bool last = (t == nt - 2);
            const char* a1 = cA + (size_t)(t + 1) * kstep;
            const char* a2 = last ? nA : cA + (size_t)(t + 2) * kstep; const char* b2 = last ? nB : cB + (size_t)(t + 2) * kstep;
            const char* a3 = a2 + kstep; const char* b3 = b2 + kstep;
            PG8_LDB(B0, 0, 0); PG8_LDB(B1, 0, 1); PG8_SCHED; PG8_LDA(At, 0, 0); PG8_STAGE(PG8_SA(1, 1), a1 + hsA, voffA);
            PG8_WAIT_V(8); PG8_WAIT_L(0); PG8_BAR; PG8_MMA(0, 0, At, B0); PG8_MMA(0, 1, At, B1); PG8_BAR; PG8_SCHED;
            PG8_LDA(At, 0, 1); PG8_STAGE(PG8_SB(0, 0), b2, voffB); PG8_STAGE(PG8_SB(0, 1), b2 + hsB, voffB); PG8_STAGE(PG8_SA(0, 0), a2, voffA);
            PG8_WAIT_V(8); PG8_WAIT_L(0); PG8_BAR; PG8_MMA(1, 0, At, B0); PG8_MMA(1, 1, At, B1); PG8_BAR; PG8_SCHED;
            PG8_LDB(B0, 1, 0); PG8_LDB(B1, 1, 1); PG8_SCHED; PG8_LDA(At, 1, 0); PG8_STAGE(PG8_SA(0, 1), a2 + hsA, voffA);
            PG8_WAIT_V(8); PG8_WAIT_L(0); PG8_BAR; PG8_MMA(0, 0, At, B0); PG8_MMA(0, 1, At, B1); PG8_BAR; PG8_SCHED;
            PG8_LDA(At, 1, 1); PG8_STAGE(PG8_SB(1, 0), b3, voffB); PG8_STAGE(PG8_SB(1, 1), b3 + hsB, voffB); PG8_STAGE(PG8_SA(1, 0), a3, voffA);
            PG8_WAIT_V(8); PG8_WAIT_L(0); PG8_BAR; PG8_MMA(1, 0, At, B0); PG8_MMA(1, 1, At, B1); PG8_BAR; PG8_SCHED;
        }
        if (wr == 0) PG8_BAR;
        epilogue(acc, ctl, cur, wr, wc, fr, fq);
        if (!has_next) break;
#pragma unroll
        for (int a = 0; a < 2; ++a)
#pragma unroll
            for (int b = 0; b < 2; ++b)
#pragma unroll
                for (int m = 0; m < 4; ++m)
#pragma unroll
                    for (int n = 0; n < 2; ++n) acc[a][b][m][n] = (f32x4){0.f, 0.f, 0.f, 0.f};
        cur = nxt; cA = nA; cB = nB; ++ui;
        if (wr == 1) PG8_BAR;
    }
    PG8_WAIT_V(0);
    PG8_BAR;
#undef PG8_SA
#undef PG8_SB
#undef PG8_STAGE
#undef PG8_LDA
#undef PG8_LDB
#undef PG8_MMA
#undef PG8_WAIT_V
#undef PG8_WAIT_L
#undef PG8_BAR
#undef PG8_SCHED
}
}

__device__ __forceinline__ int cvt_rowmap(int kind, int n) {
    if (kind == 1) { if (n < FF) return 8 * (n >> 2) + (n & 3); const int j = n - FF; return 8 * (j >> 2) + 4 + (j & 3); }
    if (kind == 2) { if (n < D) return n; if (n < 2 * D) { const int j = n - D; return D + 8 * (j >> 2) + (j & 3); } const int j = n - 2 * D; return D + 8 * (j >> 2) + 4 + (j & 3); }
    return n;
}
__device__ __forceinline__ void cvt_item(const float* src, int K, int N, bf16_t* dst, int ldd, int kind, int k0, int n0, LAS float* scr, int lane) {
    f32x4 v[16];
    const int nn = 4 * (lane & 15);
#pragma unroll
    for (int i = 0; i < 16; ++i) { const int kk = 4 * i + (lane >> 4); const int k = k0 + kk, n = n0 + nn;
        v[i] = (k < K && n < N) ? *(const f32x4*)(src + (size_t)k * N + n) : (f32x4){0.f, 0.f, 0.f, 0.f}; }
#pragma unroll
    for (int i = 0; i < 16; ++i) { const int kk = 4 * i + (lane >> 4); LAS float* s = scr + kk * 65 + nn; s[0] = v[i][0]; s[1] = v[i][1]; s[2] = v[i][2]; s[3] = v[i][3]; }
    asm volatile("s_waitcnt lgkmcnt(0)" ::: "memory");
    const int c = lane & 7;
#pragma unroll
    for (int j = 0; j < 8; ++j) { const int nl = (lane >> 3) + 8 * j; const LAS float* s = scr + (8 * c) * 65 + nl;
        u32x4 o; o.x = cvt_pk_bf16(s[0], s[65]); o.y = cvt_pk_bf16(s[2 * 65], s[3 * 65]); o.z = cvt_pk_bf16(s[4 * 65], s[5 * 65]); o.w = cvt_pk_bf16(s[6 * 65], s[7 * 65]);
        const int n = n0 + nl, k = k0 + 8 * c;
        if (n < N && k < K) *(u32x4*)(dst + (size_t)cvt_rowmap(kind, n) * ldd + k) = o; }
    asm volatile("s_waitcnt lgkmcnt(0)" ::: "memory");
}
__device__ __forceinline__ void cvt_set(LAS int* ctl, int j, const float* src, void* dst, int K, int N, int ldd, int kind, int nb, int sstride, int dstride) {
    LAS int* jd = ctl + 256 + 16 * j;
    const unsigned long long a = (unsigned long long)src, b = (unsigned long long)dst;
    jd[0] = (int)(unsigned)a; jd[1] = (int)(unsigned)(a >> 32); jd[2] = (int)(unsigned)b; jd[3] = (int)(unsigned)(b >> 32);
    jd[4] = K; jd[5] = N; jd[6] = ldd; jd[7] = kind; jd[8] = nb; jd[9] = sstride; jd[10] = dstride;
    const int nKt = (K + 63) / 64, nNt = (N + 63) / 64;
    const int i0 = (j == 0) ? 0 : ctl[256 + 16 * (j - 1) + 11] + ctl[256 + 16 * (j - 1) + 12] * ctl[256 + 16 * (j - 1) + 8];
    jd[11] = i0; jd[12] = nKt * nNt; jd[13] = nNt;
    ctl[2] = j + 1; ctl[3] = i0 + nKt * nNt * nb;
}

__device__ __forceinline__ void phase0(const Args& a, LAS unsigned char* lds, int tid, int lane, int wave, int G) {
    unsigned char* ws = a.ws;
    LAS int* ctl = (LAS int*)(lds + CTL_OFF);
    if (tid == 0) {
        cvt_set(ctl, 0, a.in[8], ws + WS_WR, D, D, D, 0, 3, D * D, D * D);
        cvt_set(ctl, 1, a.in[10], ws + WS_WW1, D, 64, D, 0, 2, D * 64, 64 * D);
        cvt_set(ctl, 2, a.in[13], ws + WS_WA1, D, 64, D, 0, 2, D * 64, 64 * D);
        cvt_set(ctl, 3, a.in[15], ws + WS_WG1, D, 160, D, 0, 1, 0, 0);
        cvt_set(ctl, 4, a.in[11], ws + WS_W2W, 64, D, 64, 0, 2, 64 * D, D * 64);
        cvt_set(ctl, 5, a.in[14], ws + WS_W2A, 64, D, 64, 0, 2, 64 * D, D * 64);
        cvt_set(ctl, 6, a.in[16], ws + WS_W2G, 160, D, 160, 0, 1, 0, 0);
        cvt_set(ctl, 7, a.in[22], ws + WS_WOUT, D, D, D, 0, 1, 0, 0);
        cvt_set(ctl, 8, a.in[26], ws + WS_WGU, D, 2 * FF, D, 1, 1, 0, 0);
        cvt_set(ctl, 9, a.in[27], ws + WS_WDN, FF, D, FF, 0, 1, 0, 0);
        cvt_set(ctl, 10, a.in[23], ws + WS_WCI, D, 3 * D, D, 2, 1, 0, 0);
        cvt_set(ctl, 11, a.in[25], ws + WS_WCO, D, D, D, 0, 1, 0, 0);
        cvt_set(ctl, 12, a.in[29], ws + WS_MGU, D, 2 * FF, D, 1, NE, D * 2 * FF, 2 * FF * D);
        cvt_set(ctl, 13, a.in[30], ws + WS_MDN, FF, D, FF, 0, NE, FF * D, D * FF);
    }
    if (blockIdx.x == 0 && tid < 64) ((int*)(ws + WS_CTL))[tid] = 0;
    {
        LAS float* s = (LAS float*)lds; LAS float* red = (LAS float*)(lds + 36864);
        for (int u = blockIdx.x; u < 192; u += G) {
            const int layer = u / 96, n0 = (u % 96) * 64;
            for (int idx = tid; idx < 9 * D; idx += NTHREADS) { const int b = idx >> 10, k = idx & 1023; const float cv = b < 8 ? a.in[1][b * D + k] : a.in[3][k]; s[idx] = siluf_(cv); }
            __syncthreads();
            const float* W = a.in[4] + (size_t)layer * D * 6 * D + n0 + lane;
            float acc[9];
#pragma unroll
            for (int b = 0; b < 9; ++b) acc[b] = 0.f;
#pragma unroll 4
            for (int k = 128 * wave; k < 128 * wave + 128; k += 4) {
                const float w0 = W[(size_t)k * 6144], w1 = W[(size_t)(k + 1) * 6144], w2 = W[(size_t)(k + 2) * 6144], w3 = W[(size_t)(k + 3) * 6144];
#pragma unroll
                for (int b = 0; b < 9; ++b) { const f32x4 sv = *(const LAS f32x4*)(s + b * D + k); acc[b] += sv[0] * w0 + sv[1] * w1 + sv[2] * w2 + sv[3] * w3; }
            }
#pragma unroll
            for (int b = 0; b < 9; ++b) red[(wave * 9 + b) * 64 + lane] = acc[b];
            __syncthreads();
            for (int idx = tid; idx < 9 * 64; idx += NTHREADS) { const int b = idx >> 6, l = idx & 63; float t = 0.f;
#pragma unroll
                for (int w = 0; w < 8; ++w) t += red[(w * 9 + b) * 64 + l];
                ((float*)(ws + WS_MODS))[(size_t)(layer * 9 + b) * 6144 + n0 + l] = t + a.in[5][layer * 6144 + n0 + l]; }
            __syncthreads();
        }
    }
    const int gw = blockIdx.x * NWAVES + wave, NGW = G * NWAVES;
    for (int row = gw; row < MT; row += NGW) {
        const float* xr = row < M ? a.in[0] + (size_t)row * D : a.in[2] + (size_t)(row - M) * D;
        float ss = 0.f;
#pragma unroll
        for (int j = 0; j < 4; ++j) { const f32x4 v = ld4(xr + 4 * lane + 256 * j); ss += v[0] * v[0] + v[1] * v[1] + v[2] * v[2] + v[3] * v[3]; }
        ss = wave_sum(ss);
        if (lane == 0) ((float*)(ws + WS_RSTD))[row] = rsqrtf(ss * (1.0f / D) + NORM_EPS);
    }
    {
        const int gt = blockIdx.x * NTHREADS + tid, NGT = G * NTHREADS;
        const u32x4 z = (u32x4){0u, 0u, 0u, 0u};
        for (int i = gt; i < 128 * D / 8; i += NGT) { ((u32x4*)(ws + WS_WW1 + 128 * D * 2))[i] = z; ((u32x4*)(ws + WS_WA1 + 128 * D * 2))[i] = z; }
        for (int i = gt; i < 96 * D / 8; i += NGT) ((u32x4*)(ws + WS_WG1 + 160 * D * 2))[i] = z;
    }
    __syncthreads();
    {
        LAS float* scr = (LAS float*)(lds + wave * 16640);
        const int nitems = rfl(ctl[3]), nj = rfl(ctl[2]);
        for (int it = gw; it < nitems; it += NGW) {
            int j = 0;
            for (int q = 1; q < nj; ++q) if (it >= rfl(ctl[256 + 16 * q + 11])) j = q;
            LAS const int* jd = ctl + 256 + 16 * j;
            const int loc = it - rfl(jd[11]), ipb = rfl(jd[12]), nNt = rfl(jd[13]);
            const int bat = loc / ipb, rem = loc % ipb, kb = rem / nNt, nb = rem % nNt;
            const float* src = (const float*)(((unsigned long long)(unsigned)rfl(jd[1]) << 32) | (unsigned)rfl(jd[0])) + (size_t)bat * (size_t)(unsigned)rfl(jd[9]);
            bf16_t* dst = (bf16_t*)(((unsigned long long)(unsigned)rfl(jd[3]) << 32) | (unsigned)rfl(jd[2])) + (size_t)bat * (size_t)(unsigned)rfl(jd[10]);
            cvt_item(src, rfl(jd[4]), rfl(jd[5]), dst, rfl(jd[6]), rfl(jd[7]), 64 * kb, 64 * nb, scr, lane);
        }
    }
}

__device__ __forceinline__ void phase_mix(const Args& a, int gw, int NGW, int lane) {
    unsigned char* ws = a.ws;
    const float* g = a.in[6];
    const float* mu = a.in[7];
    const float* mods = (const float*)(ws + WS_MODS);
    const float* rstd = (const float*)(ws + WS_RSTD);
    bf16_t* XN = (bf16_t*)(ws + WS_XN);
    for (int row = gw; row < MT; row += NGW) {
        const bool isctx = row >= M;
        const int r2 = isctx ? row - M : row;
        const int b = isctx ? r2 / TCX : r2 / T, t = isctx ? r2 % TCX : r2 % T;
        const float* base = isctx ? a.in[2] : a.in[0];
        const float* md = mods + (size_t)(isctx ? 8 : b) * 6144;
        const float rs = rstd[row];
#pragma unroll
        for (int j = 0; j < 4; ++j) {
            const int c = 4 * lane + 256 * j;
            const f32x4 xv = ld4(base + (size_t)r2 * D + c), gv = ld4(g + c), shv = ld4(md + c), scv = ld4(md + D + c);
            const f32x4 gs = gv * (1.0f + scv);
            const f32x4 hs = xv * rs * gs + shv;
            int dlt = 0;
            if (!isctx) { const int col = t & 63, gr = t >> 6;
                if (j == 0) dlt = col > 0 ? -1 : 0; else if (j == 1) dlt = col < 63 ? 1 : 0; else if (j == 2) dlt = gr > 0 ? -64 : 0; else dlt = gr < 31 ? 64 : 0;
            } else { if (j < 2) dlt = t > 0 ? -1 : 0; else dlt = t < TCX - 1 ? 1 : 0; }
            f32x4 hn = (f32x4){0.f, 0.f, 0.f, 0.f};
            if (dlt != 0) { const f32x4 xn = ld4(base + (size_t)(r2 + dlt) * D + c); const float rn = rstd[row + dlt]; hn = xn * rn * gs + shv; }
            const f32x4 dx = hn - hs;
#pragma unroll
            for (int n = 0; n < 6; ++n) { const f32x4 m4 = ld4(mu + n * D + c); const f32x4 o = hs + dx * m4;
                u32x2 w; w.x = cvt_pk_bf16(o[0], o[1]); w.y = cvt_pk_bf16(o[2], o[3]);
                *(u32x2*)(XN + ((size_t)n * MT + row) * D + c) = w; }
        }
    }
}

__device__ __forceinline__ void phase_fin(const Args& a, LAS unsigned char* lds, int tid, int lane, int wave, int G) {
    unsigned char* ws = a.ws;
    const int q = lane >> 4, rho = lane & 15;
    const bf16_t* W2W = (const bf16_t*)(ws + WS_W2W); const bf16_t* W2A = (const bf16_t*)(ws + WS_W2A); const bf16_t* W2G = (const bf16_t*)(ws + WS_W2G);
    const bf16_t* L1W = (const bf16_t*)(ws + WS_L1W); const bf16_t* L1A = (const bf16_t*)(ws + WS_L1A); const bf16_t* L1G = (const bf16_t*)(ws + WS_L1G);
    const bf16_t* KR = (const bf16_t*)(ws + WS_KRAW); const bf16_t* RB = (const bf16_t*)(ws + WS_R);
    bf16_t* DEC = (bf16_t*)(ws + WS_DEC); bf16_t* ICL = (bf16_t*)(ws + WS_ICL); bf16_t* KKN = (bf16_t*)(ws + WS_KKN); bf16_t* GATE = (bf16_t*)(ws + WS_GATE);
    float* BONUS = (float*)(ws + WS_BONUS);
    const int nparts = G / NH;
    {
        const int h = blockIdx.x % NH;
        const int part = blockIdx.x / NH;
        if (part >= nparts) return;
        __syncthreads();
        for (int f = wave; f < 52; f += NWAVES) {
            int mat, p, n, s;
            if (f < 32) { mat = f >> 3; p = (f >> 2) & 1; n = (f >> 1) & 1; s = f & 1; } else { const int r = f - 32; mat = 4; p = r / 10; n = (r % 10) / 5; s = r % 5; }
            const int ch = h * 64 + p * 32 + 8 * (rho >> 2) + 4 * n + (rho & 3), k = 32 * s + 8 * q;
            const bf16_t* src = mat < 2 ? W2W + ((size_t)mat * D + ch) * 64 + k : mat < 4 ? W2A + ((size_t)(mat - 2) * D + ch) * 64 + k : W2G + (size_t)ch * 160 + k;
            *(LAS u32x4*)(lds + f * 1024 + lane * 16) = *(const u32x4*)src;
        }
        __syncthreads();
        const float* w0p = a.in[9]; const float* a0p = a.in[12]; const float* kkp = a.in[17]; const float* kap = a.in[18]; const float* rkp = a.in[19];
        for (int rb = part; rb < MT / 128; rb += nparts) {
            const int trow = rb * 128 + wave * 16 + rho;
            const bool lat = (rb * 128) < M;
            bf16x8 tw[2][2], ta[2][2], tg[5];
#pragma unroll
            for (int z = 0; z < 2; ++z)
#pragma unroll
                for (int s = 0; s < 2; ++s) { tw[z][s] = *(const bf16x8*)(L1W + (size_t)trow * 256 + z * 64 + 32 * s + 8 * q); ta[z][s] = *(const bf16x8*)(L1A + (size_t)trow * 256 + z * 64 + 32 * s + 8 * q); }
            if (lat) {
#pragma unroll
                for (int s = 0; s < 5; ++s) tg[s] = *(const bf16x8*)(L1G + (size_t)trow * 256 + 32 * s + 8 * q);
            }
            float kkraw[2][8]; float ssq = 0.f, bon = 0.f;
#pragma unroll
            for (int p = 0; p < 2; ++p) {
                f32x4 aw[2][2], aa[2][2], ag[2];
#pragma unroll
                for (int n = 0; n < 2; ++n) {
#pragma unroll
                    for (int z = 0; z < 2; ++z) { aw[z][n] = (f32x4){0.f, 0.f, 0.f, 0.f}; aa[z][n] = (f32x4){0.f, 0.f, 0.f, 0.f};
#pragma unroll
                        for (int s = 0; s < 2; ++s) {
                            const bf16x8 fw = *(const LAS bf16x8*)(lds + ((z) * 8 + p * 4 + n * 2 + s) * 1024 + lane * 16);
                            const bf16x8 fa = *(const LAS bf16x8*)(lds + ((2 + z) * 8 + p * 4 + n * 2 + s) * 1024 + lane * 16);
                            aw[z][n] = __builtin_amdgcn_mfma_f32_16x16x32_bf16(fw, tw[z][s], aw[z][n], 0, 0, 0);
                            aa[z][n] = __builtin_amdgcn_mfma_f32_16x16x32_bf16(fa, ta[z][s], aa[z][n], 0, 0, 0); } }
                    ag[n] = (f32x4){0.f, 0.f, 0.f, 0.f};
                    if (lat) {
#pragma unroll
                        for (int s = 0; s < 5; ++s) { const bf16x8 fg = *(const LAS bf16x8*)(lds + (32 + p * 10 + n * 5 + s) * 1024 + lane * 16);
                            ag[n] = __builtin_amdgcn_mfma_f32_16x16x32_bf16(fg, tg[s], ag[n], 0, 0, 0); }
                    }
                }
                const int cl = p * 32 + 8 * q, cb = h * 64 + cl;
                float kv[8], rv[8];
                unpack8(*(const u32x4*)(KR + (size_t)trow * D + cb), kv);
                if (lat) unpack8(*(const u32x4*)(RB + (size_t)trow * D + cb), rv);
                float dlo[2][8], icl[2][8], gt[8];
#pragma unroll
                for (int e = 0; e < 8; ++e) {
                    const int n = e >> 2, i = e & 3, ch = cb + e;
#pragma unroll
                    for (int z = 0; z < 2; ++z) {
                        const float wp = aw[z][n][i] + w0p[z * D + ch];
                        dlo[z][e] = -0.60653066f * sigmoidf_(wp);
                        icl[z][e] = sigmoidf_(aa[z][n][i] + a0p[z * D + ch]);
                    }
                    gt[e] = ag[n][i];
                    const float kr = kv[e] * kkp[ch]; kkraw[p][e] = kr; ssq += kr * kr;
                    if (lat) { const float ka = kap[ch]; const float kd0 = kv[e] * (1.0f + (icl[0][e] - 1.0f) * ka), kd1 = kv[e] * (1.0f + (icl[1][e] - 1.0f) * ka);
                        bon += rv[e] * 0.5f * (kd0 + kd1) * rkp[h * 64 + cl + e]; }
                }
#pragma unroll
                for (int z = 0; z < 2; ++z) { *(u32x4*)(DEC + ((size_t)z * MT + trow) * D + cb) = pack8(dlo[z]); *(u32x4*)(ICL + ((size_t)z * MT + trow) * D + cb) = pack8(icl[z]); }
                if (lat) *(u32x4*)(GATE + (size_t)trow * D + cb) = pack8(gt);
            }
            ssq += __shfl_xor(ssq, 16); ssq += __shfl_xor(ssq, 32);
            const float inv = rsqrtf(fmaxf(ssq, 1e-24f));
#pragma unroll
            for (int p = 0; p < 2; ++p) { float o[8];
#pragma unroll
                for (int e = 0; e < 8; ++e) o[e] = kkraw[p][e] * inv;
                *(u32x4*)(KKN + (size_t)trow * D + h * 64 + p * 32 + 8 * q) = pack8(o); }
            if (lat) { bon += __shfl_xor(bon, 16); bon += __shfl_xor(bon, 32); if (q == 0) BONUS[(size_t)trow * NH + h] = bon; }
        }
    }
}

__device__ __forceinline__ void phase_scan(const Args& a, LAS unsigned char* lds, int tid, int G) {
    unsigned char* ws = a.ws;
    const bf16_t* DEC = (const bf16_t*)(ws + WS_DEC); const bf16_t* ICL = (const bf16_t*)(ws + WS_ICL); const bf16_t* KKN = (const bf16_t*)(ws + WS_KKN);
    const bf16_t* KR = (const bf16_t*)(ws + WS_KRAW); const bf16_t* RB = (const bf16_t*)(ws + WS_R); const bf16_t* VB = (const bf16_t*)(ws + WS_V);
    const float* kap = a.in[18];
    constexpr int CH = 32;
    LAS float* LA = (LAS float*)lds; LAS float* LW = LA + CH * 64; LAS float* LB = LW + CH * 64; LAS float* LK = LB + CH * 64; LAS float* LR = LK + CH * 64; LAS float* LV = LR + CH * 64; LAS float* LY = LV + CH * 64;
    const int i = tid >> 3, c = tid & 7;
    const int stt = tid >> 4, sc4 = tid & 15;
    for (int unit = blockIdx.x; unit < 2 * NB * NH; unit += G) {
        const int dir = unit & 1, bh = unit >> 1, b = bh / NH, h = bh % NH;
        bf16_t* Y = (bf16_t*)(ws + (dir ? WS_YB : WS_YF));
        float s[8];
#pragma unroll
        for (int j = 0; j < 8; ++j) s[j] = 0.f;
        const f32x4 ka4 = ld4(kap + h * 64 + 4 * sc4);
        __syncthreads();
        for (int chunk = 0; chunk < (TCX + T) / CH; ++chunk) {
            const int step0 = chunk * CH;
            const bool lat = step0 >= TCX;
            int srow;
            { const int st = step0 + stt;
              if (!lat) srow = M + b * TCX + (dir ? (TCX - 1 - st) : st); else srow = b * T + (dir ? (T - 1 - (st - TCX)) : (st - TCX)); }
            {
                const size_t off = (size_t)srow * D + h * 64 + 4 * sc4;
                float kk[4], dl[4], ic[4], kr[4], vv[4], rr[4];
                unpack4(*(const u32x2*)(KKN + off), kk); unpack4(*(const u32x2*)(DEC + (size_t)dir * MT * D + off), dl); unpack4(*(const u32x2*)(ICL + (size_t)dir * MT * D + off), ic);
                unpack4(*(const u32x2*)(KR + off), kr); unpack4(*(const u32x2*)(VB + off), vv);
                if (lat) unpack4(*(const u32x2*)(RB + off), rr); else { rr[0] = rr[1] = rr[2] = rr[3] = 0.f; }
                f32x4 va, vw, vb, vk, vr, vvv;
#pragma unroll
                for (int e = 0; e < 4; ++e) { va[e] = -kk[e]; vw[e] = __expf(dl[e]); vb[e] = kk[e] * ic[e]; vk[e] = kr[e] * (1.0f + (ic[e] - 1.0f) * ka4[e]); vr[e] = rr[e]; vvv[e] = vv[e]; }
                const int lo = stt * 64 + 4 * sc4;
                *(LAS f32x4*)(LA + lo) = va; *(LAS f32x4*)(LW + lo) = vw; *(LAS f32x4*)(LB + lo) = vb; *(LAS f32x4*)(LK + lo) = vk; *(LAS f32x4*)(LR + lo) = vr; *(LAS f32x4*)(LV + lo) = vvv;
            }
            __syncthreads();
#pragma unroll 4
            for (int tt = 0; tt < CH; ++tt) {
                const int lo = tt * 64 + 8 * c;
                const f32x4 a0 = *(const LAS f32x4*)(LA + lo), a1 = *(const LAS f32x4*)(LA + lo + 4);
                const f32x4 w0 = *(const LAS f32x4*)(LW + lo), w1 = *(const LAS f32x4*)(LW + lo + 4);
                const f32x4 b0 = *(const LAS f32x4*)(LB + lo), b1 = *(const LAS f32x4*)(LB + lo + 4);
                const f32x4 k0 = *(const LAS f32x4*)(LK + lo), k1 = *(const LAS f32x4*)(LK + lo + 4);
                const float vi = LV[tt * 64 + i];
                float sa = s[0] * a0[0] + s[1] * a0[1] + s[2] * a0[2] + s[3] * a0[3] + s[4] * a1[0] + s[5] * a1[1] + s[6] * a1[2] + s[7] * a1[3];
                sa = red8(sa);
#pragma unroll
                for (int j = 0; j < 4; ++j) { s[j] = s[j] * w0[j] + sa * b0[j] + vi * k0[j]; s[4 + j] = s[4 + j] * w1[j] + sa * b1[j] + vi * k1[j]; }
                if (lat) {
                    const f32x4 r0 = *(const LAS f32x4*)(LR + lo), r1 = *(const LAS f32x4*)(LR + lo + 4);
                    float y = s[0] * r0[0] + s[1] * r0[1] + s[2] * r0[2] + s[3] * r0[3] + s[4] * r1[0] + s[5] * r1[1] + s[6] * r1[2] + s[7] * r1[3];
                    y = red8(y);
                    if (c == 0) LY[tt * 64 + i] = y;
                }
            }
            __syncthreads();
            if (lat) {
                const f32x4 yv = *(const LAS f32x4*)(LY + stt * 64 + 4 * sc4);
                u32x2 w; w.x = cvt_pk_bf16(yv[0], yv[1]); w.y = cvt_pk_bf16(yv[2], yv[3]);
                *(u32x2*)(Y + (size_t)srow * D + h * 64 + 4 * sc4) = w;
            }
        }
    }
}

__device__ __forceinline__ void phase_readout(const Args& a, int gw, int NGW, int lane) {
    unsigned char* ws = a.ws;
    const bf16_t* YF = (const bf16_t*)(ws + WS_YF); const bf16_t* YB = (const bf16_t*)(ws + WS_YB); const bf16_t* VB = (const bf16_t*)(ws + WS_V); const bf16_t* GATE = (const bf16_t*)(ws + WS_GATE);
    const float* BONUS = (const float*)(ws + WS_BONUS); bf16_t* OG = (bf16_t*)(ws + WS_OG);
    const float* lnw = a.in[20]; const float* lnb = a.in[21];
    for (int row = gw; row < M; row += NGW) {
        const size_t off = (size_t)row * D + 16 * lane;
        float y[16], t8[8];
        unpack8(*(const u32x4*)(YF + off), y); unpack8(*(const u32x4*)(YF + off + 8), y + 8);
        unpack8(*(const u32x4*)(YB + off), t8);
#pragma unroll
        for (int e = 0; e < 8; ++e) y[e] += t8[e];
        unpack8(*(const u32x4*)(YB + off + 8), t8);
#pragma unroll
        for (int e = 0; e < 8; ++e) y[8 + e] += t8[e];
        float sm = 0.f;
#pragma unroll
        for (int e = 0; e < 16; ++e) sm += y[e];
        sm += __shfl_xor(sm, 1); sm += __shfl_xor(sm, 2);
        const float mean = sm * (1.0f / 64.0f);
        float vr = 0.f;
#pragma unroll
        for (int e = 0; e < 16; ++e) { y[e] -= mean; vr += y[e] * y[e]; }
        vr += __shfl_xor(vr, 1); vr += __shfl_xor(vr, 2);
        const float rs = rsqrtf(vr * (1.0f / 64.0f) + GN_EPS);
        const float bon = BONUS[(size_t)row * NH + (lane >> 2)];
        float vv[16], gg[16], o[16];
        unpack8(*(const u32x4*)(VB + off), vv); unpack8(*(const u32x4*)(VB + off + 8), vv + 8);
        unpack8(*(const u32x4*)(GATE + off), gg); unpack8(*(const u32x4*)(GATE + off + 8), gg + 8);
#pragma unroll
        for (int e = 0; e < 16; ++e) { const int ch = 16 * lane + e; o[e] = (y[e] * rs * lnw[ch] + lnb[ch] + bon * vv[e]) * gg[e]; }
        *(u32x4*)(OG + off) = pack8(o); *(u32x4*)(OG + off + 8) = pack8(o + 8);
    }
}

template <int MODE>
__device__ __forceinline__ void phase_rowpass(const Args& a, LAS unsigned char* lds, int tid, int lane, int wave, int G) {
    unsigned char* ws = a.ws;
    const float* mods = (const float*)(ws + WS_MODS);
    const float* ng = a.in[6];
    const float* Y0 = (const float*)(ws + WS_Y0); float* XR = (float*)(ws + WS_XR); bf16_t* HB = (bf16_t*)(ws + WS_HB);
    const int lpost = MODE < 2 ? 0 : 1, gtoff = (MODE == 0 || MODE == 2) ? 2048 : 5120, gpost = (MODE == 0 || MODE == 2) ? 1 : 3;
    const int lpre = MODE == 0 ? 0 : 1, gpre = MODE == 0 ? 2 : (MODE == 1 ? 0 : 2), shoff = MODE == 1 ? 0 : 3072, scoff = MODE == 1 ? 1024 : 4096;
    LAS int* lcnt = (LAS int*)lds;
    LAS int* linfo = (LAS int*)(lds + 256);
    int* CNT = (int*)(ws + WS_CTL);
    int pst[NE];
    if (MODE == 2) { if (tid < 16) lcnt[tid] = 0; __syncthreads(); }
    if (MODE == 3) { int acc = 0;
#pragma unroll
        for (int e = 0; e < NE; ++e) { pst[e] = acc; acc += (CNT[e] + 255) & ~255; } }
    const int rpb = (M + G - 1) / G;
    const int r0 = blockIdx.x * rpb, r1 = (r0 + rpb) < M ? (r0 + rpb) : M;
    for (int row = r0 + wave; row < r1; row += NWAVES) {
        const int b = row / T;
        const float* mdp = mods + (size_t)(lpost * 9 + b) * 6144;
        const float* mdn = mods + (size_t)(lpre * 9 + b) * 6144;
        f32x4 f[4], xr[4];
        if (MODE == 3) {
            const int* TP = (const int*)(ws + WS_TPOS); const int* TE = (const int*)(ws + WS_TOPE); const float* TG = (const float*)(ws + WS_TOPG);
            const int e1 = TE[2 * row], e2 = TE[2 * row + 1];
            int s1 = TP[2 * row], s2 = TP[2 * row + 1];
#pragma unroll
            for (int e = 0; e < NE; ++e) { if (e == e1) s1 += pst[e]; if (e == e2) s2 += pst[e]; }
            const float g1 = TG[2 * row], g2 = TG[2 * row + 1];
            const float* YS = (const float*)(ws + WS_YS);
#pragma unroll
            for (int j = 0; j < 4; ++j) f[j] = g1 * ld4(YS + (size_t)s1 * D + 4 * lane + 256 * j) + g2 * ld4(YS + (size_t)s2 * D + 4 * lane + 256 * j);
        } else {
#pragma unroll
            for (int j = 0; j < 4; ++j) f[j] = ld4(Y0 + (size_t)row * D + 4 * lane + 256 * j);
        }
        const float* rsd = MODE == 0 ? a.in[0] : XR;
        float ss = 0.f;
#pragma unroll
        for (int j = 0; j < 4; ++j) { xr[j] = ld4(rsd + (size_t)row * D + 4 * lane + 256 * j); ss += f[j][0] * f[j][0] + f[j][1] * f[j][1] + f[j][2] * f[j][2] + f[j][3] * f[j][3]; }
        ss = wave_sum(ss);
        const float rs = rsqrtf(ss * (1.0f / D) + NORM_EPS);
        float ss2 = 0.f;
#pragma unroll
        for (int j = 0; j < 4; ++j) { const int c = 4 * lane + 256 * j;
            xr[j] = xr[j] + ld4(mdp + gtoff + c) * (f[j] * rs * ld4(ng + (lpost * 4 + gpost) * D + c));
            ss2 += xr[j][0] * xr[j][0] + xr[j][1] * xr[j][1] + xr[j][2] * xr[j][2] + xr[j][3] * xr[j][3]; }
        if (MODE == 3) {
#pragma unroll
            for (int j = 0; j < 4; ++j) *(f32x4*)(a.out + (size_t)row * D + 4 * lane + 256 * j) = xr[j];
            continue;
        }
#pragma unroll
        for (int j = 0; j < 4; ++j) *(f32x4*)(XR + (size_t)row * D + 4 * lane + 256 * j) = xr[j];
        ss2 = wave_sum(ss2);
        const float rs2 = rsqrtf(ss2 * (1.0f / D) + NORM_EPS);
        float lg[NE];
#pragma unroll
        for (int e = 0; e < NE; ++e) lg[e] = 0.f;
#pragma unroll
        for (int j = 0; j < 4; ++j) { const int c = 4 * lane + 256 * j;
            const f32x4 hv = xr[j] * rs2 * ld4(ng + (lpre * 4 + gpre) * D + c) * (1.0f + ld4(mdn + scoff + c)) + ld4(mdn + shoff + c);
            u32x2 w; w.x = cvt_pk_bf16(hv[0], hv[1]); w.y = cvt_pk_bf16(hv[2], hv[3]);
            *(u32x2*)(HB + (size_t)row * D + c) = w;
            if (MODE == 2) {
                const float* wr = a.in[28] + (size_t)c * NE;
#pragma unroll
                for (int i = 0; i < 4; ++i) { const f32x4 wa = ld4(wr + i * NE), wb = ld4(wr + i * NE + 4);
                    lg[0] += hv[i] * wa[0]; lg[1] += hv[i] * wa[1]; lg[2] += hv[i] * wa[2]; lg[3] += hv[i] * wa[3];
                    lg[4] += hv[i] * wb[0]; lg[5] += hv[i] * wb[1]; lg[6] += hv[i] * wb[2]; lg[7] += hv[i] * wb[3]; }
            }
        }
        if (MODE == 2) {
#pragma unroll
            for (int e = 0; e < NE; ++e) lg[e] = wave_sum(lg[e]);
            if (lane == 0) {
                int e1 = 0; float v1 = lg[0];
#pragma unroll
                for (int e = 1; e < NE; ++e) if (lg[e] > v1) { v1 = lg[e]; e1 = e; }
                int e2 = -1; float v2 = -3.0e38f;
#pragma unroll
                for (int e = 0; e < NE; ++e) if (e != e1 && lg[e] > v2) { v2 = lg[e]; e2 = e; }
                const float g1 = 1.0f / (1.0f + __expf(v2 - v1));
                ((int*)(ws + WS_TOPE))[2 * row] = e1; ((int*)(ws + WS_TOPE))[2 * row + 1] = e2;
                ((float*)(ws + WS_TOPG))[2 * row] = g1; ((float*)(ws + WS_TOPG))[2 * row + 1] = 1.0f - g1;
                const int p1 = atomicAdd((int*)(lcnt + e1), 1), p2 = atomicAdd((int*)(lcnt + e2), 1);
                const int lr = row - r0;
                linfo[4 * lr] = e1; linfo[4 * lr + 1] = e2; linfo[4 * lr + 2] = p1; linfo[4 * lr + 3] = p2;
            }
        }
    }
    if (MODE == 2) {
        __syncthreads();
        if (tid < NE) lcnt[8 + tid] = atomicAdd(CNT + tid, lcnt[tid]);
        __syncthreads();
        int* TP = (int*)(ws + WS_TPOS); int* SLOT = (int*)(ws + WS_SLOT);
        for (int lr = tid; lr < r1 - r0; lr += NTHREADS) {
            const int e1 = linfo[4 * lr], e2 = linfo[4 * lr + 1];
            const int p1 = lcnt[8 + e1] + linfo[4 * lr + 2], p2 = lcnt[8 + e2] + linfo[4 * lr + 3];
            TP[2 * (r0 + lr)] = p1; TP[2 * (r0 + lr) + 1] = p2;
            SLOT[e1 * M + p1] = r0 + lr; SLOT[e2 * M + p2] = r0 + lr;
        }
    }
}

__device__ __forceinline__ void phase_conv(const Args& a, int tid, int G) {
    unsigned char* ws = a.ws;
    const bf16_t* BG = (const bf16_t*)(ws + WS_BG); const bf16_t* Z = (const bf16_t*)(ws + WS_Z); bf16_t* CV = (bf16_t*)(ws + WS_CV);
    const float* cw = a.in[24];
    const int gt = blockIdx.x * NTHREADS + tid, NGT = G * NTHREADS;
    for (int idx = gt; idx < M * (D / 8); idx += NGT) {
        const int row = idx >> 7, c = (idx & 127) * 8, t = row % T;
        float zc[8], zp[8], zn[8], bg[8], o[8];
        unpack8(*(const u32x4*)(Z + (size_t)row * D + c), zc); unpack8(*(const u32x4*)(BG + (size_t)row * D + c), bg);
        if (t > 0) unpack8(*(const u32x4*)(Z + (size_t)(row - 1) * D + c), zp); else { for (int e = 0; e < 8; ++e) zp[e] = 0.f; }
        if (t < T - 1) unpack8(*(const u32x4*)(Z + (size_t)(row + 1) * D + c), zn); else { for (int e = 0; e < 8; ++e) zn[e] = 0.f; }
#pragma unroll
        for (int e = 0; e < 8; ++e) o[e] = bg[e] * (zp[e] * cw[c + e] + zc[e] * cw[D + c + e] + zn[e] * cw[2 * D + c + e]);
        *(u32x4*)(CV + (size_t)row * D + c) = pack8(o);
    }
}

__device__ __forceinline__ void phase_gather(const Args& a, int gw, int NGW, int lane) {
    unsigned char* ws = a.ws;
    const int* CNT = (const int*)(ws + WS_CTL); const int* TE = (const int*)(ws + WS_TOPE); const int* TP = (const int*)(ws + WS_TPOS);
    const bf16_t* HB = (const bf16_t*)(ws + WS_HB); bf16_t* XS = (bf16_t*)(ws + WS_XS);
    int pst[NE]; { int acc = 0;
#pragma unroll
        for (int e = 0; e < NE; ++e) { pst[e] = acc; acc += (CNT[e] + 255) & ~255; } }
    for (int pr = gw; pr < 2 * M; pr += NGW) {
        const int e = TE[pr]; int slot = TP[pr];
#pragma unroll
        for (int q = 0; q < NE; ++q) if (q == e) slot += pst[q];
        const u32x4* src = (const u32x4*)(HB + (size_t)(pr >> 1) * D); u32x4* dst = (u32x4*)(XS + (size_t)slot * D);
        dst[lane] = src[lane]; dst[lane + 64] = src[lane + 64];
    }
}

__global__ void __launch_bounds__(NTHREADS, 2) mk_fwd(Args args) {
    extern __shared__ __attribute__((aligned(16))) unsigned char lds_raw[];
    LAS unsigned char* lds = (LAS unsigned char*)lds_raw;
    LAS int* ctl = (LAS int*)(lds + CTL_OFF);
    const int tid = threadIdx.x, lane = tid & 63, wave = __builtin_amdgcn_readfirstlane(tid >> 6);
    const int G = gridDim.x;
    const int gw = blockIdx.x * NWAVES + wave, NGW = G * NWAVES;
    unsigned char* ws = args.ws;
    const int lo = args.ph_lo, hi = args.ph_hi;
#ifndef PH_MASK
#define PH_MASK 0x7ffff
#endif
#define PH_ON(k) ((PH_MASK >> (k)) & 1)
#define IN(k) (PH_ON(k) && lo <= (k) && (k) < hi)
#define SEAM(k) do { if (lo <= (k) && (k) + 1 < hi) cg::this_grid().sync(); } while (0)
#define RUN_GEMM(KK, LDA, LDB) do { __syncthreads(); pg8::gemm_phase(lds, ctl, (KK), (LDA), (LDB), G, (int)blockIdx.x); } while (0)
    if (IN(0)) { phase0(args, lds, tid, lane, wave, G); } SEAM(0);
    if (IN(1)) { phase_mix(args, gw, NGW, lane); } SEAM(1);
    if (IN(2)) {
        if (tid == 0) {
            const bf16_t* XN = (const bf16_t*)(ws + WS_XN);
            pg8::set_job(ctl, 0, XN + (size_t)0 * MT * D, ws + WS_WR, ws + WS_R, M / 256, 4, pg8::EPI_BF16, D, 0);
            pg8::set_job(ctl, 1, XN + (size_t)2 * MT * D, ws + WS_WK, ws + WS_KRAW, MT / 256, 4, pg8::EPI_BF16, D, 0);
            pg8::set_job(ctl, 2, XN + (size_t)3 * MT * D, ws + WS_WV, ws + WS_V, MT / 256, 4, pg8::EPI_BF16, D, 0);
            pg8::set_job(ctl, 3, XN + (size_t)1 * MT * D, ws + WS_WW1, ws + WS_L1W, MT / 256, 1, pg8::EPI_BF16, 256, 1);
            pg8::set_job(ctl, 4, XN + (size_t)4 * MT * D, ws + WS_WA1, ws + WS_L1A, MT / 256, 1, pg8::EPI_BF16, 256, 0);
            pg8::set_job(ctl, 5, XN + (size_t)5 * MT * D, ws + WS_WG1, ws + WS_L1G, M / 256, 1, pg8::EPI_BF16, 256, 2);
        }
        RUN_GEMM(D, D, D);
    } SEAM(2);
    if (IN(3)) { phase_fin(args, lds, tid, lane, wave, G); } SEAM(3);
    if (IN(4)) { phase_scan(args, lds, tid, G); } SEAM(4);
    if (IN(5)) { phase_readout(args, gw, NGW, lane); } SEAM(5);
    if (IN(6)) { if (tid == 0) pg8::set_job(ctl, 0, ws + WS_OG, ws + WS_WOUT, ws + WS_Y0, M / 256, 4, pg8::EPI_F32, D, 0); RUN_GEMM(D, D, D); } SEAM(6);
    if (IN(7)) { phase_rowpass<0>(args, lds, tid, lane, wave, G); } SEAM(7);
    if (IN(8)) { if (tid == 0) pg8::set_job(ctl, 0, ws + WS_HB, ws + WS_WGU, ws + WS_ACT, M / 256, 2 * FF / 256, pg8::EPI_SWIGLU, FF, 0); RUN_GEMM(D, D, D); } SEAM(8);
    if (IN(9)) { if (tid == 0) pg8::set_job(ctl, 0, ws + WS_ACT, ws + WS_WDN, ws + WS_Y0, M / 256, 4, pg8::EPI_F32, D, 0); RUN_GEMM(FF, FF, FF); } SEAM(9);
    if (IN(10)) { phase_rowpass<1>(args, lds, tid, lane, wave, G); } SEAM(10);
    if (IN(11)) {
        if (tid == 0) {
            pg8::set_job(ctl, 0, ws + WS_HB, ws + WS_WCI, ws + WS_BG, M / 256, 4, pg8::EPI_BF16, D, 0);
            pg8::set_job(ctl, 1, ws + WS_HB, ws + WS_WCI + (size_t)D * D * 2, ws + WS_Z, M / 256, 8, pg8::EPI_MUL, D, 0);
        }
        RUN_GEMM(D, D, D);
    } SEAM(11);
    if (IN(12)) { phase_conv(args, tid, G); } SEAM(12);
    if (IN(13)) { if (tid == 0) pg8::set_job(ctl, 0, ws + WS_CV, ws + WS_WCO, ws + WS_Y0, M / 256, 4, pg8::EPI_F32, D, 0); RUN_GEMM(D, D, D); } SEAM(13);
    if (IN(14)) { phase_rowpass<2>(args, lds, tid, lane, wave, G); } SEAM(14);
    if (IN(15)) { phase_gather(args, gw, NGW, lane); } SEAM(15);
    if (IN(16)) {
        if (tid == 0) { const int* CNT = (const int*)(ws + WS_CTL); int ps = 0, j = 0; ctl[0] = 0; ctl[1] = 0;
            for (int e = 0; e < NE; ++e) { const int nM = (CNT[e] + 255) >> 8;
                if (nM > 0) { pg8::set_job(ctl, j, ws + WS_XS + (size_t)ps * D * 2, ws + WS_MGU + (size_t)e * 2 * FF * D * 2, ws + WS_MACT + (size_t)ps * FF * 2, nM, 2 * FF / 256, pg8::EPI_SWIGLU, FF, 0); ++j; }
                ps += nM * 256; } }
        RUN_GEMM(D, D, D);
    } SEAM(16);
    if (IN(17)) {
        if (tid == 0) { const int* CNT = (const int*)(ws + WS_CTL); int ps = 0, j = 0; ctl[0] = 0; ctl[1] = 0;
            for (int e = 0; e < NE; ++e) { const int nM = (CNT[e] + 255) >> 8;
                if (nM > 0) { pg8::set_job(ctl, j, ws + WS_MACT + (size_t)ps * FF * 2, ws + WS_MDN + (size_t)e * D * FF * 2, ws + WS_YS + (size_t)ps * D * 4, nM, 4, pg8::EPI_F32, D, 0); ++j; }
                ps += nM * 256; } }
        RUN_GEMM(FF, FF, FF);
    } SEAM(17);
    if (IN(18)) { phase_rowpass<3>(args, lds, tid, lane, wave, G); }
}

extern "C" void kernel_launch(void* const* d_in, const int* in_sizes, int n_in, void* d_out, int out_size, void* d_ws, size_t ws_size, hipStream_t stream) {
    static int grid = 0;
    if (grid == 0) {
        int dev = 0, cus = 0, per_cu = 0;
        if (n_in != 31 || ws_size < WS_END) { fprintf(stderr, "kernel_launch: unexpected n_in %d or ws_size %zu (< %zu)\n", n_in, ws_size, (size_t)WS_END); grid = -1; return; }
        hipGetDevice(&dev);
        hipDeviceGetAttribute(&cus, hipDeviceAttributeMultiprocessorCount, dev);
        if (hipFuncSetAttribute((const void*)mk_fwd, hipFuncAttributeMaxDynamicSharedMemorySize, LDS_BYTES) != hipSuccess) { fprintf(stderr, "kernel_launch: hipFuncSetAttribute failed\n"); grid = -1; return; }
        if (hipOccupancyMaxActiveBlocksPerMultiprocessor(&per_cu, (const void*)mk_fwd, NTHREADS, LDS_BYTES) != hipSuccess || per_cu < 1) { fprintf(stderr, "kernel_launch: occupancy query says %d\n", per_cu); per_cu = 1; }
        (void)hipGetLastError();
        grid = cus;
        fprintf(stderr, "kernel_launch: cus %d per_cu %d grid %d ws %zu\n", cus, per_cu, grid, ws_size);
    }
    if (grid < 0) return;
    Args a{};
    for (int i = 0; i < 31; ++i) a.in[i] = (const float*)d_in[i];
    a.out = (float*)d_out; a.ws = (unsigned char*)d_ws;
#if MK_ONE_LAUNCH
    a.ph_lo = 0; a.ph_hi = NPH;
    void* kargs[] = {&a};
    hipError_t e = hipLaunchCooperativeKernel((const void*)mk_fwd, dim3(grid), dim3(NTHREADS), kargs, LDS_BYTES, stream);
    if (e != hipSuccess) fprintf(stderr, "cooperative launch failed: %s (grid %d)\n", hipGetErrorString(e), grid);
#else
    for (int p = 0; p < NPH; ++p) {
        a.ph_lo = p; a.ph_hi = p + 1;
        hipLaunchKernelGGL(mk_fwd, dim3(grid), dim3(NTHREADS), LDS_BYTES, stream, a);
    }
#endif
}
```

```cpp
#include <hip/hip_runtime.h>
#include <hip/hip_cooperative_groups.h>
#include <cstdio>
#include <cstdint>
namespace cg = cooperative_groups;

#ifndef MK_ONE_LAUNCH
#define MK_ONE_LAUNCH 1
#endif

#define LAS __attribute__((address_space(3)))
typedef unsigned short bf16_t;
typedef short bf16x8 __attribute__((ext_vector_type(8)));
typedef float f32x4 __attribute__((ext_vector_type(4)));
typedef float f32x2 __attribute__((ext_vector_type(2)));
typedef unsigned u32x4 __attribute__((ext_vector_type(4)));
typedef unsigned u32x2 __attribute__((ext_vector_type(2)));
typedef int i32x8 __attribute__((ext_vector_type(8)));
typedef int i32x4 __attribute__((ext_vector_type(4)));

constexpr int D = 1024, NB = 8, T = 2048, TCX = 256, M = NB * T, MC = NB * TCX, MT = M + MC, NH = 16, HS = 64, FF = 3584, NE = 8;
constexpr float NORM_EPS = 1e-6f, GN_EPS = 64e-5f;
constexpr int NPH = 19;

constexpr size_t MiB = 1u << 20;
constexpr size_t WS_WR = 0, WS_WK = 2 * MiB, WS_WV = 4 * MiB, WS_WW1 = 6 * MiB, WS_WA1 = 6 * MiB + 512 * 1024, WS_WG1 = 7 * MiB;
constexpr size_t WS_W2W = 7 * MiB + 512 * 1024, WS_W2A = WS_W2W + 256 * 1024, WS_W2G = 8 * MiB;
constexpr size_t WS_WOUT = 9 * MiB, WS_WGU = 11 * MiB, WS_WDN = 25 * MiB, WS_WCI = 32 * MiB, WS_WCO = 38 * MiB, WS_MGU = 40 * MiB, WS_MDN = 152 * MiB;
constexpr size_t WS_MODS = 208 * MiB, WS_RSTD = 209 * MiB, WS_BONUS = 210 * MiB, WS_TOPE = 211 * MiB, WS_TOPG = WS_TOPE + 128 * 1024, WS_TPOS = WS_TOPG + 128 * 1024;
constexpr size_t WS_SLOT = 211 * MiB + 512 * 1024, WS_CTL = 212 * MiB;
constexpr size_t WS_XR = 214 * MiB, WS_HB = 278 * MiB, WS_GATE = 310 * MiB, WS_OG = 342 * MiB, WS_YF = 374 * MiB, WS_YB = 406 * MiB, WS_Y0 = 374 * MiB;
constexpr size_t WS_S2 = 438 * MiB, WS_R = WS_S2, WS_KRAW = WS_S2 + 36 * MiB, WS_V = WS_S2 + 72 * MiB, WS_L1W = WS_S2 + 108 * MiB, WS_L1A = WS_S2 + 117 * MiB, WS_L1G = WS_S2 + 126 * MiB;
constexpr size_t WS_BG = WS_S2, WS_Z = WS_S2 + 32 * MiB, WS_CV = WS_S2 + 64 * MiB, WS_XS = WS_S2, WS_YS = WS_S2;
constexpr size_t WS_S1 = 574 * MiB, WS_XN = WS_S1, WS_AT = WS_S1, WS_BT = WS_S1 + 72 * MiB, WS_KT = WS_S1 + 144 * MiB, WS_ACT = WS_S1, WS_MACT = WS_S1;
constexpr size_t WS_BONUS1 = 213 * MiB;
constexpr size_t WS_RT = WS_XR, WS_GC = WS_XR + 72 * MiB;
constexpr size_t HMA = (size_t)NB * NH * (TCX + T) * HS;
constexpr int NPOS = TCX + T, NCHK = NPOS / 16;
constexpr size_t WS_END = 812 * MiB;
constexpr size_t WS_DUMP = 209 * MiB + 512 * 1024;
constexpr int MAXSLOT = 2 * M + NE * 256;

constexpr int LDS_BYTES = 163840;
constexpr int CTL_OFF = 155648;
constexpr int NTHREADS = 512, NWAVES = 8;

struct Args { const float* in[31]; float* out; unsigned char* ws; int ph_lo, ph_hi; };

__device__ __forceinline__ float bf2f(unsigned h) { return __uint_as_float(h << 16); }
typedef __bf16 bf16x2_t __attribute__((ext_vector_type(2)));
__device__ __forceinline__ unsigned cvt_pk_bf16_asm(float lo, float hi) { unsigned r; asm volatile("v_cvt_pk_bf16_f32 %0, %1, %2" : "=v"(r) : "v"(lo), "v"(hi)); return r; }
__device__ __forceinline__ unsigned cvt_pk_bf16(float lo, float hi) { const f32x2 v = {lo, hi}; return __builtin_bit_cast(unsigned, __builtin_convertvector(v, bf16x2_t)); }
__device__ __forceinline__ float sigmoidf_(float x) { return __builtin_amdgcn_rcpf(1.0f + __expf(-x)); }
__device__ __forceinline__ float siluf_(float x) { return x * sigmoidf_(x); }
__device__ __forceinline__ float tanhf_(float x) { return 2.0f * sigmoidf_(2.0f * x) - 1.0f; }
__device__ __forceinline__ float wave_sum(float v) {
#pragma unroll
    for (int o = 1; o < 64; o <<= 1) v += __shfl_xor(v, o);
    return v;
}
__device__ __forceinline__ int rfl(int v) { return __builtin_amdgcn_readfirstlane(v); }
__device__ __forceinline__ f32x4 ld4(const float* p) { return *(const f32x4*)p; }
__device__ __forceinline__ void unpack4(u32x2 w, float* o) { o[0] = bf2f(w.x & 0xffffu); o[1] = bf2f(w.x >> 16); o[2] = bf2f(w.y & 0xffffu); o[3] = bf2f(w.y >> 16); }
__device__ __forceinline__ void unpack8(u32x4 w, float* o) {
    o[0] = bf2f(w.x & 0xffffu); o[1] = bf2f(w.x >> 16); o[2] = bf2f(w.y & 0xffffu); o[3] = bf2f(w.y >> 16);
    o[4] = bf2f(w.z & 0xffffu); o[5] = bf2f(w.z >> 16); o[6] = bf2f(w.w & 0xffffu); o[7] = bf2f(w.w >> 16);
}
__device__ __forceinline__ u32x4 pack8(const float* v) { u32x4 w; w.x = cvt_pk_bf16_asm(v[0], v[1]); w.y = cvt_pk_bf16_asm(v[2], v[3]); w.z = cvt_pk_bf16_asm(v[4], v[5]); w.w = cvt_pk_bf16_asm(v[6], v[7]); return w; }
__device__ __forceinline__ u32x4 pack8v(const float* v) { u32x4 w; w.x = cvt_pk_bf16(v[0], v[1]); w.y = cvt_pk_bf16(v[2], v[3]); w.z = cvt_pk_bf16(v[4], v[5]); w.w = cvt_pk_bf16(v[6], v[7]); return w; }
template <int CTRL> __device__ __forceinline__ float dpp_mov(float v) { return __builtin_bit_cast(float, __builtin_amdgcn_update_dpp(0, __builtin_bit_cast(int, v), CTRL, 0xF, 0xF, true)); }
__device__ __forceinline__ int hm_row(int row) { return row < M ? (row >> 11) * (NH * NPOS) + TCX + (row & (T - 1)) : ((row - M) >> 8) * (NH * NPOS) + ((row - M) & (TCX - 1)); }
__device__ __forceinline__ float red8(float v) {
    v += __builtin_bit_cast(float, __builtin_amdgcn_update_dpp(0, __builtin_bit_cast(int, v), 0xB1, 0xF, 0xF, true));
    v += __builtin_bit_cast(float, __builtin_amdgcn_update_dpp(0, __builtin_bit_cast(int, v), 0x4E, 0xF, 0xF, true));
    v += __builtin_bit_cast(float, __builtin_amdgcn_update_dpp(0, __builtin_bit_cast(int, v), 0x141, 0xF, 0xF, true));
    return v;
}

namespace pg8 {
constexpr int BM = 256, BK = 64, HALF = 128, HTB = HALF * BK * 2, STAGE_BYTES = 8 * HTB, NXCD = 8, WGM = 8;
__device__ __forceinline__ int lds_byte(int r, int c) { const int st = (r >> 4) * 2 + (c >> 5), rr = r & 15, cc = c & 31, ob = rr * 64 + cc * 2; return st * 1024 + (ob ^ (((ob >> 9) & 1) << 5)); }
__device__ __forceinline__ void stage_rc(int b, int& R, int& C) { const int st = b / 1024, sb = b % 1024, swz = sb ^ (((sb >> 9) & 1) << 5); R = (st >> 1) * 16 + swz / 64; C = (st & 1) * 32 + (swz % 64) / 2; }
__device__ __forceinline__ int perm32(int rho) { const int n = rho >> 4, i = rho & 15; return 8 * (i >> 2) + 4 * n + (i & 3); }

enum { EPI_BF16 = 0, EPI_F32 = 1, EPI_SWIGLU = 2, EPI_MUL = 3, EPI_BF16_HM = 4, EPI_SWIGLU8 = 5 };
struct Unit { const char* A; const char* B; int pm, pn, job; };

__device__ __forceinline__ void set_job(LAS int* ctl, int j, const void* A, const void* B, void* O, int nM, int nN, int mode, int ldo, int act) {
    LAS int* jd = ctl + 16 + 16 * j;
    const unsigned long long a = (unsigned long long)A, b = (unsigned long long)B, o = (unsigned long long)O;
    jd[0] = (int)(unsigned)a; jd[1] = (int)(unsigned)(a >> 32); jd[2] = (int)(unsigned)b; jd[3] = (int)(unsigned)(b >> 32); jd[4] = (int)(unsigned)o; jd[5] = (int)(unsigned)(o >> 32);
    jd[6] = nM; jd[7] = nN; jd[9] = mode; jd[10] = ldo; jd[11] = act;
    const int u0 = (j == 0) ? 0 : ctl[16 + 16 * (j - 1) + 8] + ctl[16 + 16 * (j - 1) + 6] * ctl[16 + 16 * (j - 1) + 7];
    jd[8] = u0; ctl[0] = j + 1; ctl[1] = u0 + nM * nN;
}

__device__ __forceinline__ bool sched_next(LAS const int* ctl, int i, int G, int c, size_t tstepA, size_t tstepB, Unit& u) {
    const int total = rfl(ctl[1]), nj = rfl(ctl[0]);
    const long L = (long)i * G + c; if (L >= total) return false;
    int j = 0;
    for (int q = 1; q < nj; ++q) if ((int)L >= rfl(ctl[16 + 16 * q + 8])) j = q;
    LAS const int* jd = ctl + 16 + 16 * j;
    const int nM = rfl(jd[6]), nN = rfl(jd[7]); int wgid = (int)L - rfl(jd[8]);
    const int nwg = nM * nN;
    { const int q = nwg / NXCD, r = nwg % NXCD, xcd = wgid % NXCD, off = wgid / NXCD; wgid = (xcd < r ? xcd * (q + 1) : r * (q + 1) + (xcd - r) * q) + off; }
    const int nig = WGM * nN, gid = wgid / nig, fm = gid * WGM, gsz = (nM - fm) < WGM ? (nM - fm) : WGM;
    u.pm = fm + ((wgid % nig) % gsz); u.pn = (wgid % nig) / gsz; u.job = j;
    const unsigned long long a = ((unsigned long long)(unsigned)rfl(jd[1]) << 32) | (unsigned)rfl(jd[0]);
    const unsigned long long b = ((unsigned long long)(unsigned)rfl(jd[3]) << 32) | (unsigned)rfl(jd[2]);
    u.A = (const char*)a + (size_t)u.pm * tstepA; u.B = (const char*)b + (size_t)u.pn * tstepB;
    return true;
}

__device__ __forceinline__ void epilogue(const f32x4 (&acc)[2][2][4][2], LAS const int* ctl, const Unit& u, int wr, int wc, int fr, int fq) {
    LAS const int* jd = ctl + 16 + 16 * u.job;
    const int mode = rfl(jd[9]), ldo = rfl(jd[10]), act = rfl(jd[11]);
    char* O = (char*)(((unsigned long long)(unsigned)rfl(jd[5]) << 32) | (unsigned)rfl(jd[4]));
    const int row0 = u.pm * BM + wr * 64 + fr;
    if (mode == EPI_BF16) {
        bf16_t* base = (bf16_t*)O; const int col0 = u.pn * BM + wc * 32 + 8 * fq;
#pragma unroll
        for (int ai = 0; ai < 2; ++ai)
#pragma unroll
            for (int m = 0; m < 4; ++m) { bf16_t* rowp = base + (size_t)(row0 + ai * HALF + m * 16) * ldo + col0;
#pragma unroll
                for (int bj = 0; bj < 2; ++bj) { f32x4 v0 = acc[ai][bj][m][0], v1 = acc[ai][bj][m][1];
                    if (act == 1) { _Pragma("unroll") for (int e = 0; e < 4; ++e) { v0[e] = tanhf_(v0[e]); v1[e] = tanhf_(v1[e]); } }
                    else if (act == 2) { _Pragma("unroll") for (int e = 0; e < 4; ++e) { v0[e] = sigmoidf_(v0[e]); v1[e] = sigmoidf_(v1[e]); } }
                    u32x4 w; w.x = cvt_pk_bf16_asm(v0[0], v0[1]); w.y = cvt_pk_bf16_asm(v0[2], v0[3]); w.z = cvt_pk_bf16_asm(v1[0], v1[1]); w.w = cvt_pk_bf16_asm(v1[2], v1[3]);
                    *(u32x4*)(rowp + bj * HALF) = w; } }
    } else if (mode == EPI_BF16_HM) {
        bf16_t* base = (bf16_t*)O; const int col0 = u.pn * BM + wc * 32 + 8 * fq;
#pragma unroll
        for (int ai = 0; ai < 2; ++ai)
#pragma unroll
            for (int m = 0; m < 4; ++m) { const int hr = hm_row(row0 + ai * HALF + m * 16);
#pragma unroll
                for (int bj = 0; bj < 2; ++bj) { const int col = col0 + bj * HALF; const f32x4 v0 = acc[ai][bj][m][0], v1 = acc[ai][bj][m][1];
                    u32x4 w; w.x = cvt_pk_bf16_asm(v0[0], v0[1]); w.y = cvt_pk_bf16_asm(v0[2], v0[3]); w.z = cvt_pk_bf16_asm(v1[0], v1[1]); w.w = cvt_pk_bf16_asm(v1[2], v1[3]);
                    *(u32x4*)(base + ((size_t)(hr + (col >> 6) * NPOS)) * 64 + (col & 63)) = w; } }
    } else if (mode == EPI_F32) {
        float* base = (float*)O; const int col0 = u.pn * BM + wc * 32 + 8 * fq;
#pragma unroll
        for (int ai = 0; ai < 2; ++ai)
#pragma unroll
            for (int m = 0; m < 4; ++m) { float* rowp = base + (size_t)(row0 + ai * HALF + m * 16) * ldo + col0;
#pragma unroll
                for (int bj = 0; bj < 2; ++bj) { *(f32x4*)(rowp + bj * HALF) = acc[ai][bj][m][0]; *(f32x4*)(rowp + bj * HALF + 4) = acc[ai][bj][m][1]; } }
    } else if (mode == EPI_SWIGLU8) {
        unsigned char* base = (unsigned char*)O; const int colb = u.pn * HALF + wc * 16;
#pragma unroll
        for (int ai = 0; ai < 2; ++ai)
#pragma unroll
            for (int bj = 0; bj < 2; ++bj) { int w[4];
#pragma unroll
                for (int m = 0; m < 4; ++m) { const f32x4 g = acc[ai][bj][m][0], uu = acc[ai][bj][m][1]; f32x4 r;
                    _Pragma("unroll") for (int e = 0; e < 4; ++e) r[e] = 4.0f * siluf_(g[e]) * uu[e];
                    w[m] = __builtin_amdgcn_cvt_pk_fp8_f32(r[0], r[1], 0, false); w[m] = __builtin_amdgcn_cvt_pk_fp8_f32(r[2], r[3], w[m], true); }
                const auto s02 = __builtin_amdgcn_permlane32_swap(w[0], w[2], false, false), s13 = __builtin_amdgcn_permlane32_swap(w[1], w[3], false, false);
                const auto t01 = __builtin_amdgcn_permlane16_swap(s02[0], s13[0], false, false), t23 = __builtin_amdgcn_permlane16_swap(s02[1], s13[1], false, false);
                const u32x4 o = {(unsigned)t01[0], (unsigned)t01[1], (unsigned)t23[0], (unsigned)t23[1]};
                *(u32x4*)(base + (size_t)(u.pm * BM + wr * 64 + ai * HALF + 16 * fq + fr) * ldo + colb + bj * 64) = o; }
    } else {
        bf16_t* base = (bf16_t*)O; const int col0 = u.pn * HALF + wc * 16 + 4 * (fq & 2);
#pragma unroll
        for (int ai = 0; ai < 2; ++ai)
#pragma unroll
            for (int bj = 0; bj < 2; ++bj) { u32x2 w[4];
#pragma unroll
                for (int m = 0; m < 4; ++m) { const f32x4 g = acc[ai][bj][m][0], uu = acc[ai][bj][m][1]; f32x4 r;
                    if (mode == EPI_SWIGLU) { _Pragma("unroll") for (int e = 0; e < 4; ++e) r[e] = siluf_(g[e]) * uu[e]; } else { r = g * uu; }
                    w[m].x = cvt_pk_bf16(r[0], r[1]); w[m].y = cvt_pk_bf16(r[2], r[3]); }
#pragma unroll
                for (int mp = 0; mp < 4; mp += 2) {
                    const auto sx = __builtin_amdgcn_permlane16_swap((int)w[mp].x, (int)w[mp + 1].x, false, false), sy = __builtin_amdgcn_permlane16_swap((int)w[mp].y, (int)w[mp + 1].y, false, false);
                    const u32x4 o = {(unsigned)sx[0], (unsigned)sy[0], (unsigned)sx[1], (unsigned)sy[1]};
                    *(u32x4*)(base + (size_t)(row0 + ai * HALF + (mp + (fq & 1)) * 16) * ldo + col0 + bj * 64) = o; } }
    }
}

template <bool FP8>
__device__ __forceinline__ void gemm_phase(LAS unsigned char* lds, LAS const int* ctl, int K, int lda, int ldb, int G, int c, int sW = 127, int sA = 127) {
    const int tid = threadIdx.x, wid = __builtin_amdgcn_readfirstlane(tid >> 6), lane = tid & 63, wr = wid >> 2, wc = wid & 3, fr = lane & 15, fq = lane >> 4;
    const int nt = K / BK;
    sW = sW * 0x01010101; sA = sA * 0x01010101;
    unsigned voffA[2], voffB[2];
#pragma unroll
    for (int i = 0; i < 2; ++i) { int R, C; stage_rc(tid * 16 + i * 8192, R, C); const int Rb = (R & ~31) + perm32(R & 31);
        voffA[i] = (unsigned)(R * lda + C) * 2u; voffB[i] = (unsigned)(Rb * ldb + C) * 2u; }
    const size_t kstep = (size_t)(BK * 2);
    const size_t hsA = (size_t)HALF * lda * 2, hsB = (size_t)HALF * ldb * 2;
    const size_t tsA = 2 * hsA, tsB = 2 * hsB;
    const unsigned ldsw = (unsigned)wid * 1024u;
    const int aoff = lds_byte(wr * 64 + fr, fq * 8), boff = lds_byte(wc * 32 + fr, fq * 8);
#define PG8_SA(b, h) (((b) * 2 + (h)) * HTB)
#define PG8_SB(b, h) ((4 + (b) * 2 + (h)) * HTB)
#define PG8_STAGE(bufoff, gbase, voff) do { _Pragma("unroll") for (int _i = 0; _i < 2; ++_i) \
        __builtin_amdgcn_global_load_lds((const unsigned*)((const char*)(gbase) + (voff)[_i]), (LAS unsigned*)(lds + (bufoff) + ldsw + _i * 8192), 16, 0, 0); } while (0)
#define PG8_LDA(dst, b, h) do { _Pragma("unroll") for (int m = 0; m < 4; ++m) { const i32x4 lo_ = *(const LAS i32x4*)(lds + PG8_SA(b, h) + aoff + m * 2048), hi_ = *(const LAS i32x4*)(lds + PG8_SA(b, h) + aoff + m * 2048 + 1024); \
        dst[m] = __builtin_shufflevector(lo_, hi_, 0, 1, 2, 3, 4, 5, 6, 7); } } while (0)
#define PG8_LDB(dst, b, h) do { _Pragma("unroll") for (int n = 0; n < 2; ++n) { const i32x4 lo_ = *(const LAS i32x4*)(lds + PG8_SB(b, h) + boff + n * 2048), hi_ = *(const LAS i32x4*)(lds + PG8_SB(b, h) + boff + n * 2048 + 1024); \
        dst[n] = __builtin_shufflevector(lo_, hi_, 0, 1, 2, 3, 4, 5, 6, 7); } } while (0)
#define PG8_LO(v) __builtin_bit_cast(bf16x8, __builtin_shufflevector(v, v, 0, 1, 2, 3))
#define PG8_HI(v) __builtin_bit_cast(bf16x8, __builtin_shufflevector(v, v, 4, 5, 6, 7))
#define PG8_MMA16(ai, bj, At, Bt) do { __builtin_amdgcn_s_setprio(1); _Pragma("unroll") for (int m = 0; m < 4; ++m) _Pragma("unroll") for (int n = 0; n < 2; ++n) { \
        acc[ai][bj][m][n] = __builtin_amdgcn_mfma_f32_16x16x32_bf16(PG8_LO(Bt[n]), PG8_LO(At[m]), acc[ai][bj][m][n], 0, 0, 0); \
        acc[ai][bj][m][n] = __builtin_amdgcn_mfma_f32_16x16x32_bf16(PG8_HI(Bt[n]), PG8_HI(At[m]), acc[ai][bj][m][n], 0, 0, 0); } __builtin_amdgcn_s_setprio(0); } while (0)
#define PG8_MMA8(ai, bj, At, Bt) do { __builtin_amdgcn_s_setprio(1); _Pragma("unroll") for (int m = 0; m < 4; ++m) _Pragma("unroll") for (int n = 0; n < 2; ++n) \
        asm volatile("v_mfma_scale_f32_16x16x128_f8f6f4 %0, %1, %2, %0, %3, %4 op_sel_hi:[0,0,0]" : "+v"(acc[ai][bj][m][n]) : "v"(Bt[n]), "v"(At[m]), "v"(sW), "v"(sA)); __builtin_amdgcn_s_setprio(0); } while (0)
#define PG8_MMA(ai, bj, At, Bt) do { if constexpr (FP8) PG8_MMA8(ai, bj, At, Bt); else PG8_MMA16(ai, bj, At, Bt); } while (0)
#define PG8_WAIT_V(n) asm volatile("s_waitcnt vmcnt(" #n ")" ::: "memory")
#define PG8_WAIT_L(n) asm volatile("s_waitcnt lgkmcnt(" #n ")" ::: "memory")
#define PG8_BAR __builtin_amdgcn_s_barrier()
#define PG8_SCHED __builtin_amdgcn_sched_barrier(0)
    Unit cur, nxt; int ui = 0;
    if (!sched_next(ctl, 0, G, c, tsA, tsB, cur)) return;
    f32x4 acc[2][2][4][2];
#pragma unroll
    for (int a = 0; a < 2; ++a)
#pragma unroll
        for (int b = 0; b < 2; ++b)
#pragma unroll
            for (int m = 0; m < 4; ++m)
#pragma unroll
                for (int n = 0; n < 2; ++n) acc[a][b][m][n] = (f32x4){0.f, 0.f, 0.f, 0.f};
    i32x8 At[4], B0[2], B1[2];
    const char* cA = cur.A; const char* cB = cur.B;
    PG8_STAGE(PG8_SB(0, 0), cB, voffB); PG8_STAGE(PG8_SB(0, 1), cB + hsB, voffB); PG8_STAGE(PG8_SA(0, 0), cA, voffA); PG8_STAGE(PG8_SA(0, 1), cA + hsA, voffA);
    if (wr == 1) PG8_BAR;
    PG8_WAIT_V(2); PG8_BAR;
    PG8_STAGE(PG8_SB(1, 0), cB + kstep, voffB); PG8_STAGE(PG8_SA(1, 0), cA + kstep, voffA); PG8_STAGE(PG8_SB(1, 1), cB + hsB + kstep, voffB);
    PG8_WAIT_V(6); PG8_BAR;
    for (;;) {
        const bool has_next = sched_next(ctl, ui + 1, G, c, tsA, tsB, nxt);
        const char* nA = has_next ? nxt.A : cA; const char* nB = has_next ? nxt.B : cB;
        for (int t = 0; t < nt; t += 2) {
            const bool last = (t == nt - 2);
            const char* a1 = cA + (size_t)(t + 1) * kstep;
            const char* a2 = last ? nA : cA + (size_t)(t + 2) * kstep; const char* b2 = last ? nB : cB + (size_t)(t + 2) * kstep;
            const char* a3 = a2 + kstep; const char* b3 = b2 + kstep;
            PG8_LDB(B0, 0, 0); PG8_LDB(B1, 0, 1); PG8_SCHED; PG8_LDA(At, 0, 0); PG8_STAGE(PG8_SA(1, 1), a1 + hsA, voffA);
            PG8_WAIT_V(8); PG8_WAIT_L(0); PG8_BAR; PG8_MMA(0, 0, At, B0); PG8_MMA(0, 1, At, B1); PG8_BAR; PG8_SCHED;
            PG8_LDA(At, 0, 1); PG8_STAGE(PG8_SB(0, 0), b2, voffB); PG8_STAGE(PG8_SB(0, 1), b2 + hsB, voffB); PG8_STAGE(PG8_SA(0, 0), a2, voffA);
            PG8_WAIT_V(8); PG8_WAIT_L(0); PG8_BAR; PG8_MMA(1, 0, At, B0); PG8_MMA(1, 1, At, B1); PG8_BAR; PG8_SCHED;
            PG8_LDB(B0, 1, 0); PG8_LDB(B1, 1, 1); PG8_SCHED; PG8_LDA(At, 1, 0); PG8_STAGE(PG8_SA(0, 1), a2 + hsA, voffA);
            PG8_WAIT_V(8); PG8_WAIT_L(0); PG8_BAR; PG8_MMA(0, 0, At, B0); PG8_MMA(0, 1, At, B1); PG8_BAR; PG8_SCHED;
            PG8_LDA(At, 1, 1); PG8_STAGE(PG8_SB(1, 0), b3, voffB); PG8_STAGE(PG8_SB(1, 1), b3 + hsB, voffB); PG8_STAGE(PG8_SA(1, 0), a3, voffA);
            PG8_WAIT_V(8); PG8_WAIT_L(0); PG8_BAR; PG8_MMA(1, 0, At, B0); PG8_MMA(1, 1, At, B1); PG8_BAR; PG8_SCHED;
        }
        if (wr == 0) PG8_BAR;
        if constexpr (FP8) asm volatile("s_nop 15\n\ts_nop 15" ::: "memory");
        epilogue(acc, ctl, cur, wr, wc, fr, fq);
        if (!has_next) break;
#pragma unroll
        for (int a = 0; a < 2; ++a)
#pragma unroll
            for (int b = 0; b < 2; ++b)
#pragma unroll
                for (int m = 0; m < 4; ++m)
#pragma unroll
                    for (int n = 0; n < 2; ++n) acc[a][b][m][n] = (f32x4){0.f, 0.f, 0.f, 0.f};
        cur = nxt; cA = nA; cB = nB; ++ui;
        if (wr == 1) PG8_BAR;
    }
    PG8_WAIT_V(0);
    PG8_BAR;
#undef PG8_SA
#undef PG8_SB
#undef PG8_STAGE
#undef PG8_LDA
#undef PG8_LDB
#undef PG8_MMA
#undef PG8_MMA8
#undef PG8_MMA16
#undef PG8_LO
#undef PG8_HI
#undef PG8_WAIT_V
#undef PG8_WAIT_L
#undef PG8_BAR
#undef PG8_SCHED
}
}

__device__ __forceinline__ int cvt_rowmap(int kind, int n) {
    if (kind == 1) { if (n < FF) return 8 * (n >> 2) + (n & 3); const int j = n - FF; return 8 * (j >> 2) + 4 + (j & 3); }
    if (kind == 2) { if (n < D) return n; if (n < 2 * D) { const int j = n - D; return D + 8 * (j >> 2) + (j & 3); } const int j = n - 2 * D; return D + 8 * (j >> 2) + 4 + (j & 3); }
    return n;
}
struct CvtIt { const float* src; bf16_t* dst; int K, N, ldd, kind, k0, n0; };
__device__ __forceinline__ void cvt_decode(LAS const int* ctl, int it, CvtIt& c) {
    const int nj = rfl(ctl[2]);
    int j = 0;
    for (int q = 1; q < nj; ++q) if (it >= rfl(ctl[256 + 16 * q + 11])) j = q;
    LAS const int* jd = ctl + 256 + 16 * j;
    const int loc = it - rfl(jd[11]), ipb = rfl(jd[12]), nNt = rfl(jd[13]);
    const int bat = loc / ipb, rem = loc % ipb, kb = rem / nNt, nb = rem % nNt;
    c.src = (const float*)(((unsigned long long)(unsigned)rfl(jd[1]) << 32) | (unsigned)rfl(jd[0])) + (size_t)bat * (size_t)(unsigned)rfl(jd[9]);
    c.dst = (bf16_t*)(((unsigned long long)(unsigned)rfl(jd[3]) << 32) | (unsigned)rfl(jd[2])) + (size_t)bat * (size_t)(unsigned)rfl(jd[10]);
    c.K = rfl(jd[4]); c.N = rfl(jd[5]); c.ldd = rfl(jd[6]); c.kind = rfl(jd[7]); c.k0 = 64 * kb; c.n0 = 64 * nb;
}
__device__ __forceinline__ void cvt_load(const CvtIt& c, f32x4 (&v)[16], int lane) {
    const int nn = 4 * (lane & 15);
    const int n = (c.n0 + nn) < c.N ? (c.n0 + nn) : (c.N - 4);
#pragma unroll
    for (int i = 0; i < 16; ++i) { const int k_ = c.k0 + 4 * i + (lane >> 4); const int k = k_ < c.K ? k_ : c.K - 1;
        v[i] = *(const f32x4*)(c.src + (size_t)k * c.N + n); }
}
__device__ __forceinline__ void cvt_to_lds(const f32x4 (&v)[16], LAS float* scr, int lane) {
    const int nn = 4 * (lane & 15);
#pragma unroll
    for (int i = 0; i < 16; ++i) { const int kk = 4 * i + (lane >> 4); LAS float* s = scr + kk * 65 + nn; s[0] = v[i][0]; s[1] = v[i][1]; s[2] = v[i][2]; s[3] = v[i][3]; }
    asm volatile("s_waitcnt lgkmcnt(0)" ::: "memory");
}
__device__ __forceinline__ void cvt_store(const CvtIt& ci, LAS const float* scr, int lane) {
    const int c = lane & 7; const int K = ci.K, N = ci.N, ldd = ci.ldd, kind = ci.kind, k0 = ci.k0, n0 = ci.n0; bf16_t* dst = ci.dst;
    if (kind & 0x100) {
        const float sc = (float)(1 << (kind >> 16));
#pragma unroll
        for (int j = 0; j < 8; ++j) { const int nl = (lane >> 3) + 8 * j; const LAS float* s = scr + (8 * c) * 65 + nl;
            int w0 = __builtin_amdgcn_cvt_pk_fp8_f32(s[0] * sc, s[65] * sc, 0, false); w0 = __builtin_amdgcn_cvt_pk_fp8_f32(s[2 * 65] * sc, s[3 * 65] * sc, w0, true);
            int w1 = __builtin_amdgcn_cvt_pk_fp8_f32(s[4 * 65] * sc, s[5 * 65] * sc, 0, false); w1 = __builtin_amdgcn_cvt_pk_fp8_f32(s[6 * 65] * sc, s[7 * 65] * sc, w1, true);
            const int n = n0 + nl, k = k0 + 8 * c;
            if (n < N && k < K) *(u32x2*)((unsigned char*)dst + (size_t)cvt_rowmap(kind & 15, n) * ldd + k) = (u32x2){(unsigned)w0, (unsigned)w1}; }
    } else {
#pragma unroll
        for (int j = 0; j < 8; ++j) { const int nl = (lane >> 3) + 8 * j; const LAS float* s = scr + (8 * c) * 65 + nl;
            u32x4 o; o.x = cvt_pk_bf16_asm(s[0], s[65]); o.y = cvt_pk_bf16_asm(s[2 * 65], s[3 * 65]); o.z = cvt_pk_bf16_asm(s[4 * 65], s[5 * 65]); o.w = cvt_pk_bf16_asm(s[6 * 65], s[7 * 65]);
            const int n = n0 + nl, k = k0 + 8 * c;
            if (n < N && k < K) *(u32x4*)(dst + (size_t)cvt_rowmap(kind & 15, n) * ldd + k) = o; }
    }
    asm volatile("s_waitcnt lgkmcnt(0)" ::: "memory");
}
__device__ __forceinline__ void cvt_set(LAS int* ctl, int j, const float* src, void* dst, int K, int N, int ldd, int kind, int nb, int sstride, int dstride) {
    LAS int* jd = ctl + 256 + 16 * j;
    const unsigned long long a = (unsigned long long)src, b = (unsigned long long)dst;
    jd[0] = (int)(unsigned)a; jd[1] = (int)(unsigned)(a >> 32); jd[2] = (int)(unsigned)b; jd[3] = (int)(unsigned)(b >> 32);
    jd[4] = K; jd[5] = N; jd[6] = ldd; jd[7] = kind; jd[8] = nb; jd[9] = sstride; jd[10] = dstride;
    const int nKt = (K + 63) / 64, nNt = (N + 63) / 64;
    const int i0 = (j == 0) ? 0 : ctl[256 + 16 * (j - 1) + 11] + ctl[256 + 16 * (j - 1) + 12] * ctl[256 + 16 * (j - 1) + 8];
    jd[11] = i0; jd[12] = nKt * nNt; jd[13] = nNt;
    ctl[2] = j + 1; ctl[3] = i0 + nKt * nNt * nb;
}

__device__ __forceinline__ void phase0(const Args& a, LAS unsigned char* lds, int tid, int lane, int wave, int G) {
    unsigned char* ws = a.ws;
    LAS int* ctl = (LAS int*)(lds + CTL_OFF);
    if (tid == 0) {
        cvt_set(ctl, 0, a.in[8], ws + WS_WR, D, D, D, 0, 3, D * D, D * D);
        cvt_set(ctl, 1, a.in[10], ws + WS_WW1, D, 64, D, 0 | 0x100 | (5 << 16), 2, D * 64, 64 * D / 2);
        cvt_set(ctl, 2, a.in[13], ws + WS_WA1, D, 64, D, 0 | 0x100 | (5 << 16), 2, D * 64, 64 * D / 2);
        cvt_set(ctl, 3, a.in[15], ws + WS_WG1, D, 160, D, 0, 1, 0, 0);
        cvt_set(ctl, 4, a.in[11], ws + WS_W2W, 64, D, 64, 0, 2, 64 * D, D * 64);
        cvt_set(ctl, 5, a.in[14], ws + WS_W2A, 64, D, 64, 0, 2, 64 * D, D * 64);
        cvt_set(ctl, 6, a.in[16], ws + WS_W2G, 160, D, 160, 0, 1, 0, 0);
        cvt_set(ctl, 7, a.in[22], ws + WS_WOUT, D, D, D, 0, 1, 0, 0);
        cvt_set(ctl, 8, a.in[26], ws + WS_WGU, D, 2 * FF, D, 1 | 0x100 | (5 << 16), 1, 0, 0);
        cvt_set(ctl, 9, a.in[27], ws + WS_WDN, FF, D, FF, 0 | 0x100 | (6 << 16), 1, 0, 0);
        cvt_set(ctl, 10, a.in[23], ws + WS_WCI, D, 3 * D, D, 2, 1, 0, 0);
        cvt_set(ctl, 11, a.in[25], ws + WS_WCO, D, D, D, 0, 1, 0, 0);
        cvt_set(ctl, 12, a.in[29], ws + WS_MGU, D, 2 * FF, D, 1 | 0x100 | (5 << 16), NE, D * 2 * FF, FF * D);
        cvt_set(ctl, 13, a.in[30], ws + WS_MDN, FF, D, FF, 0 | 0x100 | (6 << 16), NE, FF * D, D * FF / 2);
    }
    if (blockIdx.x == 0 && tid < 64) ((int*)(ws + WS_CTL))[tid] = 0;
    {
        LAS float* s = (LAS float*)lds; LAS float* red = (LAS float*)(lds + 36864);
        for (int u = blockIdx.x; u < 192; u += G) {
            const int layer = u / 96, n0 = (u % 96) * 64;
            for (int idx = tid; idx < 9 * D; idx += NTHREADS) { const int b = idx >> 10, k = idx & 1023; const float cv = b < 8 ? a.in[1][b * D + k] : a.in[3][k]; s[idx] = siluf_(cv); }
            __syncthreads();
            const float* W = a.in[4] + (size_t)layer * D * 6 * D + n0 + lane;
            float acc[9];
#pragma unroll
            for (int b = 0; b < 9; ++b) acc[b] = 0.f;
#pragma unroll 4
            for (int k = 128 * wave; k < 128 * wave + 128; k += 4) {
                const float w0 = W[(size_t)k * 6144], w1 = W[(size_t)(k + 1) * 6144], w2 = W[(size_t)(k + 2) * 6144], w3 = W[(size_t)(k + 3) * 6144];
#pragma unroll
                for (int b = 0; b < 9; ++b) { const f32x4 sv = *(const LAS f32x4*)(s + b * D + k); acc[b] += sv[0] * w0 + sv[1] * w1 + sv[2] * w2 + sv[3] * w3; }
            }
#pragma unroll
            for (int b = 0; b < 9; ++b) red[(wave * 9 + b) * 64 + lane] = acc[b];
            __syncthreads();
            for (int idx = tid; idx < 9 * 64; idx += NTHREADS) { const int b = idx >> 6, l = idx & 63; float t = 0.f;
#pragma unroll
                for (int w = 0; w < 8; ++w) t += red[(w * 9 + b) * 64 + l];
                ((float*)(ws + WS_MODS))[(size_t)(layer * 9 + b) * 6144 + n0 + l] = t + a.in[5][layer * 6144 + n0 + l]; }
            __syncthreads();
        }
    }
    const int gw = blockIdx.x * NWAVES + wave, NGW = G * NWAVES;
    for (int row = gw; row < MT; row += NGW) {
        const float* xr = row < M ? a.in[0] + (size_t)row * D : a.in[2] + (size_t)(row - M) * D;
        float ss = 0.f;
#pragma unroll
        for (int j = 0; j < 4; ++j) { const f32x4 v = ld4(xr + 4 * lane + 256 * j); ss += v[0] * v[0] + v[1] * v[1] + v[2] * v[2] + v[3] * v[3]; }
        ss = wave_sum(ss);
        if (lane == 0) ((float*)(ws + WS_RSTD))[row] = rsqrtf(ss * (1.0f / D) + NORM_EPS);
    }
    {
        const int gt = blockIdx.x * NTHREADS + tid, NGT = G * NTHREADS;
        const u32x4 z = (u32x4){0u, 0u, 0u, 0u};
        for (int i = gt; i < 128 * D / 16; i += NGT) { ((u32x4*)(ws + WS_WW1 + 128 * D))[i] = z; ((u32x4*)(ws + WS_WA1 + 128 * D))[i] = z; }
        for (int i = gt; i < 96 * D / 8; i += NGT) ((u32x4*)(ws + WS_WG1 + 160 * D * 2))[i] = z;
    }
    __syncthreads();
    {
        LAS float* scr = (LAS float*)(lds + wave * 16640);
        const int nitems = rfl(ctl[3]);
        f32x4 v[16]; CvtIt cur, nxt;
        int it = gw;
        if (it < nitems) { cvt_decode(ctl, it, cur); cvt_load(cur, v, lane); }
        for (; it < nitems; it += NGW) {
            cvt_to_lds(v, scr, lane);
            const bool more = it + NGW < nitems;
            if (more) { cvt_decode(ctl, it + NGW, nxt); cvt_load(nxt, v, lane); }
            cvt_store(cur, scr, lane);
            if (more) cur = nxt;
        }
    }
}

__device__ __forceinline__ void phase_mix(const Args& a, int gw, int NGW, int lane) {
    unsigned char* ws = a.ws;
    const float* g = a.in[6];
    const float* mu = a.in[7];
    const float* mods = (const float*)(ws + WS_MODS);
    const float* rstd = (const float*)(ws + WS_RSTD);
    bf16_t* XN = (bf16_t*)(ws + WS_XN);
    const int rpw = (MT + NGW - 1) / NGW;
    const int rbeg = gw * rpw, rend = (rbeg + rpw) < MT ? (rbeg + rpw) : MT;
    float muv[6][2][8], gs[2][8], sh[2][8];
#pragma unroll
    for (int n = 0; n < 6; ++n)
#pragma unroll
        for (int j = 0; j < 2; ++j) { const f32x4 t0 = ld4(mu + n * D + 512 * j + 8 * lane), t1 = ld4(mu + n * D + 512 * j + 8 * lane + 4);
#pragma unroll
            for (int e = 0; e < 4; ++e) { muv[n][j][e] = t0[e]; muv[n][j][4 + e] = t1[e]; } }
    int curb = -1;
    f32x4 ps[2][2], pn_[2][2]; float prs = 0.f, prn[2] = {0.f, 0.f};
#define MIX_LOAD(rowv) do { const int row_ = (rowv); const bool ic_ = row_ >= M; const int r2_ = ic_ ? row_ - M : row_; const int t_ = ic_ ? r2_ % TCX : r2_ % T; \
        const float* base_ = ic_ ? a.in[2] : a.in[0]; prs = rstd[row_]; \
        _Pragma("unroll") for (int j = 0; j < 2; ++j) { int d_; \
            if (!ic_) { const int col = t_ & 63, gr = t_ >> 6, qd = 2 * j + (lane >> 5); \
                d_ = qd == 0 ? (col > 0 ? -1 : 0) : qd == 1 ? (col < 63 ? 1 : 0) : qd == 2 ? (gr > 0 ? -64 : 0) : (gr < 31 ? 64 : 0); \
            } else d_ = j == 0 ? (t_ > 0 ? -1 : 0) : (t_ < TCX - 1 ? 1 : 0); \
            const int c = 512 * j + 8 * lane; const float* p0_ = base_ + (size_t)r2_ * D + c; const float* p1_ = base_ + (size_t)(r2_ + d_) * D + c; \
            ps[j][0] = ld4(p0_); ps[j][1] = ld4(p0_ + 4); pn_[j][0] = ld4(p1_); pn_[j][1] = ld4(p1_ + 4); prn[j] = d_ != 0 ? rstd[row_ + d_] : 0.f; } } while (0)
    if (rbeg < rend) MIX_LOAD(rbeg);
    for (int row = rbeg; row < rend; ++row) {
        const bool isctx = row >= M;
        const int r2 = isctx ? row - M : row;
        const int b = isctx ? r2 / TCX : r2 / T;
        const int mb = isctx ? 8 : b;
        if (mb != curb) { curb = mb; const float* md = mods + (size_t)mb * 6144;
#pragma unroll
            for (int j = 0; j < 2; ++j) { const int c = 512 * j + 8 * lane;
#pragma unroll
                for (int e = 0; e < 8; e += 4) { const f32x4 gv = ld4(g + c + e), shv = ld4(md + c + e), scv = ld4(md + D + c + e);
#pragma unroll
                    for (int i = 0; i < 4; ++i) { gs[j][e + i] = gv[i] * (1.0f + scv[i]); sh[j][e + i] = shv[i]; } } } }
        f32x4 cs[2][2], cn[2][2]; const float rs = prs; float rn[2];
#pragma unroll
        for (int j = 0; j < 2; ++j) { cs[j][0] = ps[j][0]; cs[j][1] = ps[j][1]; cn[j][0] = pn_[j][0]; cn[j][1] = pn_[j][1]; rn[j] = prn[j]; }
        if (row + 1 < rend) MIX_LOAD(row + 1);
#pragma unroll
        for (int j = 0; j < 2; ++j) {
            const int c = 512 * j + 8 * lane;
            const float msk = rn[j] != 0.f ? 1.0f : 0.0f;
            float hs[8], dx[8];
#pragma unroll
            for (int e = 0; e < 8; ++e) { const float xs_ = cs[j][e >> 2][e & 3], xn_ = cn[j][e >> 2][e & 3];
                hs[e] = xs_ * rs * gs[j][e] + sh[j][e];
                const float hn = xn_ * rn[j] * gs[j][e] + sh[j][e] * msk;
                dx[e] = hn - hs[e]; }
#pragma unroll
            for (int n = 0; n < 6; ++n) { float o[8];
#pragma unroll
                for (int e = 0; e < 8; ++e) o[e] = hs[e] + dx[e] * muv[n][j][e];
                if (n == 1 || n == 4) {
                    int w0 = __builtin_amdgcn_cvt_pk_fp8_f32(o[0], o[1], 0, false); w0 = __builtin_amdgcn_cvt_pk_fp8_f32(o[2], o[3], w0, true);
                    int w1 = __builtin_amdgcn_cvt_pk_fp8_f32(o[4], o[5], 0, false); w1 = __builtin_amdgcn_cvt_pk_fp8_f32(o[6], o[7], w1, true);
                    *(u32x2*)((unsigned char*)(XN + (size_t)n * MT * D) + (size_t)row * D + c) = (u32x2){(unsigned)w0, (unsigned)w1};
                } else *(u32x4*)(XN + ((size_t)n * MT + row) * D + c) = pack8(o); }
        }
    }
#undef MIX_LOAD
}

__device__ __forceinline__ void phase_fin(const Args& a, LAS unsigned char* lds, int tid, int lane, int wave, int G) {
    unsigned char* ws = a.ws;
    const int q = lane >> 4, rho = lane & 15;
    const bf16_t* W2W = (const bf16_t*)(ws + WS_W2W); const bf16_t* W2A = (const bf16_t*)(ws + WS_W2A); const bf16_t* W2G = (const bf16_t*)(ws + WS_W2G);
    const bf16_t* L1W = (const bf16_t*)(ws + WS_L1W); const bf16_t* L1A = (const bf16_t*)(ws + WS_L1A); const bf16_t* L1G = (const bf16_t*)(ws + WS_L1G);
    const bf16_t* KR = (const bf16_t*)(ws + WS_KRAW); const bf16_t* RB = (const bf16_t*)(ws + WS_R);
    bf16_t* AT = (bf16_t*)(ws + WS_AT); bf16_t* BT = (bf16_t*)(ws + WS_BT); bf16_t* KT = (bf16_t*)(ws + WS_KT); bf16_t* RT = (bf16_t*)(ws + WS_RT); float* GC = (float*)(ws + WS_GC); bf16_t* GATE = (bf16_t*)(ws + WS_GATE);
    float* BONUS = (float*)(ws + WS_BONUS);
    const int nparts = G / NH;
    {
        const int h = blockIdx.x % NH;
        const int part = blockIdx.x / NH;
        if (part >= nparts) return;
        __syncthreads();
        for (int f = wave; f < 52; f += NWAVES) {
            int mat, p, n, s;
            if (f < 32) { mat = f >> 3; p = (f >> 2) & 1; n = (f >> 1) & 1; s = f & 1; } else { const int r = f - 32; mat = 4; p = r / 10; n = (r % 10) / 5; s = r % 5; }
            const int ch = h * 64 + p * 32 + 8 * (rho >> 2) + 4 * n + (rho & 3), k = 32 * s + 8 * q;
            const bf16_t* src = mat < 2 ? W2W + ((size_t)mat * D + ch) * 64 + k : mat < 4 ? W2A + ((size_t)(mat - 2) * D + ch) * 64 + k : W2G + (size_t)ch * 160 + k;
            *(LAS u32x4*)(lds + f * 1024 + lane * 16) = *(const u32x4*)src;
        }
        LAS float* PRM = (LAS float*)(lds + 53248);
        if (tid < 448) { const int arr = tid >> 6, c = tid & 63;
            PRM[tid] = arr < 2 ? a.in[9][arr * D + h * 64 + c] : arr < 4 ? a.in[12][(arr - 2) * D + h * 64 + c] : arr == 4 ? a.in[17][h * 64 + c] : arr == 5 ? a.in[18][h * 64 + c] : a.in[19][h * 64 + c]; }
        __syncthreads();
        bf16x8 n_tw[2][2], n_ta[2][2], n_tg[5]; u32x4 n_kv[2], n_rv[2];
#define FIN_LOAD(rbv) do { const int trow_ = (rbv) * 128 + wave * 16 + rho; const bool lat_ = ((rbv) * 128) < M; \
            _Pragma("unroll") for (int z = 0; z < 2; ++z) _Pragma("unroll") for (int s_ = 0; s_ < 2; ++s_) { n_tw[z][s_] = *(const bf16x8*)(L1W + (size_t)trow_ * 256 + z * 64 + 32 * s_ + 8 * q); n_ta[z][s_] = *(const bf16x8*)(L1A + (size_t)trow_ * 256 + z * 64 + 32 * s_ + 8 * q); } \
            if (lat_) { _Pragma("unroll") for (int s_ = 0; s_ < 5; ++s_) n_tg[s_] = *(const bf16x8*)(L1G + (size_t)trow_ * 256 + 32 * s_ + 8 * q); } \
            const size_t hb_ = ((size_t)(hm_row(trow_) + h * NPOS)) * 64; \
            _Pragma("unroll") for (int p_ = 0; p_ < 2; ++p_) { n_kv[p_] = *(const u32x4*)(KR + hb_ + p_ * 32 + 8 * q); if (lat_) n_rv[p_] = *(const u32x4*)(RB + hb_ + p_ * 32 + 8 * q); } } while (0)
        if (part < MT / 128) FIN_LOAD(part);
        for (int rb = part; rb < MT / 128; rb += nparts) {
            const int trow = rb * 128 + wave * 16 + rho;
            const bool lat = (rb * 128) < M;
            f32x4 aw[2][2][2], aa[2][2][2]; u32x4 gpk[2];
#pragma unroll
            for (int p = 0; p < 2; ++p)
#pragma unroll
                for (int n = 0; n < 2; ++n) {
#pragma unroll
                    for (int z = 0; z < 2; ++z) { aw[p][z][n] = (f32x4){0.f, 0.f, 0.f, 0.f}; aa[p][z][n] = (f32x4){0.f, 0.f, 0.f, 0.f};
#pragma unroll
                        for (int s = 0; s < 2; ++s) {
                            const bf16x8 fw = *(const LAS bf16x8*)(lds + ((z) * 8 + p * 4 + n * 2 + s) * 1024 + lane * 16);
                            const bf16x8 fa = *(const LAS bf16x8*)(lds + ((2 + z) * 8 + p * 4 + n * 2 + s) * 1024 + lane * 16);
                            aw[p][z][n] = __builtin_amdgcn_mfma_f32_16x16x32_bf16(fw, n_tw[z][s], aw[p][z][n], 0, 0, 0);
                            aa[p][z][n] = __builtin_amdgcn_mfma_f32_16x16x32_bf16(fa, n_ta[z][s], aa[p][z][n], 0, 0, 0); } }
                    if (lat) {
                        f32x4 ag = (f32x4){0.f, 0.f, 0.f, 0.f};
#pragma unroll
                        for (int s = 0; s < 5; ++s) { const bf16x8 fg = *(const LAS bf16x8*)(lds + (32 + p * 10 + n * 5 + s) * 1024 + lane * 16);
                            ag = __builtin_amdgcn_mfma_f32_16x16x32_bf16(fg, n_tg[s], ag, 0, 0, 0); }
                        if (n == 0) { gpk[p].x = cvt_pk_bf16(ag[0], ag[1]); gpk[p].y = cvt_pk_bf16(ag[2], ag[3]); } else { gpk[p].z = cvt_pk_bf16(ag[0], ag[1]); gpk[p].w = cvt_pk_bf16(ag[2], ag[3]); }
                    }
                }
            const u32x4 c_kv0 = n_kv[0], c_kv1 = n_kv[1], c_rv0 = n_rv[0], c_rv1 = n_rv[1];
            asm volatile("" :: "v"(c_kv0), "v"(c_kv1), "v"(c_rv0), "v"(c_rv1));
            if (rb + nparts < MT / 128) FIN_LOAD(rb + nparts);
            const int hr = hm_row(trow), bb = hr / (NH * NPOS), pos = hr - bb * (NH * NPOS);
            const size_t hbase = ((size_t)(hr + h * NPOS)) * 64;
            float ssq = 0.f, bon = 0.f;
#pragma unroll
            for (int p = 0; p < 2; ++p) { float kvt[8]; unpack8(p ? c_kv1 : c_kv0, kvt);
#pragma unroll
                for (int e = 0; e < 8; ++e) { const float kr = kvt[e] * PRM[4 * 64 + p * 32 + 8 * q + e]; ssq += kr * kr; } }
            ssq += __shfl_xor(ssq, 16); ssq += __shfl_xor(ssq, 32);
            const float inv = rsqrtf(fmaxf(ssq, 1e-24f));
#pragma unroll
            for (int p = 0; p < 2; ++p) {
                const int cl = p * 32 + 8 * q, cb = h * 64 + cl;
                const LAS float* pp = PRM + cl;
                float kv[8], rv[8], kds[8];
                unpack8(p ? c_kv1 : c_kv0, kv);
                if (lat) unpack8(p ? c_rv1 : c_rv0, rv); else { for (int e = 0; e < 8; ++e) rv[e] = 0.f; }
#pragma unroll
                for (int e = 0; e < 8; ++e) kds[e] = 0.f;
#pragma unroll
                for (int z = 0; z < 2; ++z) {
                    float oA[8], oB[8], oK[8], oR[8], gc[8];
#pragma unroll
                    for (int e = 0; e < 8; ++e) {
                        const int n = e >> 2, i = e & 3;
                        const float dl = -0.60653066f * sigmoidf_(aw[p][z][n][i] + pp[z * 64 + e]);
                        const float ic = sigmoidf_(aa[p][z][n][i] + pp[(2 + z) * 64 + e]);
                        float cum = dl, epv;
                        if (z == 0) { cum += dpp_mov<0x111>(cum); cum += dpp_mov<0x112>(cum); cum += dpp_mov<0x114>(cum); cum += dpp_mov<0x118>(cum); }
                        else        { cum += dpp_mov<0x101>(cum); cum += dpp_mov<0x102>(cum); cum += dpp_mov<0x104>(cum); cum += dpp_mov<0x108>(cum); }
                        const float ec = __builtin_amdgcn_exp2f(cum * 1.44269504f), en = __builtin_amdgcn_rcpf(ec);
                        if (z == 0) { epv = dpp_mov<0x111>(ec); if (rho == 0) epv = 1.0f; } else { epv = dpp_mov<0x101>(ec); if (rho == 15) epv = 1.0f; }
                        const float kk = kv[e] * pp[4 * 64 + e] * inv, bq = kk * ic, kd = kv[e] * (1.0f + (ic - 1.0f) * pp[5 * 64 + e]);
                        oA[e] = -kk * epv; oB[e] = bq * en; oK[e] = kd * en; oR[e] = rv[e] * ec; gc[e] = ec; kds[e] += kd;
                    }
                    *(u32x4*)(AT + (size_t)z * HMA + hbase + cl) = pack8(oA); *(u32x4*)(BT + (size_t)z * HMA + hbase + cl) = pack8(oB);
                    *(u32x4*)(KT + (size_t)z * HMA + hbase + cl) = pack8(oK); *(u32x4*)(RT + (size_t)z * HMA + hbase + cl) = pack8(oR);
                    if (rho == (z == 0 ? 15 : 0)) { float* gp = GC + (((size_t)z * NB * NH + bb * NH + h) * NCHK + (pos >> 4)) * 64 + cl;
                        *(f32x4*)gp = (f32x4){gc[0], gc[1], gc[2], gc[3]}; *(f32x4*)(gp + 4) = (f32x4){gc[4], gc[5], gc[6], gc[7]}; }
                }
                if (lat) {
#pragma unroll
                    for (int e = 0; e < 8; ++e) bon += rv[e] * 0.5f * kds[e] * pp[6 * 64 + e];
                    *(u32x4*)(GATE + (size_t)trow * D + cb) = gpk[p];
                }
            }
            if (lat) { bon += __shfl_xor(bon, 16); bon += __shfl_xor(bon, 32); if (q == 0) BONUS[(size_t)trow * NH + h] = bon; }
        }
    }
}

#undef FIN_LOAD
typedef unsigned short u16;
typedef short s16x4 __attribute__((ext_vector_type(4)));
constexpr int SC_PITCHB = 144;
constexpr int SET_R = 0, SET_P = 2304, SET_BH = 4608, SET_KH = 6912, SET_V = 9216, SET_TLM = 11520, SET_G = 13312, SET_BYTES = 13568;
constexpr int TLM_PITCHB = 112;
constexpr int SCR_OFF = 8 * SET_BYTES, SCR_BYTES = 2304;
static_assert(SCR_OFF + 4 * SCR_BYTES <= CTL_OFF, "scan LDS map");

__device__ __forceinline__ f32x4 mfma16(u32x4 a, u32x4 b, f32x4 c) {
    return __builtin_amdgcn_mfma_f32_16x16x32_bf16(__builtin_bit_cast(bf16x8, a), __builtin_bit_cast(bf16x8, b), c, 0, 0, 0);
}
__device__ __forceinline__ u32x4 opnd(f32x4 d) { u32x4 w; w.x = cvt_pk_bf16(d[0], d[1]); w.y = cvt_pk_bf16(d[2], d[3]); w.z = 0u; w.w = 0u; return w; }
__device__ __forceinline__ unsigned tr_addr(unsigned matbase, int pitchb, int r0, int c0, int rho) { return matbase + (unsigned)((r0 + (rho >> 2)) * pitchb + (c0 + 4 * (rho & 3)) * 2); }

__device__ __forceinline__ int scan_row(int b, int dir, int s) {
    if (s < TCX) return M + b * TCX + (dir ? (TCX - 1 - s) : s);
    const int u = s - TCX; return b * T + (dir ? (T - 1 - u) : u);
}

__device__ __forceinline__ void scan_produce_tail(LAS unsigned char* set, LAS unsigned char* scr, int rho, int q) {
                asm volatile("s_waitcnt lgkmcnt(0)" ::: "memory");
                u32x4 fA[2], fB[2], fK[2], fR[2];
#pragma unroll
                for (int ks = 0; ks < 2; ++ks) { const int fo = rho * SC_PITCHB + (32 * ks + 8 * q) * 2;
                    fA[ks] = *(const LAS u32x4*)(scr + fo); fB[ks] = *(const LAS u32x4*)(set + SET_BH + fo); fK[ks] = *(const LAS u32x4*)(set + SET_KH + fo); fR[ks] = *(const LAS u32x4*)(set + SET_R + fo); }
                const f32x4 z4 = (f32x4){0.f, 0.f, 0.f, 0.f};
                f32x4 Lt = mfma16(fB[1], fA[1], mfma16(fB[0], fA[0], z4));
                f32x4 L  = mfma16(fA[1], fB[1], mfma16(fA[0], fB[0], z4));
                f32x4 Lk = mfma16(fA[1], fK[1], mfma16(fA[0], fK[0], z4));
                f32x4 Mb = mfma16(fB[1], fR[1], mfma16(fB[0], fR[0], z4));
                f32x4 Mk = mfma16(fK[1], fR[1], mfma16(fK[0], fR[0], z4));
                f32x4 Tt;
#pragma unroll
                for (int r = 0; r < 4; ++r) { const int rr_ = 4 * q + r;
                    Lt[r] = rr_ < rho ? Lt[r] : 0.f; Mb[r] = rr_ <= rho ? Mb[r] : 0.f; Mk[r] = rr_ <= rho ? Mk[r] : 0.f;
                    L[r] = rho < rr_ ? L[r] : 0.f; Lk[r] = rho < rr_ ? Lk[r] : 0.f;
                    Tt[r] = Lt[r] + (rr_ == rho ? 1.0f : 0.f); }
                { u32x2 w; w.x = cvt_pk_bf16(Mb[0], Mb[1]); w.y = cvt_pk_bf16(Mb[2], Mb[3]); *(LAS u32x2*)(set + SET_TLM + rho * TLM_PITCHB + (16 + 4 * q) * 2) = w;
                  w.x = cvt_pk_bf16(Mk[0], Mk[1]); w.y = cvt_pk_bf16(Mk[2], Mk[3]); *(LAS u32x2*)(set + SET_TLM + rho * TLM_PITCHB + (32 + 4 * q) * 2) = w; }
                const u32x4 oL = opnd(L), oLt = opnd(Lt);
                f32x4 X = mfma16(oLt, oL, z4), Xt = mfma16(oL, oLt, z4);
                u32x4 oX = opnd(X), oXt = opnd(Xt);
                Tt = mfma16(oX, opnd(Tt), Tt);
                X = mfma16(oXt, oX, z4); Xt = mfma16(oX, oXt, z4);
                oX = opnd(X); oXt = opnd(Xt);
                Tt = mfma16(oX, opnd(Tt), Tt);
                X = mfma16(oXt, oX, z4);
                oX = opnd(X);
                Tt = mfma16(oX, opnd(Tt), Tt);
                const u32x4 oT = opnd(Tt);
                { const f32x4 tl = mfma16(opnd(Lk), oT, z4);
                  u32x2 w; w.x = cvt_pk_bf16(tl[0], tl[1]); w.y = cvt_pk_bf16(tl[2], tl[3]); *(LAS u32x2*)(set + SET_TLM + rho * TLM_PITCHB + (4 * q) * 2) = w; }
                {
                    const LAS unsigned char* ab = scr + (4 * q + (rho >> 2)) * SC_PITCHB + (4 * (rho & 3)) * 2;
                    const u32x2 t0 = __builtin_bit_cast(u32x2, __builtin_amdgcn_ds_read_tr16_b64_v4i16((LAS s16x4*)(ab))), t1 = __builtin_bit_cast(u32x2, __builtin_amdgcn_ds_read_tr16_b64_v4i16((LAS s16x4*)(ab + 32))),
                                t2 = __builtin_bit_cast(u32x2, __builtin_amdgcn_ds_read_tr16_b64_v4i16((LAS s16x4*)(ab + 64))), t3 = __builtin_bit_cast(u32x2, __builtin_amdgcn_ds_read_tr16_b64_v4i16((LAS s16x4*)(ab + 96)));
                    const f32x4 p0 = mfma16((u32x4){t0.x, t0.y, 0u, 0u}, oT, z4), p1 = mfma16((u32x4){t1.x, t1.y, 0u, 0u}, oT, z4);
                    const f32x4 p2 = mfma16((u32x4){t2.x, t2.y, 0u, 0u}, oT, z4), p3 = mfma16((u32x4){t3.x, t3.y, 0u, 0u}, oT, z4);
                    LAS unsigned char* pr = set + SET_P + rho * SC_PITCHB + (4 * q) * 2;
                    u32x2 w;
                    w.x = cvt_pk_bf16(p0[0], p0[1]); w.y = cvt_pk_bf16(p0[2], p0[3]); *(LAS u32x2*)(pr + 0) = w;
                    w.x = cvt_pk_bf16(p1[0], p1[1]); w.y = cvt_pk_bf16(p1[2], p1[3]); *(LAS u32x2*)(pr + 32) = w;
                    w.x = cvt_pk_bf16(p2[0], p2[1]); w.y = cvt_pk_bf16(p2[2], p2[3]); *(LAS u32x2*)(pr + 64) = w;
                    w.x = cvt_pk_bf16(p3[0], p3[1]); w.y = cvt_pk_bf16(p3[2], p3[3]); *(LAS u32x2*)(pr + 96) = w;
                }
                asm volatile("s_waitcnt lgkmcnt(0)" ::: "memory");
}

constexpr int WF_OFF = SCR_OFF + 8 * 2304, GF_OFF = WF_OFF + 16384, PRM_OFF = GF_OFF + 10240, FLG_OFF = PRM_OFF + 5 * 64 * 4;
static_assert(FLG_OFF + 64 <= CTL_OFF, "fused scan LDS map");
template <int DIR>
__device__ __forceinline__ void scan_producer(const Args& a, LAS unsigned char* lds, int lane, int p, int b, int h) {
    unsigned char* ws = a.ws;
    const int rho = lane & 15, q = lane >> 4, nr0 = lane >> 3, cc = lane & 7, bh = b * NH + h;
    constexpr int NR = NCHK / 4;
    const LAS float* PRM = (const LAS float*)(lds + PRM_OFF);
    const bf16_t* L1W = (const bf16_t*)(ws + WS_L1W); const bf16_t* L1A = (const bf16_t*)(ws + WS_L1A); const bf16_t* L1G = (const bf16_t*)(ws + WS_L1G);
    const bf16_t* KR = (const bf16_t*)(ws + WS_KRAW); const bf16_t* RB = (const bf16_t*)(ws + WS_R); const bf16_t* VB = (const bf16_t*)(ws + WS_V);
    bf16_t* GATE = (bf16_t*)(ws + WS_GATE); float* BON = (float*)(ws + (DIR ? WS_BONUS1 : WS_BONUS));
    bf16x8 n_tw[2], n_ta[2], n_tg[5]; u32x4 n_kv[2], n_rv[2], n_vv[2];
#define FS_NATC(chv) (DIR ? ((chv) < TCX / 16 ? TCX / 16 - 1 - (chv) : NCHK + TCX / 16 - 1 - (chv)) : (chv))
#define FS_TROW(natc) ((natc) < TCX / 16 ? M + b * TCX + 16 * (natc) + rho : b * T + 16 * (natc) - TCX + rho)
#define FS_LOAD_A(chv) do { const int natc_ = FS_NATC(chv); const bool lat_ = natc_ >= TCX / 16; const int trow_ = FS_TROW(natc_); \
        _Pragma("unroll") for (int s_ = 0; s_ < 2; ++s_) { n_tw[s_] = *(const bf16x8*)(L1W + (size_t)trow_ * 256 + DIR * 64 + 32 * s_ + 8 * q); n_ta[s_] = *(const bf16x8*)(L1A + (size_t)trow_ * 256 + DIR * 64 + 32 * s_ + 8 * q); } \
        { const int trg_ = lat_ ? trow_ : rho; _Pragma("unroll") for (int s_ = 0; s_ < 5; ++s_) n_tg[s_] = *(const bf16x8*)(L1G + (size_t)trg_ * 256 + 32 * s_ + 8 * q); } } while (0)
#define FS_LOAD_B(chv) do { const int natc_ = FS_NATC(chv); \
        const size_t hb_ = ((size_t)bh * NPOS + 16 * natc_ + rho) * 64; \
        _Pragma("unroll") for (int p_ = 0; p_ < 2; ++p_) { n_kv[p_] = *(const u32x4*)(KR + hb_ + p_ * 32 + 8 * q); n_rv[p_] = *(const u32x4*)(RB + hb_ + p_ * 32 + 8 * q); } \
        const size_t vo_ = ((size_t)bh * NPOS + 16 * natc_ + nr0) * 64 + 8 * cc; \
        n_vv[0] = *(const u32x4*)(VB + vo_); n_vv[1] = *(const u32x4*)(VB + vo_ + 512); } while (0)
    FS_LOAD_A(p); FS_LOAD_B(p);
    for (int n = 0; n < NR; ++n) {
        const int ch = 4 * n + p, natc = FS_NATC(ch); const bool lat = natc >= TCX / 16; const int trow = FS_TROW(natc);
        LAS unsigned char* set = lds + ((n & 1) * 4 + p) * SET_BYTES;
        LAS unsigned char* scr = lds + SCR_OFF + ((n & 1) * 4 + p) * 2304;
        f32x4 aw[2][2], aa[2][2]; u32x4 gpk = (u32x4){0u, 0u, 0u, 0u};
#pragma unroll
        for (int pp = 0; pp < 2; ++pp)
#pragma unroll
            for (int nn = 0; nn < 2; ++nn) { aw[pp][nn] = (f32x4){0.f, 0.f, 0.f, 0.f}; aa[pp][nn] = (f32x4){0.f, 0.f, 0.f, 0.f};
#pragma unroll
                for (int s = 0; s < 2; ++s) {
                    const bf16x8 fw = *(const LAS bf16x8*)(lds + WF_OFF + (pp * 4 + nn * 2 + s) * 1024 + lane * 16);
                    const bf16x8 fa = *(const LAS bf16x8*)(lds + WF_OFF + (8 + pp * 4 + nn * 2 + s) * 1024 + lane * 16);
                    aw[pp][nn] = __builtin_amdgcn_mfma_f32_16x16x32_bf16(fw, n_tw[s], aw[pp][nn], 0, 0, 0);
                    aa[pp][nn] = __builtin_amdgcn_mfma_f32_16x16x32_bf16(fa, n_ta[s], aa[pp][nn], 0, 0, 0); } }
        if (lat) {
#pragma unroll
            for (int nn = 0; nn < 2; ++nn) { f32x4 ag = (f32x4){0.f, 0.f, 0.f, 0.f};
#pragma unroll
                for (int s = 0; s < 5; ++s) { const bf16x8 fg = *(const LAS bf16x8*)(lds + GF_OFF + (nn * 5 + s) * 1024 + lane * 16);
                    ag = __builtin_amdgcn_mfma_f32_16x16x32_bf16(fg, n_tg[s], ag, 0, 0, 0); }
                if (nn == 0) { gpk.x = cvt_pk_bf16(ag[0], ag[1]); gpk.y = cvt_pk_bf16(ag[2], ag[3]); } else { gpk.z = cvt_pk_bf16(ag[0], ag[1]); gpk.w = cvt_pk_bf16(ag[2], ag[3]); } }
        }
        const int chn = n + 1 < NR ? ch + 4 : ch;
        FS_LOAD_A(chn);
        float ssq = 0.f, bon = 0.f;
#pragma unroll
        for (int pp = 0; pp < 2; ++pp) { float kvt[8]; unpack8(pp ? n_kv[1] : n_kv[0], kvt);
#pragma unroll
            for (int e = 0; e < 8; ++e) { const float kr = kvt[e] * PRM[2 * 64 + pp * 32 + 8 * q + e]; ssq += kr * kr; } }
        ssq += __shfl_xor(ssq, 16); ssq += __shfl_xor(ssq, 32);
        const float inv = rsqrtf(fmaxf(ssq, 1e-24f));
        const int tau = DIR ? 15 - rho : rho;
#pragma unroll
        for (int pp = 0; pp < 2; ++pp) {
            const int cl = pp * 32 + 8 * q;
            const LAS float* pr = PRM + cl;
            float kv[8], rv[8], oA[8], oB[8], oK[8], oR[8], gc[8];
            unpack8(pp ? n_kv[1] : n_kv[0], kv);
            if (lat) unpack8(pp ? n_rv[1] : n_rv[0], rv); else { for (int e = 0; e < 8; ++e) rv[e] = 0.f; }
#pragma unroll
            for (int e = 0; e < 8; ++e) {
                const int nn = e >> 2, i = e & 3;
                const float dl = -0.60653066f * sigmoidf_(aw[pp][nn][i] + pr[e]);
                const float ic = sigmoidf_(aa[pp][nn][i] + pr[64 + e]);
                float cum = dl, epv;
                if (DIR == 0) { cum += dpp_mov<0x111>(cum); cum += dpp_mov<0x112>(cum); cum += dpp_mov<0x114>(cum); cum += dpp_mov<0x118>(cum); }
                else          { cum += dpp_mov<0x101>(cum); cum += dpp_mov<0x102>(cum); cum += dpp_mov<0x104>(cum); cum += dpp_mov<0x108>(cum); }
                const float ec = __builtin_amdgcn_exp2f(cum * 1.44269504f), en = __builtin_amdgcn_rcpf(ec);
                if (DIR == 0) { epv = dpp_mov<0x111>(ec); if (rho == 0) epv = 1.0f; } else { epv = dpp_mov<0x101>(ec); if (rho == 15) epv = 1.0f; }
                const float kk = kv[e] * pr[2 * 64 + e] * inv, bq = kk * ic, kd = kv[e] * (1.0f + (ic - 1.0f) * pr[3 * 64 + e]);
                oA[e] = -kk * epv; oB[e] = bq * en; oK[e] = kd * en; oR[e] = rv[e] * ec; gc[e] = ec;
                bon += rv[e] * 0.5f * kd * pr[4 * 64 + e];
            }
            const int ro = tau * SC_PITCHB + cl * 2;
            *(LAS u32x4*)(scr + ro) = pack8v(oA); *(LAS u32x4*)(set + SET_BH + ro) = pack8v(oB); *(LAS u32x4*)(set + SET_KH + ro) = pack8v(oK); *(LAS u32x4*)(set + SET_R + ro) = pack8v(oR);
            if (rho == (DIR ? 0 : 15)) { *(LAS f32x4*)(set + SET_G + cl * 4) = (f32x4){gc[0], gc[1], gc[2], gc[3]}; *(LAS f32x4*)(set + SET_G + cl * 4 + 16) = (f32x4){gc[4], gc[5], gc[6], gc[7]}; }
            asm volatile("" ::: "memory");
        }
        { const int t0 = DIR ? 15 - nr0 : nr0, t1 = DIR ? 7 - nr0 : nr0 + 8;
          *(LAS u32x4*)(set + SET_V + t0 * SC_PITCHB + 16 * cc) = n_vv[0]; *(LAS u32x4*)(set + SET_V + t1 * SC_PITCHB + 16 * cc) = n_vv[1]; }
        FS_LOAD_B(chn);
        {
            bf16_t* gd = lat ? GATE + (size_t)trow * D + h * 64 + DIR * 32 + 8 * q : (bf16_t*)(ws + WS_DUMP) + 8 * lane;
            *(u32x4*)gd = gpk;
            bon += __shfl_xor(bon, 16); bon += __shfl_xor(bon, 32);
            float* bd = (lat && q == 0) ? BON + (size_t)trow * NH + h : (float*)(ws + WS_DUMP + 1024) + lane;
            *bd = bon;
        }
        asm volatile("s_waitcnt lgkmcnt(0)" ::: "memory");
        __syncthreads();
    }
#undef FS_LOAD_A
#undef FS_LOAD_B
#undef FS_TROW
#undef FS_NATC
}

__device__ __forceinline__ void phase_scan_chunked(const Args& a, LAS unsigned char* lds, int tid, int lane, int wave, int G) {
    unsigned char* ws = a.ws;
    const bf16_t* VB = (const bf16_t*)(ws + WS_V);
    const int rho = lane & 15, q = lane >> 4;
    const unsigned ldsb = (unsigned)(size_t)lds;
    constexpr int NCH = NPOS / 16, NR = NCH / 4;
    for (int unit = blockIdx.x; unit < 2 * NB * NH; unit += G) {
        const int b = unit & 7, h = (unit >> 3) & 15, dir = unit >> 7, bh = b * NH + h;
        bf16_t* Yout = (bf16_t*)(ws + (dir ? WS_YB : WS_YF));
        __syncthreads();
        {
            const bf16_t* W2W = (const bf16_t*)(ws + WS_W2W); const bf16_t* W2A = (const bf16_t*)(ws + WS_W2A); const bf16_t* W2G = (const bf16_t*)(ws + WS_W2G);
            for (int f = wave; f < 26; f += NWAVES) {
                const bf16_t* src;
                if (f < 16) { const int mat = f >> 3, pp = (f >> 2) & 1, nn = (f >> 1) & 1, sx = f & 1; const int chn = h * 64 + pp * 32 + 8 * (rho >> 2) + 4 * nn + (rho & 3);
                    src = (mat ? W2A : W2W) + ((size_t)dir * D + chn) * 64 + 32 * sx + 8 * q; }
                else { const int r = f - 16, nn = r / 5, sx = r % 5; const int chn = h * 64 + dir * 32 + 8 * (rho >> 2) + 4 * nn + (rho & 3); src = W2G + (size_t)chn * 160 + 32 * sx + 8 * q; }
                *(LAS u32x4*)(lds + WF_OFF + f * 1024 + lane * 16) = *(const u32x4*)src;
            }
            if (tid < 4) ((LAS int*)(lds + FLG_OFF))[tid] = 0;
            if (tid < 320) { const int arr = tid >> 6, c = tid & 63;
                ((LAS float*)(lds + PRM_OFF))[tid] = arr == 0 ? a.in[9][dir * D + h * 64 + c] : arr == 1 ? a.in[12][dir * D + h * 64 + c] : arr == 2 ? a.in[17][h * 64 + c] : arr == 3 ? a.in[18][h * 64 + c] : a.in[19][h * 64 + c]; }
            __syncthreads();
        }
        if (wave >= 4) {
            if (dir == 0) scan_producer<0>(a, lds, lane, wave - 4, b, h); else scan_producer<1>(a, lds, lane, wave - 4, b, h);
            __syncthreads();
        } else {
            f32x4 S[4];
#pragma unroll
            for (int jb = 0; jb < 4; ++jb) S[jb] = (f32x4){0.f, 0.f, 0.f, 0.f};
            const f32x4 z4 = (f32x4){0.f, 0.f, 0.f, 0.f};
            const int trb = (4 * q + (rho >> 2)) * SC_PITCHB + (4 * (rho & 3)) * 2;
            const int rowb = rho * SC_PITCHB + (4 * q) * 2, tlmb = SET_TLM + rho * TLM_PITCHB + (4 * q) * 2;
#define TRRD(p) __builtin_bit_cast(u32x2, __builtin_amdgcn_ds_read_tr16_b64_v4i16((LAS s16x4*)(p)))
#define C_LOAD(X, st) \
            LAS unsigned char* const X##bptr = (st); \
            const u32x2 X##tv = TRRD((st) + SET_V + trb + 32 * wave); \
            const u32x2 X##tb0 = TRRD((st) + SET_BH + trb), X##tb1 = TRRD((st) + SET_BH + trb + 32), X##tb2 = TRRD((st) + SET_BH + trb + 64), X##tb3 = TRRD((st) + SET_BH + trb + 96); \
            const u32x2 X##tk0 = TRRD((st) + SET_KH + trb), X##tk1 = TRRD((st) + SET_KH + trb + 32), X##tk2 = TRRD((st) + SET_KH + trb + 64), X##tk3 = TRRD((st) + SET_KH + trb + 96); \
            const u32x2 X##pa = *(const LAS u32x2*)((st) + SET_P + rowb), X##pb = *(const LAS u32x2*)((st) + SET_P + rowb + 32), X##pc = *(const LAS u32x2*)((st) + SET_P + rowb + 64), X##pd = *(const LAS u32x2*)((st) + SET_P + rowb + 96); \
            const u32x2 X##tl = *(const LAS u32x2*)((st) + tlmb);
#define C_COMPUTE(X, chv) do { const int ch_ = (chv); \
            const f32x4 X##g0 = *(const LAS f32x4*)(X##bptr + SET_G + 16 * q), X##g1 = *(const LAS f32x4*)(X##bptr + SET_G + 16 * q + 64), X##g2 = *(const LAS f32x4*)(X##bptr + SET_G + 16 * q + 128), X##g3 = *(const LAS f32x4*)(X##bptr + SET_G + 16 * q + 192); \
            u32x4 bs0, bs1; \
            bs0.x = cvt_pk_bf16(S[0][0], S[0][1]); bs0.y = cvt_pk_bf16(S[0][2], S[0][3]); bs0.z = cvt_pk_bf16(S[1][0], S[1][1]); bs0.w = cvt_pk_bf16(S[1][2], S[1][3]); \
            bs1.x = cvt_pk_bf16(S[2][0], S[2][1]); bs1.y = cvt_pk_bf16(S[2][2], S[2][3]); bs1.z = cvt_pk_bf16(S[3][0], S[3][1]); bs1.w = cvt_pk_bf16(S[3][2], S[3][3]); \
            f32x4 U = mfma16((u32x4){X##tl.x, X##tl.y, 0u, 0u}, (u32x4){X##tv.x, X##tv.y, 0u, 0u}, z4); \
            U = mfma16((u32x4){X##pa.x, X##pa.y, X##pb.x, X##pb.y}, bs0, U); \
            U = mfma16((u32x4){X##pc.x, X##pc.y, X##pd.x, X##pd.y}, bs1, U); \
            u32x4 buv; buv.x = cvt_pk_bf16(U[0], U[1]); buv.y = cvt_pk_bf16(U[2], U[3]); buv.z = X##tv.x; buv.w = X##tv.y; \
            S[0] = mfma16((u32x4){X##tb0.x, X##tb0.y, X##tk0.x, X##tk0.y}, buv, S[0]) * X##g0; \
            S[1] = mfma16((u32x4){X##tb1.x, X##tb1.y, X##tk1.x, X##tk1.y}, buv, S[1]) * X##g1; \
            S[2] = mfma16((u32x4){X##tb2.x, X##tb2.y, X##tk2.x, X##tk2.y}, buv, S[2]) * X##g2; \
            S[3] = mfma16((u32x4){X##tb3.x, X##tb3.y, X##tk3.x, X##tk3.y}, buv, S[3]) * X##g3; \
            if (ch_ >= TCX / 16) { \
                const u32x2 X##ra = *(const LAS u32x2*)(X##bptr + SET_R + rowb), X##rb = *(const LAS u32x2*)(X##bptr + SET_R + rowb + 32), X##rc = *(const LAS u32x2*)(X##bptr + SET_R + rowb + 64), X##rd = *(const LAS u32x2*)(X##bptr + SET_R + rowb + 96); \
                const u32x2 X##mrb = *(const LAS u32x2*)(X##bptr + tlmb + 32), X##mrk = *(const LAS u32x2*)(X##bptr + tlmb + 64); \
                f32x4 Yv = mfma16((u32x4){X##ra.x, X##ra.y, X##rb.x, X##rb.y}, bs0, z4); \
                Yv = mfma16((u32x4){X##rc.x, X##rc.y, X##rd.x, X##rd.y}, bs1, Yv); \
                Yv = mfma16((u32x4){X##mrb.x, X##mrb.y, X##mrk.x, X##mrk.y}, buv, Yv); \
                _Pragma("unroll") for (int r = 0; r < 4; ++r) { const int row = scan_row(b, dir, 16 * ch_ + 4 * q + r); \
                    Yout[(size_t)row * D + h * 64 + 16 * wave + rho] = (bf16_t)(cvt_pk_bf16(Yv[r], 0.f) & 0xffffu); } } } while (0)
            volatile LAS int* flg = (volatile LAS int*)(lds + FLG_OFF);
            __syncthreads();
            for (int n = 1; n <= NR; ++n) {
                LAS unsigned char* sbase = lds + (((n - 1) & 1) * 4) * SET_BYTES;
                const int ch0 = 4 * (n - 1);
                scan_produce_tail(sbase + wave * SET_BYTES, lds + SCR_OFF + (((n - 1) & 1) * 4 + wave) * 2304, rho, q);
                asm volatile("s_waitcnt lgkmcnt(0)" ::: "memory");
                if (lane == 0) flg[wave] = n;
                asm volatile("s_waitcnt lgkmcnt(0)" ::: "memory");
#define C_WAIT(c) do { while (flg[(c)] < n) __builtin_amdgcn_s_sleep(1); asm volatile("" ::: "memory"); } while (0)
#pragma unroll 1
                for (int cc = 0; cc < 4; ++cc) { C_WAIT(cc); { C_LOAD(a_, sbase + cc * SET_BYTES) C_COMPUTE(a_, ch0 + cc); } }
                __syncthreads();
            }
#undef C_WAIT
#undef C_LOAD
#undef C_COMPUTE
#undef TRRD
        }
    }
}

__device__ __forceinline__ void phase_readout(const Args& a, int gw, int NGW, int lane) {
    unsigned char* ws = a.ws;
    const bf16_t* YF = (const bf16_t*)(ws + WS_YF); const bf16_t* YB = (const bf16_t*)(ws + WS_YB); const bf16_t* VB = (const bf16_t*)(ws + WS_V); const bf16_t* GATE = (const bf16_t*)(ws + WS_GATE);
    const float* BONUS = (const float*)(ws + WS_BONUS); const float* BONUS1 = (const float*)(ws + WS_BONUS1); bf16_t* OG = (bf16_t*)(ws + WS_OG);
    float lw[16], lb[16];
#pragma unroll
    for (int e = 0; e < 16; e += 4) { const f32x4 w4 = ld4(a.in[20] + 16 * lane + e), b4 = ld4(a.in[21] + 16 * lane + e);
#pragma unroll
        for (int i = 0; i < 4; ++i) { lw[e + i] = w4[i]; lb[e + i] = b4[i]; } }
    u32x4 pyf[2], pyb[2], pv[2], pg[2]; float pbon = 0.f;
#define RO_LOAD(rowv) do { const int row_ = (rowv); const size_t off_ = (size_t)row_ * D + 16 * lane; \
        const size_t vo_ = ((size_t)(hm_row(row_) + (lane >> 2) * NPOS)) * 64 + 16 * (lane & 3); \
        pyf[0] = *(const u32x4*)(YF + off_); pyf[1] = *(const u32x4*)(YF + off_ + 8); pyb[0] = *(const u32x4*)(YB + off_); pyb[1] = *(const u32x4*)(YB + off_ + 8); \
        pv[0] = *(const u32x4*)(VB + vo_); pv[1] = *(const u32x4*)(VB + vo_ + 8); pg[0] = *(const u32x4*)(GATE + off_); pg[1] = *(const u32x4*)(GATE + off_ + 8); \
        pbon = BONUS[(size_t)row_ * NH + (lane >> 2)] + BONUS1[(size_t)row_ * NH + (lane >> 2)]; } while (0)
    if (gw < M) RO_LOAD(gw);
    for (int row = gw; row < M; row += NGW) {
        const size_t off = (size_t)row * D + 16 * lane;
        float y[16], t8[8], vv[16], gg[16], o[16];
        unpack8(pyf[0], y); unpack8(pyf[1], y + 8);
        unpack8(pyb[0], t8);
#pragma unroll
        for (int e = 0; e < 8; ++e) y[e] += t8[e];
        unpack8(pyb[1], t8);
#pragma unroll
        for (int e = 0; e < 8; ++e) y[8 + e] += t8[e];
        unpack8(pv[0], vv); unpack8(pv[1], vv + 8); unpack8(pg[0], gg); unpack8(pg[1], gg + 8);
        const float bon = pbon;
        if (row + NGW < M) RO_LOAD(row + NGW);
        float sm = 0.f;
#pragma unroll
        for (int e = 0; e < 16; ++e) sm += y[e];
        sm += __shfl_xor(sm, 1); sm += __shfl_xor(sm, 2);
        const float mean = sm * (1.0f / 64.0f);
        float vr = 0.f;
#pragma unroll
        for (int e = 0; e < 16; ++e) { y[e] -= mean; vr += y[e] * y[e]; }
        vr += __shfl_xor(vr, 1); vr += __shfl_xor(vr, 2);
        const float rs = rsqrtf(vr * (1.0f / 64.0f) + GN_EPS);
#pragma unroll
        for (int e = 0; e < 16; ++e) o[e] = (y[e] * rs * lw[e] + lb[e] + bon * vv[e]) * gg[e];
        *(u32x4*)(OG + off) = pack8(o); *(u32x4*)(OG + off + 8) = pack8(o + 8);
    }
#undef RO_LOAD
}

template <int MODE>
__device__ __forceinline__ void phase_rowpass(const Args& a, LAS unsigned char* lds, int tid, int lane, int wave, int G) {
    unsigned char* ws = a.ws;
    const float* mods = (const float*)(ws + WS_MODS);
    const float* ng = a.in[6];
    const bf16_t* Y0 = (const bf16_t*)(ws + WS_Y0); bf16_t* XR = (bf16_t*)(ws + WS_XR); bf16_t* HB = (bf16_t*)(ws + WS_HB);
    const bf16_t* YS = (const bf16_t*)(ws + WS_YS);
    const int lpost = MODE < 2 ? 0 : 1, gtoff = (MODE == 0 || MODE == 2) ? 2048 : 5120, gpost = (MODE == 0 || MODE == 2) ? 1 : 3;
    const int lpre = MODE == 0 ? 0 : 1, gpre = MODE == 0 ? 2 : (MODE == 1 ? 0 : 2), shoff = MODE == 1 ? 0 : 3072, scoff = MODE == 1 ? 1024 : 4096;
    LAS int* lcnt = (LAS int*)lds;
    LAS int* linfo = (LAS int*)(lds + 256);
    LAS float* lwr = (LAS float*)(lds + 4096);
    int* CNT = (int*)(ws + WS_CTL);
    if (MODE == 2) {
        if (tid < 16) lcnt[tid] = 0;
        for (int i = tid; i < D * NE / 4; i += NTHREADS) *(LAS f32x4*)(lwr + 4 * i) = ld4(a.in[28] + 4 * i);
        __syncthreads();
    }
    const int rpb = (M + G - 1) / G;
    const int r0 = blockIdx.x * rpb, r1 = (r0 + rpb) < M ? (r0 + rpb) : M;
    const int nrw = (r1 - r0 - wave + NWAVES - 1) / NWAVES;
    const int bt = r0 / T;
    const float* mdp = mods + (size_t)(lpost * 9 + bt) * 6144;
    const float* mdn = mods + (size_t)(lpre * 9 + bt) * 6144;
    f32x4 cgt[4], cgp[4], cgn[4], csh[4];
#pragma unroll
    for (int j = 0; j < 4; ++j) { const int c = 4 * lane + 256 * j;
        cgt[j] = ld4(mdp + gtoff + c) * ld4(ng + (lpost * 4 + gpost) * D + c);
        if (MODE != 3) { cgn[j] = ld4(ng + (lpre * 4 + gpre) * D + c) * (1.0f + ld4(mdn + scoff + c)); csh[j] = ld4(mdn + shoff + c); } }
    int sl1 = 0, sl2 = 0; float gg1 = 0.f, gg2 = 0.f;
    if (MODE == 3) {
        int pst[NE]; int acc = 0;
#pragma unroll
        for (int e = 0; e < NE; ++e) { pst[e] = acc; acc += (CNT[e] + 255) & ~255; }
        if (lane < nrw) { const int row = r0 + wave + NWAVES * lane;
            const int* TP = (const int*)(ws + WS_TPOS); const int* TE = (const int*)(ws + WS_TOPE); const float* TG = (const float*)(ws + WS_TOPG);
            const int e1 = TE[2 * row], e2 = TE[2 * row + 1]; sl1 = TP[2 * row]; sl2 = TP[2 * row + 1];
#pragma unroll
            for (int e = 0; e < NE; ++e) { if (e == e1) sl1 += pst[e]; if (e == e2) sl2 += pst[e]; }
            gg1 = TG[2 * row]; gg2 = TG[2 * row + 1]; }
    }
    u32x2 pf[4], pf2[4], pxb[4]; f32x4 pxf[4];
#define RP_LOAD(k) do { const int row_ = r0 + wave + NWAVES * (k); \
        if (MODE == 3) { const int s1_ = __builtin_amdgcn_readlane(sl1, (k)), s2_ = __builtin_amdgcn_readlane(sl2, (k)); \
            _Pragma("unroll") for (int j = 0; j < 4; ++j) { pf[j] = *(const u32x2*)(YS + (size_t)s1_ * D + 4 * lane + 256 * j); pf2[j] = *(const u32x2*)(YS + (size_t)s2_ * D + 4 * lane + 256 * j); } } \
        else { _Pragma("unroll") for (int j = 0; j < 4; ++j) pf[j] = *(const u32x2*)(Y0 + (size_t)row_ * D + 4 * lane + 256 * j); } \
        if (MODE == 0) { _Pragma("unroll") for (int j = 0; j < 4; ++j) pxf[j] = ld4(a.in[0] + (size_t)row_ * D + 4 * lane + 256 * j); } \
        else { _Pragma("unroll") for (int j = 0; j < 4; ++j) pxb[j] = *(const u32x2*)(XR + (size_t)row_ * D + 4 * lane + 256 * j); } } while (0)
    if (nrw > 0) RP_LOAD(0);
    for (int k = 0; k < nrw; ++k) {
        const int row = r0 + wave + NWAVES * k;
        f32x4 f[4], xr[4];
#pragma unroll
        for (int j = 0; j < 4; ++j) { float y1[4]; unpack4(pf[j], y1);
            if (MODE == 3) { float y2[4]; unpack4(pf2[j], y2);
                const float g1 = __builtin_bit_cast(float, __builtin_amdgcn_readlane(__builtin_bit_cast(int, gg1), k)), g2 = __builtin_bit_cast(float, __builtin_amdgcn_readlane(__builtin_bit_cast(int, gg2), k));
                f[j] = (f32x4){g1 * y1[0] + g2 * y2[0], g1 * y1[1] + g2 * y2[1], g1 * y1[2] + g2 * y2[2], g1 * y1[3] + g2 * y2[3]}; }
            else f[j] = (f32x4){y1[0], y1[1], y1[2], y1[3]};
            if (MODE == 0) xr[j] = pxf[j]; else { float x1[4]; unpack4(pxb[j], x1); xr[j] = (f32x4){x1[0], x1[1], x1[2], x1[3]}; } }
        if (k + 1 < nrw) RP_LOAD(k + 1);
        float ss = 0.f;
#pragma unroll
        for (int j = 0; j < 4; ++j) ss += f[j][0] * f[j][0] + f[j][1] * f[j][1] + f[j][2] * f[j][2] + f[j][3] * f[j][3];
        ss = wave_sum(ss);
        const float rs = rsqrtf(ss * (1.0f / D) + NORM_EPS);
        float ss2 = 0.f;
#pragma unroll
        for (int j = 0; j < 4; ++j) {
            xr[j] = xr[j] + cgt[j] * (f[j] * rs);
            ss2 += xr[j][0] * xr[j][0] + xr[j][1] * xr[j][1] + xr[j][2] * xr[j][2] + xr[j][3] * xr[j][3]; }
        if (MODE == 3) {
#pragma unroll
            for (int j = 0; j < 4; ++j) *(f32x4*)(a.out + (size_t)row * D + 4 * lane + 256 * j) = xr[j];
            continue;
        }
#pragma unroll
        for (int j = 0; j < 4; ++j) { u32x2 w; w.x = cvt_pk_bf16_asm(xr[j][0], xr[j][1]); w.y = cvt_pk_bf16_asm(xr[j][2], xr[j][3]); *(u32x2*)(XR + (size_t)row * D + 4 * lane + 256 * j) = w; }
        ss2 = wave_sum(ss2);
        const float rs2 = rsqrtf(ss2 * (1.0f / D) + NORM_EPS);
        float lg[NE];
#pragma unroll
        for (int e = 0; e < NE; ++e) lg[e] = 0.f;
#pragma unroll
        for (int j = 0; j < 4; ++j) { const int c = 4 * lane + 256 * j;
            const f32x4 hv = xr[j] * rs2 * cgn[j] + csh[j];
            if (MODE == 1) { u32x2 w; w.x = cvt_pk_bf16_asm(hv[0], hv[1]); w.y = cvt_pk_bf16_asm(hv[2], hv[3]); *(u32x2*)(HB + (size_t)row * D + c) = w; }
            else { int w = __builtin_amdgcn_cvt_pk_fp8_f32(hv[0], hv[1], 0, false); w = __builtin_amdgcn_cvt_pk_fp8_f32(hv[2], hv[3], w, true);
                if (MODE == 0) *(int*)((unsigned char*)HB + (size_t)row * D + c) = w; else *(LAS int*)(lds + 40960 + (row - r0) * D + c) = w; }
            if (MODE == 2) {
                const LAS float* wr = lwr + (size_t)c * NE;
#pragma unroll
                for (int i = 0; i < 4; ++i) { const f32x4 wa = *(const LAS f32x4*)(wr + i * NE), wb = *(const LAS f32x4*)(wr + i * NE + 4);
                    lg[0] += hv[i] * wa[0]; lg[1] += hv[i] * wa[1]; lg[2] += hv[i] * wa[2]; lg[3] += hv[i] * wa[3];
                    lg[4] += hv[i] * wb[0]; lg[5] += hv[i] * wb[1]; lg[6] += hv[i] * wb[2]; lg[7] += hv[i] * wb[3]; }
            }
        }
        if (MODE == 2) {
#pragma unroll
            for (int e = 0; e < NE; ++e) lg[e] = wave_sum(lg[e]);
            if (lane == 0) {
                int e1 = 0; float v1 = lg[0];
#pragma unroll
                for (int e = 1; e < NE; ++e) if (lg[e] > v1) { v1 = lg[e]; e1 = e; }
                int e2 = -1; float v2 = -3.0e38f;
#pragma unroll
                for (int e = 0; e < NE; ++e) if (e != e1 && lg[e] > v2) { v2 = lg[e]; e2 = e; }
                const float g1 = 1.0f / (1.0f + __expf(v2 - v1));
                ((int*)(ws + WS_TOPE))[2 * row] = e1; ((int*)(ws + WS_TOPE))[2 * row + 1] = e2;
                ((float*)(ws + WS_TOPG))[2 * row] = g1; ((float*)(ws + WS_TOPG))[2 * row + 1] = 1.0f - g1;
                const int p1 = atomicAdd((int*)(lcnt + e1), 1), p2 = atomicAdd((int*)(lcnt + e2), 1);
                const int lr = row - r0;
                linfo[4 * lr] = e1; linfo[4 * lr + 1] = e2; linfo[4 * lr + 2] = p1; linfo[4 * lr + 3] = p2;
            }
        }
    }
#undef RP_LOAD
    if (MODE == 2) {
        __syncthreads();
        if (tid < NE) lcnt[8 + tid] = atomicAdd(CNT + tid, lcnt[tid]);
        __syncthreads();
        int* TP = (int*)(ws + WS_TPOS);
        for (int lr = tid; lr < r1 - r0; lr += NTHREADS) {
            const int e1 = linfo[4 * lr], e2 = linfo[4 * lr + 1];
            TP[2 * (r0 + lr)] = lcnt[8 + e1] + linfo[4 * lr + 2]; TP[2 * (r0 + lr) + 1] = lcnt[8 + e2] + linfo[4 * lr + 3];
        }
        unsigned char* XS = ws + WS_XS;
        for (int pr = wave; pr < 2 * (r1 - r0); pr += NWAVES) { const int lr = pr >> 1, k = pr & 1;
            const int e = linfo[4 * lr + k], pos = lcnt[8 + e] + linfo[4 * lr + 2 + k];
            *(u32x4*)(XS + ((size_t)e * M + pos) * D + 16 * lane) = *(const LAS u32x4*)(lds + 40960 + lr * D + 16 * lane); }
    }
}

__device__ __forceinline__ void phase_conv(const Args& a, int tid, int G) {
    unsigned char* ws = a.ws;
    const bf16_t* BG = (const bf16_t*)(ws + WS_BG); const bf16_t* Z = (const bf16_t*)(ws + WS_Z); bf16_t* CV = (bf16_t*)(ws + WS_CV);
    const float* cw = a.in[24];
    const int gt = blockIdx.x * NTHREADS + tid, NGT = G * NTHREADS;
    const int c = (gt & 127) * 8;
    float w0[8], w1[8], w2[8];
#pragma unroll
    for (int e = 0; e < 8; ++e) { w0[e] = cw[c + e]; w1[e] = cw[D + c + e]; w2[e] = cw[2 * D + c + e]; }
    u32x4 pz, pp, pn, pb;
#define CV_LOAD(idxv) do { const int row_ = (idxv) >> 7, t_ = row_ % T; \
        pz = *(const u32x4*)(Z + (size_t)row_ * D + c); pb = *(const u32x4*)(BG + (size_t)row_ * D + c); \
        pp = *(const u32x4*)(Z + (size_t)(row_ - (t_ > 0 ? 1 : 0)) * D + c); pn = *(const u32x4*)(Z + (size_t)(row_ + (t_ < T - 1 ? 1 : 0)) * D + c); } while (0)
    if (gt < M * (D / 8)) CV_LOAD(gt);
    for (int idx = gt; idx < M * (D / 8); idx += NGT) {
        const int row = idx >> 7, t = row % T;
        float zc[8], zp[8], zn[8], bg[8], o[8];
        unpack8(pz, zc); unpack8(pb, bg); unpack8(pp, zp); unpack8(pn, zn);
        if (idx + NGT < M * (D / 8)) CV_LOAD(idx + NGT);
        const float mp = t > 0 ? 1.f : 0.f, mn = t < T - 1 ? 1.f : 0.f;
#pragma unroll
        for (int e = 0; e < 8; ++e) o[e] = bg[e] * (zp[e] * (w0[e] * mp) + zc[e] * w1[e] + zn[e] * (w2[e] * mn));
        *(u32x4*)(CV + (size_t)row * D + c) = pack8(o);
    }
#undef CV_LOAD
}

__device__ __forceinline__ void phase_gather(const Args& a, int gw, int NGW, int lane) {
    unsigned char* ws = a.ws;
    const int* CNT = (const int*)(ws + WS_CTL); const int* TE = (const int*)(ws + WS_TOPE); const int* TP = (const int*)(ws + WS_TPOS);
    const bf16_t* HB = (const bf16_t*)(ws + WS_HB); bf16_t* XS = (bf16_t*)(ws + WS_XS);
    int pst[NE]; { int acc = 0;
#pragma unroll
        for (int e = 0; e < NE; ++e) { pst[e] = acc; acc += (CNT[e] + 255) & ~255; } }
    for (int pr = gw; pr < 2 * M; pr += NGW) {
        const int e = TE[pr]; int slot = TP[pr];
#pragma unroll
        for (int q = 0; q < NE; ++q) if (q == e) slot += pst[q];
        const u32x4* src = (const u32x4*)((const unsigned char*)HB + (size_t)(pr >> 1) * D); u32x4* dst = (u32x4*)((unsigned char*)XS + (size_t)slot * D);
        dst[lane] = src[lane];
    }
}

#define XB_TMO      128
#define XB_XCNT(j)  (256  + 64 * (j))
#define XB_XSUB(j)  (1280 + 64 * (j))
#define XB_XGEN(j)  (2304 + 64 * (j))
#define XB_TOP      3328
#define XB_TOPGEN   3392
#define XCD_BAR_WORDS 3456
#define XB_SPIN_CAP (1u << 20)
__device__ __forceinline__ unsigned xb_ld(unsigned* p)              { return __hip_atomic_load(p, __ATOMIC_RELAXED, __HIP_MEMORY_SCOPE_AGENT); }
__device__ __forceinline__ unsigned xb_add(unsigned* p, unsigned v) { return __hip_atomic_fetch_add(p, v, __ATOMIC_RELAXED, __HIP_MEMORY_SCOPE_AGENT); }
__device__ __forceinline__ unsigned xb_xcc_id() { return (unsigned)__builtin_amdgcn_s_getreg((3 << 11) | 20) & 0xFu; }
#define XB_SPIN(cond, bar) do { unsigned _sp = 0; while (cond) { __builtin_amdgcn_s_sleep(1); \
    if ((++_sp & 255u) == 0u) { if (xb_ld(&(bar)[XB_TMO])) break; if (_sp > XB_SPIN_CAP) { atomicAdd(&(bar)[XB_TMO], 1u); break; } } } } while (0)
struct XcdBarrier { unsigned* bar; unsigned x, rank; volatile LAS unsigned* st; };
__device__ __forceinline__ void xb_st(unsigned* p, unsigned v) { __hip_atomic_store(p, v, __ATOMIC_RELAXED, __HIP_MEMORY_SCOPE_AGENT); }
__device__ __forceinline__ XcdBarrier xcd_barrier_post(unsigned* bar, volatile LAS unsigned* st) {
    XcdBarrier b; b.bar = bar; b.x = xb_xcc_id(); b.st = st; b.rank = 0u;
    if (threadIdx.x == 0) b.rank = xb_add(&bar[XB_XCNT(b.x)], 1u);
    b.rank = (unsigned)__builtin_amdgcn_readfirstlane((int)b.rank);
    return b;
}
__device__ __forceinline__ void xcd_barrier_complete(unsigned* bar, unsigned x, unsigned& nloc, unsigned& mask) {
    const unsigned G = gridDim.x * gridDim.y * gridDim.z;
    unsigned sum, mk, mine, sp = 0u;
    for (;;) {
        sum = 0u; mk = 0u; mine = 0u;
#pragma unroll
        for (unsigned j = 0; j < 16; ++j) { const unsigned c = xb_ld(&bar[XB_XCNT(j)]); sum += c; mk |= (c > 0u) ? (1u << j) : 0u; mine = (j == x) ? c : mine; }
        if (sum == G) break;
        __builtin_amdgcn_s_sleep(1);
        if ((++sp & 255u) == 0u) { if (xb_ld(&bar[XB_TMO])) break; if (sp > XB_SPIN_CAP) { atomicAdd(&bar[XB_TMO], 1u); break; } }
    }
    nloc = mine > 0u ? mine : 1u; mask = mk;
}
__device__ __forceinline__ void xcd_barrier(const XcdBarrier& b) {
    asm volatile("s_waitcnt vmcnt(0)" ::: "memory");
    __syncthreads();
    if (threadIdx.x < 64) {
        const unsigned lane = threadIdx.x;
        unsigned* bar = b.bar;
        if (b.st[0] == 0u) { if (lane == 0) { unsigned nl, mk; xcd_barrier_complete(bar, b.x, nl, mk); b.st[0] = nl; b.st[1] = mk; } }
        const unsigned nloc = b.st[0], mask = b.st[1], gen = b.st[2] + 1u;
        if (lane == 0) b.st[2] = gen;
        if (b.rank != 0u) { if (lane == 0) xb_st(&bar[XB_XSUB(b.x) + b.rank], gen); }
        else {
            for (unsigned base = 0; base < nloc; base += 64u) {
                const unsigned r = base + lane; unsigned sp = 0u;
                for (;;) {
                    const unsigned v = (r > 0u && r < nloc) ? xb_ld(&bar[XB_XSUB(b.x) + r]) : gen;
                    if (__builtin_amdgcn_ballot_w64((int)(v - gen) < 0) == 0ull) break;
                    __builtin_amdgcn_s_sleep(1);
                    if ((++sp & 255u) == 0u) { if (xb_ld(&bar[XB_TMO])) break; if (sp > XB_SPIN_CAP) { if (lane == 0) atomicAdd(&bar[XB_TMO], 1u); break; } }
                }
            }
            __builtin_amdgcn_fence(__ATOMIC_RELEASE, "agent");
            asm volatile("s_waitcnt vmcnt(0)" ::: "memory");
            if (lane == 0) xb_st(&bar[XB_TOP + b.x], gen);
        }
        { unsigned sp = 0u;
          for (;;) {
              const unsigned v = (lane < 16u && ((mask >> lane) & 1u)) ? xb_ld(&bar[XB_TOP + lane]) : gen;
              if (__builtin_amdgcn_ballot_w64((int)(v - gen) < 0) == 0ull) break;
              __builtin_amdgcn_s_sleep(1);
              if ((++sp & 255u) == 0u) { if (xb_ld(&bar[XB_TMO])) break; if (sp > XB_SPIN_CAP) { if (lane == 0) atomicAdd(&bar[XB_TMO], 1u); break; } }
          } }
        __builtin_amdgcn_fence(__ATOMIC_ACQUIRE, "agent");
        asm volatile("s_waitcnt vmcnt(0)" ::: "memory");
    }
    __syncthreads();
}

__global__ void __launch_bounds__(NTHREADS, 2) mk_fwd(Args args) {
    extern __shared__ __attribute__((aligned(16))) unsigned char lds_raw[];
    LAS unsigned char* lds = (LAS unsigned char*)lds_raw;
    LAS int* ctl = (LAS int*)(lds + CTL_OFF);
    const int tid = threadIdx.x, lane = tid & 63, wave = __builtin_amdgcn_readfirstlane(tid >> 6);
    const int G = gridDim.x;
    const int gw = blockIdx.x * NWAVES + wave, NGW = G * NWAVES;
    unsigned char* ws = args.ws;
    const int lo = args.ph_lo, hi = args.ph_hi;
    if (tid < 16) ((LAS unsigned*)(lds + CTL_OFF + 4096))[tid] = 0u;
    __syncthreads();
    XcdBarrier xbar; xbar.bar = (unsigned*)(ws + WS_CTL + 4096); xbar.x = 0; xbar.st = (volatile LAS unsigned*)(lds + CTL_OFF + 4096);
    if (blockIdx.x == 0) { for (int i = tid; i < XCD_BAR_WORDS; i += NTHREADS) ((unsigned*)(ws + WS_CTL + 4096))[i] = 0u; }
#ifndef PH_MASK
#define PH_MASK 0x7ffff
#endif
#define PH_ON(k) ((PH_MASK >> (k)) & 1)
#define IN(k) (PH_ON(k) && lo <= (k) && (k) < hi)
#ifndef REP_MASK
#define REP_MASK 0
#endif
#define PHASE(k, ...) if (IN(k)) { __VA_ARGS__ if ((REP_MASK >> (k)) & 1) { __syncthreads(); __VA_ARGS__ } }
#ifndef XB_REP
#define XB_REP 1
#endif
#ifndef CG_SEAM_MASK
#define CG_SEAM_MASK 0x1
#endif
#define SEAM(k) do { if (lo <= (k) && (k) + 1 < hi) { if ((CG_SEAM_MASK >> (k)) & 1) cg::this_grid().sync(); else { for (int _s = 0; _s < XB_REP; ++_s) xcd_barrier(xbar); } } } while (0)
#define RUN_GEMM(KK, LDA, LDB) do { __syncthreads(); pg8::gemm_phase<false>(lds, ctl, (KK), (LDA), (LDB), G, (int)blockIdx.x); } while (0)
#define RUN_GEMM8(KK, LDA, LDB, SW, SA) do { __syncthreads(); pg8::gemm_phase<true>(lds, ctl, (KK) / 2, (LDA) / 2, (LDB) / 2, G, (int)blockIdx.x, (SW), (SA)); } while (0)
    PHASE(0,  phase0(args, lds, tid, lane, wave, G); ) SEAM(0);
    xbar = xcd_barrier_post((unsigned*)(ws + WS_CTL + 4096), (volatile LAS unsigned*)(lds + CTL_OFF + 4096));
    PHASE(1,  phase_mix(args, gw, NGW, lane); ) SEAM(1);
    PHASE(2,
        if (tid == 0) {
            const bf16_t* XN = (const bf16_t*)(ws + WS_XN);
            pg8::set_job(ctl, 0, XN + (size_t)0 * MT * D, ws + WS_WR, ws + WS_R, M / 256, 4, pg8::EPI_BF16_HM, D, 0);
            pg8::set_job(ctl, 1, XN + (size_t)2 * MT * D, ws + WS_WK, ws + WS_KRAW, MT / 256, 4, pg8::EPI_BF16_HM, D, 0);
            pg8::set_job(ctl, 2, XN + (size_t)3 * MT * D, ws + WS_WV, ws + WS_V, MT / 256, 4, pg8::EPI_BF16_HM, D, 0);
            pg8::set_job(ctl, 3, XN + (size_t)5 * MT * D, ws + WS_WG1, ws + WS_L1G, M / 256, 1, pg8::EPI_BF16, 256, 2);
        }
        RUN_GEMM(D, D, D);
        __syncthreads();
        if (tid == 0) { const bf16_t* XN = (const bf16_t*)(ws + WS_XN); ctl[0] = 0; ctl[1] = 0;
            pg8::set_job(ctl, 0, XN + (size_t)1 * MT * D, ws + WS_WW1, ws + WS_L1W, MT / 256, 1, pg8::EPI_BF16, 256, 1);
            pg8::set_job(ctl, 1, XN + (size_t)4 * MT * D, ws + WS_WA1, ws + WS_L1A, MT / 256, 1, pg8::EPI_BF16, 256, 0); }
        __syncthreads();
        if ((int)blockIdx.x >= G / 2) pg8::gemm_phase<true>(lds, ctl, D / 2, D / 2, D / 2, G - G / 2, (int)blockIdx.x - G / 2, 127 - 5, 127);
    ) SEAM(2);
    PHASE(4,  phase_scan_chunked(args, lds, tid, lane, wave, G); ) SEAM(4);
    PHASE(5,  phase_readout(args, gw, NGW, lane); ) SEAM(5);
    PHASE(6,  if (tid == 0) pg8::set_job(ctl, 0, ws + WS_OG, ws + WS_WOUT, ws + WS_Y0, M / 256, 4, pg8::EPI_BF16, D, 0); RUN_GEMM(D, D, D); ) SEAM(6);
    PHASE(7,  phase_rowpass<0>(args, lds, tid, lane, wave, G); ) SEAM(7);
    PHASE(8,  if (tid == 0) pg8::set_job(ctl, 0, ws + WS_HB, ws + WS_WGU, ws + WS_ACT, M / 256, 2 * FF / 256, pg8::EPI_SWIGLU8, FF, 0); RUN_GEMM8(D, D, D, 127 - 5, 127); ) SEAM(8);
    PHASE(9,  if (tid == 0) pg8::set_job(ctl, 0, ws + WS_ACT, ws + WS_WDN, ws + WS_Y0, M / 256, 4, pg8::EPI_BF16, D, 0); RUN_GEMM8(FF, FF, FF, 127 - 6, 127 - 2); ) SEAM(9);
    PHASE(10,  phase_rowpass<1>(args, lds, tid, lane, wave, G); ) SEAM(10);
    PHASE(11,
        if (tid == 0) {
            pg8::set_job(ctl, 0, ws + WS_HB, ws + WS_WCI, ws + WS_BG, M / 256, 4, pg8::EPI_BF16, D, 0);
            pg8::set_job(ctl, 1, ws + WS_HB, ws + WS_WCI + (size_t)D * D * 2, ws + WS_Z, M / 256, 8, pg8::EPI_MUL, D, 0);
        }
        RUN_GEMM(D, D, D);
    ) SEAM(11);
    PHASE(12,  phase_conv(args, tid, G); ) SEAM(12);
    PHASE(13,  if (tid == 0) pg8::set_job(ctl, 0, ws + WS_CV, ws + WS_WCO, ws + WS_Y0, M / 256, 4, pg8::EPI_BF16, D, 0); RUN_GEMM(D, D, D); ) SEAM(13);
    PHASE(14,  phase_rowpass<2>(args, lds, tid, lane, wave, G); ) SEAM(14);
    PHASE(16,
        if (tid == 0) { const int* CNT = (const int*)(ws + WS_CTL); int ps = 0, j = 0; ctl[0] = 0; ctl[1] = 0;
            for (int e = 0; e < NE; ++e) { const int nM = (CNT[e] + 255) >> 8;
                if (nM > 0) { pg8::set_job(ctl, j, ws + WS_XS + (size_t)e * M * D, ws + WS_MGU + (size_t)e * 2 * FF * D, ws + WS_MACT + (size_t)ps * FF, nM, 2 * FF / 256, pg8::EPI_SWIGLU8, FF, 0); ++j; }
                ps += nM * 256; } }
        RUN_GEMM8(D, D, D, 127 - 5, 127);
    ) SEAM(16);
    PHASE(17,
        if (tid == 0) { const int* CNT = (const int*)(ws + WS_CTL); int ps = 0, j = 0; ctl[0] = 0; ctl[1] = 0;
            for (int e = 0; e < NE; ++e) { const int nM = (CNT[e] + 255) >> 8;
                if (nM > 0) { pg8::set_job(ctl, j, ws + WS_MACT + (size_t)ps * FF, ws + WS_MDN + (size_t)e * D * FF, ws + WS_YS + (size_t)ps * D * 2, nM, 4, pg8::EPI_BF16, D, 0); ++j; }
                ps += nM * 256; } }
        RUN_GEMM8(FF, FF, FF, 127 - 6, 127 - 2);
    ) SEAM(17);
    PHASE(18,  phase_rowpass<3>(args, lds, tid, lane, wave, G); )
}

extern "C" void kernel_launch(void* const* d_in, const int* in_sizes, int n_in, void* d_out, int out_size, void* d_ws, size_t ws_size, hipStream_t stream) {
    static int grid = 0;
    if (grid == 0) {
        int dev = 0, cus = 0, per_cu = 0;
        if (n_in != 31 || ws_size < WS_END) { fprintf(stderr, "kernel_launch: unexpected n_in %d or ws_size %zu (< %zu)\n", n_in, ws_size, (size_t)WS_END); grid = -1; return; }
        hipGetDevice(&dev);
        hipDeviceGetAttribute(&cus, hipDeviceAttributeMultiprocessorCount, dev);
        if (hipFuncSetAttribute((const void*)mk_fwd, hipFuncAttributeMaxDynamicSharedMemorySize, LDS_BYTES) != hipSuccess) { fprintf(stderr, "kernel_launch: hipFuncSetAttribute failed\n"); grid = -1; return; }
        if (hipOccupancyMaxActiveBlocksPerMultiprocessor(&per_cu, (const void*)mk_fwd, NTHREADS, LDS_BYTES) != hipSuccess || per_cu < 1) { fprintf(stderr, "kernel_launch: occupancy query says %d\n", per_cu); per_cu = 1; }
        (void)hipGetLastError();
        grid = cus;
        fprintf(stderr, "kernel_launch: cus %d per_cu %d grid %d ws %zu\n", cus, per_cu, grid, ws_size);
    }
    if (grid < 0) return;
    Args a{};
    for (int i = 0; i < 31; ++i) a.in[i] = (const float*)d_in[i];
    a.out = (float*)d_out; a.ws = (unsigned char*)d_ws;
#if MK_ONE_LAUNCH
    a.ph_lo = 0; a.ph_hi = NPH;
    void* kargs[] = {&a};
    hipError_t e = hipLaunchCooperativeKernel((const void*)mk_fwd, dim3(grid), dim3(NTHREADS), kargs, LDS_BYTES, stream);
    if (e != hipSuccess) fprintf(stderr, "cooperative launch failed: %s (grid %d)\n", hipGetErrorString(e), grid);
#else
    for (int p = 0; p < NPH; ++p) {
        a.ph_lo = p; a.ph_hi = p + 1;
        hipLaunchKernelGGL(mk_fwd, dim3(grid), dim3(NTHREADS), LDS_BYTES, stream, a);
    }
#endif
}
```

```cpp
#include <hip/hip_runtime.h>
#include <hip/hip_cooperative_groups.h>
#include <cstdio>
#include <cstdint>
namespace cg = cooperative_groups;

#ifndef MK_ONE_LAUNCH
#define MK_ONE_LAUNCH 1
#endif

#define LAS __attribute__((address_space(3)))
typedef unsigned short bf16_t;
typedef short bf16x8 __attribute__((ext_vector_type(8)));
typedef float f32x4 __attribute__((ext_vector_type(4)));
typedef float f32x2 __attribute__((ext_vector_type(2)));
typedef unsigned u32x4 __attribute__((ext_vector_type(4)));
typedef unsigned u32x2 __attribute__((ext_vector_type(2)));
typedef int i32x8 __attribute__((ext_vector_type(8)));
typedef int i32x4 __attribute__((ext_vector_type(4)));

constexpr int D = 1024, NB = 8, T = 2048, TCX = 256, M = NB * T, MC = NB * TCX, MT = M + MC, NH = 16, HS = 64, FF = 3584, NE = 8;
constexpr float NORM_EPS = 1e-6f, GN_EPS = 64e-5f;
constexpr int NPH = 19;

constexpr size_t MiB = 1u << 20;
constexpr size_t WS_WR = 0, WS_WK = 2 * MiB, WS_WV = 4 * MiB, WS_WW1 = 6 * MiB, WS_WA1 = 6 * MiB + 512 * 1024, WS_WG1 = 7 * MiB;
constexpr size_t WS_W2W = 7 * MiB + 512 * 1024, WS_W2A = WS_W2W + 256 * 1024, WS_W2G = 8 * MiB;
constexpr size_t WS_WOUT = 9 * MiB, WS_WGU = 11 * MiB, WS_WDN = 25 * MiB, WS_WCI = 32 * MiB, WS_WCO = 38 * MiB, WS_MGU = 40 * MiB, WS_MDN = 152 * MiB;
constexpr size_t WS_MODS = 208 * MiB, WS_RSTD = 209 * MiB, WS_BONUS = 210 * MiB, WS_TOPE = 211 * MiB, WS_TOPG = WS_TOPE + 128 * 1024, WS_TPOS = WS_TOPG + 128 * 1024;
constexpr size_t WS_SLOT = 211 * MiB + 512 * 1024, WS_CTL = 212 * MiB;
constexpr size_t WS_XR = 214 * MiB, WS_HB = 278 * MiB, WS_GATE = 310 * MiB, WS_OG = 342 * MiB, WS_YF = 374 * MiB, WS_YB = 406 * MiB, WS_Y0 = 374 * MiB;
constexpr size_t WS_S2 = 438 * MiB, WS_R = WS_S2, WS_KRAW = WS_S2 + 36 * MiB, WS_V = WS_S2 + 72 * MiB, WS_L1W = WS_S2 + 108 * MiB, WS_L1A = WS_S2 + 117 * MiB, WS_L1G = WS_S2 + 126 * MiB;
constexpr size_t WS_BG = WS_S2, WS_Z = WS_S2 + 32 * MiB, WS_CV = WS_S2 + 64 * MiB, WS_XS = WS_S2, WS_YS = WS_S2;
constexpr size_t WS_S1 = 574 * MiB, WS_XN = WS_S1, WS_AT = WS_S1, WS_BT = WS_S1 + 72 * MiB, WS_KT = WS_S1 + 144 * MiB, WS_ACT = WS_S1, WS_MACT = WS_S1;
constexpr size_t WS_BONUS1 = 213 * MiB;
constexpr size_t WS_RT = WS_XR, WS_GC = WS_XR + 72 * MiB;
constexpr size_t HMA = (size_t)NB * NH * (TCX + T) * HS;
constexpr int NPOS = TCX + T, NCHK = NPOS / 16;
constexpr size_t WS_END = 812 * MiB;
constexpr size_t WS_DUMP = 209 * MiB + 512 * 1024;
constexpr int MAXSLOT = 2 * M + NE * 256;

constexpr int LDS_BYTES = 163840;
constexpr int CTL_OFF = 155648;
constexpr int NTHREADS = 512, NWAVES = 8;

struct Args { const float* in[31]; float* out; unsigned char* ws; int ph_lo, ph_hi; };

__device__ __forceinline__ float bf2f(unsigned h) { return __uint_as_float(h << 16); }
typedef __bf16 bf16x2_t __attribute__((ext_vector_type(2)));
__device__ __forceinline__ unsigned cvt_pk_bf16_asm(float lo, float hi) { unsigned r; asm volatile("v_cvt_pk_bf16_f32 %0, %1, %2" : "=v"(r) : "v"(lo), "v"(hi)); return r; }
__device__ __forceinline__ unsigned cvt_pk_bf16(float lo, float hi) { const f32x2 v = {lo, hi}; return __builtin_bit_cast(unsigned, __builtin_convertvector(v, bf16x2_t)); }
__device__ __forceinline__ float sigmoidf_(float x) { return __builtin_amdgcn_rcpf(1.0f + __expf(-x)); }
__device__ __forceinline__ float siluf_(float x) { return x * sigmoidf_(x); }
__device__ __forceinline__ float tanhf_(float x) { return 2.0f * sigmoidf_(2.0f * x) - 1.0f; }
__device__ __forceinline__ float wave_sum(float v) {
#pragma unroll
    for (int o = 1; o < 64; o <<= 1) v += __shfl_xor(v, o);
    return v;
}
__device__ __forceinline__ int rfl(int v) { return __builtin_amdgcn_readfirstlane(v); }
__device__ __forceinline__ f32x4 ld4(const float* p) { return *(const f32x4*)p; }
__device__ __forceinline__ void unpack4(u32x2 w, float* o) { o[0] = bf2f(w.x & 0xffffu); o[1] = bf2f(w.x >> 16); o[2] = bf2f(w.y & 0xffffu); o[3] = bf2f(w.y >> 16); }
__device__ __forceinline__ void unpack8(u32x4 w, float* o) {
    o[0] = bf2f(w.x & 0xffffu); o[1] = bf2f(w.x >> 16); o[2] = bf2f(w.y & 0xffffu); o[3] = bf2f(w.y >> 16);
    o[4] = bf2f(w.z & 0xffffu); o[5] = bf2f(w.z >> 16); o[6] = bf2f(w.w & 0xffffu); o[7] = bf2f(w.w >> 16);
}
__device__ __forceinline__ u32x4 pack8(const float* v) { u32x4 w; w.x = cvt_pk_bf16_asm(v[0], v[1]); w.y = cvt_pk_bf16_asm(v[2], v[3]); w.z = cvt_pk_bf16_asm(v[4], v[5]); w.w = cvt_pk_bf16_asm(v[6], v[7]); return w; }
__device__ __forceinline__ u32x4 pack8v(const float* v) { u32x4 w; w.x = cvt_pk_bf16(v[0], v[1]); w.y = cvt_pk_bf16(v[2], v[3]); w.z = cvt_pk_bf16(v[4], v[5]); w.w = cvt_pk_bf16(v[6], v[7]); return w; }
template <int CTRL> __device__ __forceinline__ float dpp_mov(float v) { return __builtin_bit_cast(float, __builtin_amdgcn_update_dpp(0, __builtin_bit_cast(int, v), CTRL, 0xF, 0xF, true)); }
__device__ __forceinline__ int hm_row(int row) { return row < M ? (row >> 11) * (NH * NPOS) + TCX + (row & (T - 1)) : ((row - M) >> 8) * (NH * NPOS) + ((row - M) & (TCX - 1)); }
__device__ __forceinline__ float red8(float v) {
    v += __builtin_bit_cast(float, __builtin_amdgcn_update_dpp(0, __builtin_bit_cast(int, v), 0xB1, 0xF, 0xF, true));
    v += __builtin_bit_cast(float, __builtin_amdgcn_update_dpp(0, __builtin_bit_cast(int, v), 0x4E, 0xF, 0xF, true));
    v += __builtin_bit_cast(float, __builtin_amdgcn_update_dpp(0, __builtin_bit_cast(int, v), 0x141, 0xF, 0xF, true));
    return v;
}

namespace pg8 {
constexpr int BM = 256, BK = 64, HALF = 128, HTB = HALF * BK * 2, STAGE_BYTES = 8 * HTB, NXCD = 8, WGM = 8;
__device__ __forceinline__ int lds_byte(int r, int c) { const int st = (r >> 4) * 2 + (c >> 5), rr = r & 15, cc = c & 31, ob = rr * 64 + cc * 2; return st * 1024 + (ob ^ (((ob >> 9) & 1) << 5)); }
__device__ __forceinline__ void stage_rc(int b, int& R, int& C) { const int st = b / 1024, sb = b % 1024, swz = sb ^ (((sb >> 9) & 1) << 5); R = (st >> 1) * 16 + swz / 64; C = (st & 1) * 32 + (swz % 64) / 2; }
__device__ __forceinline__ int perm32(int rho) { const int n = rho >> 4, i = rho & 15; return 8 * (i >> 2) + 4 * n + (i & 3); }

enum { EPI_BF16 = 0, EPI_F32 = 1, EPI_SWIGLU = 2, EPI_MUL = 3, EPI_BF16_HM = 4, EPI_SWIGLU8 = 5 };
struct Unit { const char* A; const char* B; int pm, pn, job; };

__device__ __forceinline__ void set_job(LAS int* ctl, int j, const void* A, const void* B, void* O, int nM, int nN, int mode, int ldo, int act) {
    LAS int* jd = ctl + 16 + 16 * j;
    const unsigned long long a = (unsigned long long)A, b = (unsigned long long)B, o = (unsigned long long)O;
    jd[0] = (int)(unsigned)a; jd[1] = (int)(unsigned)(a >> 32); jd[2] = (int)(unsigned)b; jd[3] = (int)(unsigned)(b >> 32); jd[4] = (int)(unsigned)o; jd[5] = (int)(unsigned)(o >> 32);
    jd[6] = nM; jd[7] = nN; jd[9] = mode; jd[10] = ldo; jd[11] = act;
    const int u0 = (j == 0) ? 0 : ctl[16 + 16 * (j - 1) + 8] + ctl[16 + 16 * (j - 1) + 6] * ctl[16 + 16 * (j - 1) + 7];
    jd[8] = u0; ctl[0] = j + 1; ctl[1] = u0 + nM * nN;
}

__device__ __forceinline__ bool sched_next(LAS const int* ctl, int i, int G, int c, size_t tstepA, size_t tstepB, Unit& u) {
    const int total = rfl(ctl[1]), nj = rfl(ctl[0]);
    const long L = (long)i * G + c; if (L >= total) return false;
    int j = 0;
    for (int q = 1; q < nj; ++q) if ((int)L >= rfl(ctl[16 + 16 * q + 8])) j = q;
    LAS const int* jd = ctl + 16 + 16 * j;
    const int nM = rfl(jd[6]), nN = rfl(jd[7]); int wgid = (int)L - rfl(jd[8]);
    const int nwg = nM * nN;
    { const int q = nwg / NXCD, r = nwg % NXCD, xcd = wgid % NXCD, off = wgid / NXCD; wgid = (xcd < r ? xcd * (q + 1) : r * (q + 1) + (xcd - r) * q) + off; }
    const int nig = WGM * nN, gid = wgid / nig, fm = gid * WGM, gsz = (nM - fm) < WGM ? (nM - fm) : WGM;
    u.pm = fm + ((wgid % nig) % gsz); u.pn = (wgid % nig) / gsz; u.job = j;
    const unsigned long long a = ((unsigned long long)(unsigned)rfl(jd[1]) << 32) | (unsigned)rfl(jd[0]);
    const unsigned long long b = ((unsigned long long)(unsigned)rfl(jd[3]) << 32) | (unsigned)rfl(jd[2]);
    u.A = (const char*)a + (size_t)u.pm * tstepA; u.B = (const char*)b + (size_t)u.pn * tstepB;
    return true;
}

__device__ __forceinline__ void epilogue(const f32x4 (&acc)[2][2][4][2], LAS const int* ctl, const Unit& u, int wr, int wc, int fr, int fq) {
    LAS const int* jd = ctl + 16 + 16 * u.job;
    const int mode = rfl(jd[9]), ldo = rfl(jd[10]), act = rfl(jd[11]);
    char* O = (char*)(((unsigned long long)(unsigned)rfl(jd[5]) << 32) | (unsigned)rfl(jd[4]));
    const int row0 = u.pm * BM + wr * 64 + fr;
    if (mode == EPI_BF16) {
        bf16_t* base = (bf16_t*)O; const int col0 = u.pn * BM + wc * 32 + 8 * fq;
#pragma unroll
        for (int ai = 0; ai < 2; ++ai)
#pragma unroll
            for (int m = 0; m < 4; ++m) { bf16_t* rowp = base + (size_t)(row0 + ai * HALF + m * 16) * ldo + col0;
#pragma unroll
                for (int bj = 0; bj < 2; ++bj) { f32x4 v0 = acc[ai][bj][m][0], v1 = acc[ai][bj][m][1];
                    if (act == 1) { _Pragma("unroll") for (int e = 0; e < 4; ++e) { v0[e] = tanhf_(v0[e]); v1[e] = tanhf_(v1[e]); } }
                    else if (act == 2) { _Pragma("unroll") for (int e = 0; e < 4; ++e) { v0[e] = sigmoidf_(v0[e]); v1[e] = sigmoidf_(v1[e]); } }
                    u32x4 w; w.x = cvt_pk_bf16_asm(v0[0], v0[1]); w.y = cvt_pk_bf16_asm(v0[2], v0[3]); w.z = cvt_pk_bf16_asm(v1[0], v1[1]); w.w = cvt_pk_bf16_asm(v1[2], v1[3]);
                    *(u32x4*)(rowp + bj * HALF) = w; } }
    } else if (mode == EPI_BF16_HM) {
        bf16_t* base = (bf16_t*)O; const int col0 = u.pn * BM + wc * 32 + 8 * fq;
#pragma unroll
        for (int ai = 0; ai < 2; ++ai)
#pragma unroll
            for (int m = 0; m < 4; ++m) { const int hr = hm_row(row0 + ai * HALF + m * 16);
#pragma unroll
                for (int bj = 0; bj < 2; ++bj) { const int col = col0 + bj * HALF; const f32x4 v0 = acc[ai][bj][m][0], v1 = acc[ai][bj][m][1];
                    u32x4 w; w.x = cvt_pk_bf16_asm(v0[0], v0[1]); w.y = cvt_pk_bf16_asm(v0[2], v0[3]); w.z = cvt_pk_bf16_asm(v1[0], v1[1]); w.w = cvt_pk_bf16_asm(v1[2], v1[3]);
                    *(u32x4*)(base + ((size_t)(hr + (col >> 6) * NPOS)) * 64 + (col & 63)) = w; } }
    } else if (mode == EPI_F32) {
        float* base = (float*)O; const int col0 = u.pn * BM + wc * 32 + 8 * fq;
#pragma unroll
        for (int ai = 0; ai < 2; ++ai)
#pragma unroll
            for (int m = 0; m < 4; ++m) { float* rowp = base + (size_t)(row0 + ai * HALF + m * 16) * ldo + col0;
#pragma unroll
                for (int bj = 0; bj < 2; ++bj) { *(f32x4*)(rowp + bj * HALF) = acc[ai][bj][m][0]; *(f32x4*)(rowp + bj * HALF + 4) = acc[ai][bj][m][1]; } }
    } else if (mode == EPI_SWIGLU8) {
        unsigned char* base = (unsigned char*)O; const int colb = u.pn * HALF + wc * 16;
#pragma unroll
        for (int ai = 0; ai < 2; ++ai)
#pragma unroll
            for (int bj = 0; bj < 2; ++bj) { int w[4];
#pragma unroll
                for (int m = 0; m < 4; ++m) { const f32x4 g = acc[ai][bj][m][0], uu = acc[ai][bj][m][1]; f32x4 r;
                    _Pragma("unroll") for (int e = 0; e < 4; ++e) r[e] = 4.0f * siluf_(g[e]) * uu[e];
                    w[m] = __builtin_amdgcn_cvt_pk_fp8_f32(r[0], r[1], 0, false); w[m] = __builtin_amdgcn_cvt_pk_fp8_f32(r[2], r[3], w[m], true); }
                const auto s02 = __builtin_amdgcn_permlane32_swap(w[0], w[2], false, false), s13 = __builtin_amdgcn_permlane32_swap(w[1], w[3], false, false);
                const auto t01 = __builtin_amdgcn_permlane16_swap(s02[0], s13[0], false, false), t23 = __builtin_amdgcn_permlane16_swap(s02[1], s13[1], false, false);
                const u32x4 o = {(unsigned)t01[0], (unsigned)t01[1], (unsigned)t23[0], (unsigned)t23[1]};
                *(u32x4*)(base + (size_t)(u.pm * BM + wr * 64 + ai * HALF + 16 * fq + fr) * ldo + colb + bj * 64) = o; }
    } else {
        bf16_t* base = (bf16_t*)O; const int col0 = u.pn * HALF + wc * 16 + 4 * (fq & 2);
#pragma unroll
        for (int ai = 0; ai < 2; ++ai)
#pragma unroll
            for (int bj = 0; bj < 2; ++bj) { u32x2 w[4];
#pragma unroll
                for (int m = 0; m < 4; ++m) { const f32x4 g = acc[ai][bj][m][0], uu = acc[ai][bj][m][1]; f32x4 r;
                    if (mode == EPI_SWIGLU) { _Pragma("unroll") for (int e = 0; e < 4; ++e) r[e] = siluf_(g[e]) * uu[e]; } else { r = g * uu; }
                    w[m].x = cvt_pk_bf16(r[0], r[1]); w[m].y = cvt_pk_bf16(r[2], r[3]); }
#pragma unroll
                for (int mp = 0; mp < 4; mp += 2) {
                    const auto sx = __builtin_amdgcn_permlane16_swap((int)w[mp].x, (int)w[mp + 1].x, false, false), sy = __builtin_amdgcn_permlane16_swap((int)w[mp].y, (int)w[mp + 1].y, false, false);
                    const u32x4 o = {(unsigned)sx[0], (unsigned)sy[0], (unsigned)sx[1], (unsigned)sy[1]};
                    *(u32x4*)(base + (size_t)(row0 + ai * HALF + (mp + (fq & 1)) * 16) * ldo + col0 + bj * 64) = o; } }
    }
}

template <bool FP8>
__device__ __forceinline__ void gemm_phase(LAS unsigned char* lds, LAS const int* ctl, int K, int lda, int ldb, int G, int c, int sW = 127, int sA = 127) {
    const int tid = threadIdx.x, wid = __builtin_amdgcn_readfirstlane(tid >> 6), lane = tid & 63, wr = wid >> 2, wc = wid & 3, fr = lane & 15, fq = lane >> 4;
    const int nt = K / BK;
    sW = sW * 0x01010101; sA = sA * 0x01010101;
    unsigned voffA[2], voffB[2];
#pragma unroll
    for (int i = 0; i < 2; ++i) { int R, C; stage_rc(tid * 16 + i * 8192, R, C); const int Rb = (R & ~31) + perm32(R & 31);
        voffA[i] = (unsigned)(R * lda + C) * 2u; voffB[i] = (unsigned)(Rb * ldb + C) * 2u; }
    const size_t kstep = (size_t)(BK * 2);
    const size_t hsA = (size_t)HALF * lda * 2, hsB = (size_t)HALF * ldb * 2;
    const size_t tsA = 2 * hsA, tsB = 2 * hsB;
    const unsigned ldsw = (unsigned)wid * 1024u;
    const int aoff = lds_byte(wr * 64 + fr, fq * 8), boff = lds_byte(wc * 32 + fr, fq * 8);
#define PG8_SA(b, h) (((b) * 2 + (h)) * HTB)
#define PG8_SB(b, h) ((4 + (b) * 2 + (h)) * HTB)
#define PG8_STAGE(bufoff, gbase, voff) do { _Pragma("unroll") for (int _i = 0; _i < 2; ++_i) \
        __builtin_amdgcn_global_load_lds((const unsigned*)((const char*)(gbase) + (voff)[_i]), (LAS unsigned*)(lds + (bufoff) + ldsw + _i * 8192), 16, 0, 0); } while (0)
#define PG8_LDA(dst, b, h) do { _Pragma("unroll") for (int m = 0; m < 4; ++m) { const i32x4 lo_ = *(const LAS i32x4*)(lds + PG8_SA(b, h) + aoff + m * 2048), hi_ = *(const LAS i32x4*)(lds + PG8_SA(b, h) + aoff + m * 2048 + 1024); \
        dst[m] = __builtin_shufflevector(lo_, hi_, 0, 1, 2, 3, 4, 5, 6, 7); } } while (0)
#define PG8_LDB(dst, b, h) do { _Pragma("unroll") for (int n = 0; n < 2; ++n) { const i32x4 lo_ = *(const LAS i32x4*)(lds + PG8_SB(b, h) + boff + n * 2048), hi_ = *(const LAS i32x4*)(lds + PG8_SB(b, h) + boff + n * 2048 + 1024); \
        dst[n] = __builtin_shufflevector(lo_, hi_, 0, 1, 2, 3, 4, 5, 6, 7); } } while (0)
#define PG8_LO(v) __builtin_bit_cast(bf16x8, __builtin_shufflevector(v, v, 0, 1, 2, 3))
#define PG8_HI(v) __builtin_bit_cast(bf16x8, __builtin_shufflevector(v, v, 4, 5, 6, 7))
#define PG8_MMA16(ai, bj, At, Bt) do { __builtin_amdgcn_s_setprio(1); _Pragma("unroll") for (int m = 0; m < 4; ++m) _Pragma("unroll") for (int n = 0; n < 2; ++n) { \
        acc[ai][bj][m][n] = __builtin_amdgcn_mfma_f32_16x16x32_bf16(PG8_LO(Bt[n]), PG8_LO(At[m]), acc[ai][bj][m][n], 0, 0, 0); \
        acc[ai][bj][m][n] = __builtin_amdgcn_mfma_f32_16x16x32_bf16(PG8_HI(Bt[n]), PG8_HI(At[m]), acc[ai][bj][m][n], 0, 0, 0); } __builtin_amdgcn_s_setprio(0); } while (0)
#define PG8_MMA8(ai, bj, At, Bt) do { __builtin_amdgcn_s_setprio(1); _Pragma("unroll") for (int m = 0; m < 4; ++m) _Pragma("unroll") for (int n = 0; n < 2; ++n) \
        asm volatile("v_mfma_scale_f32_16x16x128_f8f6f4 %0, %1, %2, %0, %3, %4 op_sel_hi:[0,0,0]" : "+v"(acc[ai][bj][m][n]) : "v"(Bt[n]), "v"(At[m]), "v"(sW), "v"(sA)); __builtin_amdgcn_s_setprio(0); } while (0)
#define PG8_MMA(ai, bj, At, Bt) do { if constexpr (FP8) PG8_MMA8(ai, bj, At, Bt); else PG8_MMA16(ai, bj, At, Bt); } while (0)
#define PG8_WAIT_V(n) asm volatile("s_waitcnt vmcnt(" #n ")" ::: "memory")
#define PG8_WAIT_L(n) asm volatile("s_waitcnt lgkmcnt(" #n ")" ::: "memory")
#define PG8_BAR __builtin_amdgcn_s_barrier()
#define PG8_SCHED __builtin_amdgcn_sched_barrier(0)
    Unit cur, nxt; int ui = 0;
    if (!sched_next(ctl, 0, G, c, tsA, tsB, cur)) return;
    f32x4 acc[2][2][4][2];
#pragma unroll
    for (int a = 0; a < 2; ++a)
#pragma unroll
        for (int b = 0; b < 2; ++b)
#pragma unroll
            for (int m = 0; m < 4; ++m)
#pragma unroll
                for (int n = 0; n < 2; ++n) acc[a][b][m][n] = (f32x4){0.f, 0.f, 0.f, 0.f};
    i32x8 At[4], B0[2], B1[2];
    const char* cA = cur.A; const char* cB = cur.B;
    PG8_STAGE(PG8_SB(0, 0), cB, voffB); PG8_STAGE(PG8_SB(0, 1), cB + hsB, voffB); PG8_STAGE(PG8_SA(0, 0), cA, voffA); PG8_STAGE(PG8_SA(0, 1), cA + hsA, voffA);
    if (wr == 1) PG8_BAR;
    PG8_WAIT_V(2); PG8_BAR;
    PG8_STAGE(PG8_SB(1, 0), cB + kstep, voffB); PG8_STAGE(PG8_SA(1, 0), cA + kstep, voffA); PG8_STAGE(PG8_SB(1, 1), cB + hsB + kstep, voffB);
    PG8_WAIT_V(6); PG8_BAR;
    for (;;) {
        const bool has_next = sched_next(ctl, ui + 1, G, c, tsA, tsB, nxt);
        const char* nA = has_next ? nxt.A : cA; const char* nB = has_next ? nxt.B : cB;
        for (int t = 0; t < nt; t += 2) {
            const bool last = (t == nt - 2);
            const char* a1 = cA + (size_t)(t + 1) * kstep;
            const char* a2 = last ? nA : cA + (size_t)(t + 2) * kstep; const char* b2 = last ? nB : cB + (size_t)(t + 2) * kstep;
            const char* a3 = a2 + kstep; const char* b3 = b2 + kstep;
            PG8_LDB(B0, 0, 0); PG8_LDB(B1, 0, 1); PG8_SCHED; PG8_LDA(At, 0, 0); PG8_STAGE(PG8_SA(1, 1), a1 + hsA, voffA);
            PG8_WAIT_V(8); PG8_WAIT_L(0); PG8_BAR; PG8_MMA(0, 0, At, B0); PG8_MMA(0, 1, At, B1); PG8_BAR; PG8_SCHED;
            PG8_LDA(At, 0, 1); PG8_STAGE(PG8_SB(0, 0), b2, voffB); PG8_STAGE(PG8_SB(0, 1), b2 + hsB, voffB); PG8_STAGE(PG8_SA(0, 0), a2, voffA);
            PG8_WAIT_V(8); PG8_WAIT_L(0); PG8_BAR; PG8_MMA(1, 0, At, B0); PG8_MMA(1, 1, At, B1); PG8_BAR; PG8_SCHED;
            PG8_LDB(B0, 1, 0); PG8_LDB(B1, 1, 1); PG8_SCHED; PG8_LDA(At, 1, 0); PG8_STAGE(PG8_SA(0, 1), a2 + hsA, voffA);
            PG8_WAIT_V(8); PG8_WAIT_L(0); PG8_BAR; PG8_MMA(0, 0, At, B0); PG8_MMA(0, 1, At, B1); PG8_BAR; PG8_SCHED;
            PG8_LDA(At, 1, 1); PG8_STAGE(PG8_SB(1, 0), b3, voffB); PG8_STAGE(PG8_SB(1, 1), b3 + hsB, voffB); PG8_STAGE(PG8_SA(1, 0), a3, voffA);
            PG8_WAIT_V(8); PG8_WAIT_L(0); PG8_BAR; PG8_MMA(1, 0, At, B0); PG8_MMA(1, 1, At, B1); PG8_BAR; PG8_SCHED;
        }
        if (wr == 0) PG8_BAR;
        if constexpr (FP8) asm volatile("s_nop 15\n\ts_nop 15" ::: "memory");
        epilogue(acc, ctl, cur, wr, wc, fr, fq);
        if (!has_next) break;
#pragma unroll
        for (int a = 0; a < 2; ++a)
#pragma unroll
            for (int b = 0; b < 2; ++b)
#pragma unroll
                for (int m = 0; m < 4; ++m)
#pragma unroll
                    for (int n = 0; n < 2; ++n) acc[a][b][m][n] = (f32x4){0.f, 0.f, 0.f, 0.f};
        cur = nxt; cA = nA; cB = nB; ++ui;
        if (wr == 1) PG8_BAR;
    }
    PG8_WAIT_V(0);
    PG8_BAR;
#undef PG8_SA
#undef PG8_SB
#undef PG8_STAGE
#undef PG8_LDA
#undef PG8_LDB
#undef PG8_MMA
#undef PG8_MMA8
#undef PG8_MMA16
#undef PG8_LO
#undef PG8_HI
#undef PG8_WAIT_V
#undef PG8_WAIT_L
#undef PG8_BAR
#undef PG8_SCHED
}
}

__device__ __forceinline__ int cvt_rowmap(int kind, int n) {
    if (kind == 1) { if (n < FF) return 8 * (n >> 2) + (n & 3); const int j = n - FF; return 8 * (j >> 2) + 4 + (j & 3); }
    if (kind == 2) { if (n < D) return n; if (n < 2 * D) { const int j = n - D; return D + 8 * (j >> 2) + (j & 3); } const int j = n - 2 * D; return D + 8 * (j >> 2) + 4 + (j & 3); }
    return n;
}
struct CvtIt { const float* src; bf16_t* dst; int K, N, ldd, kind, k0, n0; };
__device__ __forceinline__ void cvt_decode(LAS const int* ctl, int it, CvtIt& c) {
    const int nj = rfl(ctl[2]);
    int j = 0;
    for (int q = 1; q < nj; ++q) if (it >= rfl(ctl[256 + 16 * q + 11])) j = q;
    LAS const int* jd = ctl + 256 + 16 * j;
    const int loc = it - rfl(jd[11]), ipb = rfl(jd[12]), nNt = rfl(jd[13]);
    const int bat = loc / ipb, rem = loc % ipb, kb = rem / nNt, nb = rem % nNt;
    c.src = (const float*)(((unsigned long long)(unsigned)rfl(jd[1]) << 32) | (unsigned)rfl(jd[0])) + (size_t)bat * (size_t)(unsigned)rfl(jd[9]);
    c.dst = (bf16_t*)(((unsigned long long)(unsigned)rfl(jd[3]) << 32) | (unsigned)rfl(jd[2])) + (size_t)bat * (size_t)(unsigned)rfl(jd[10]);
    c.K = rfl(jd[4]); c.N = rfl(jd[5]); c.ldd = rfl(jd[6]); c.kind = rfl(jd[7]); c.k0 = 64 * kb; c.n0 = 64 * nb;
}
__device__ __forceinline__ void cvt_load(const CvtIt& c, f32x4 (&v)[16], int lane) {
    const int nn = 4 * (lane & 15);
    const int n = (c.n0 + nn) < c.N ? (c.n0 + nn) : (c.N - 4);
#pragma unroll
    for (int i = 0; i < 16; ++i) { const int k_ = c.k0 + 4 * i + (lane >> 4); const int k = k_ < c.K ? k_ : c.K - 1;
        v[i] = *(const f32x4*)(c.src + (size_t)k * c.N + n); }
}
__device__ __forceinline__ void cvt_to_lds(const f32x4 (&v)[16], LAS float* scr, int lane) {
    const int nn = 4 * (lane & 15);
#pragma unroll
    for (int i = 0; i < 16; ++i) { const int kk = 4 * i + (lane >> 4); LAS float* s = scr + kk * 65 + nn; s[0] = v[i][0]; s[1] = v[i][1]; s[2] = v[i][2]; s[3] = v[i][3]; }
    asm volatile("s_waitcnt lgkmcnt(0)" ::: "memory");
}
__device__ __forceinline__ void cvt_store(const CvtIt& ci, LAS const float* scr, int lane) {
    const int c = lane & 7; const int K = ci.K, N = ci.N, ldd = ci.ldd, kind = ci.kind, k0 = ci.k0, n0 = ci.n0; bf16_t* dst = ci.dst;
    if (kind & 0x100) {
        const float sc = (float)(1 << (kind >> 16));
#pragma unroll
        for (int j = 0; j < 8; ++j) { const int nl = (lane >> 3) + 8 * j; const LAS float* s = scr + (8 * c) * 65 + nl;
            int w0 = __builtin_amdgcn_cvt_pk_fp8_f32(s[0] * sc, s[65] * sc, 0, false); w0 = __builtin_amdgcn_cvt_pk_fp8_f32(s[2 * 65] * sc, s[3 * 65] * sc, w0, true);
            int w1 = __builtin_amdgcn_cvt_pk_fp8_f32(s[4 * 65] * sc, s[5 * 65] * sc, 0, false); w1 = __builtin_amdgcn_cvt_pk_fp8_f32(s[6 * 65] * sc, s[7 * 65] * sc, w1, true);
            const int n = n0 + nl, k = k0 + 8 * c;
            if (n < N && k < K) *(u32x2*)((unsigned char*)dst + (size_t)cvt_rowmap(kind & 15, n) * ldd + k) = (u32x2){(unsigned)w0, (unsigned)w1}; }
    } else {
        const float sc = (kind & 0x200) ? -1.44269504f : 1.0f;
#pragma unroll
        for (int j = 0; j < 8; ++j) { const int nl = (lane >> 3) + 8 * j; const LAS float* s = scr + (8 * c) * 65 + nl;
            u32x4 o; o.x = cvt_pk_bf16_asm(s[0] * sc, s[65] * sc); o.y = cvt_pk_bf16_asm(s[2 * 65] * sc, s[3 * 65] * sc); o.z = cvt_pk_bf16_asm(s[4 * 65] * sc, s[5 * 65] * sc); o.w = cvt_pk_bf16_asm(s[6 * 65] * sc, s[7 * 65] * sc);
            const int n = n0 + nl, k = k0 + 8 * c;
            if (n < N && k < K) *(u32x4*)(dst + (size_t)cvt_rowmap(kind & 15, n) * ldd + k) = o; }
    }
    asm volatile("s_waitcnt lgkmcnt(0)" ::: "memory");
}
__device__ __forceinline__ void cvt_set(LAS int* ctl, int j, const float* src, void* dst, int K, int N, int ldd, int kind, int nb, int sstride, int dstride) {
    LAS int* jd = ctl + 256 + 16 * j;
    const unsigned long long a = (unsigned long long)src, b = (unsigned long long)dst;
    jd[0] = (int)(unsigned)a; jd[1] = (int)(unsigned)(a >> 32); jd[2] = (int)(unsigned)b; jd[3] = (int)(unsigned)(b >> 32);
    jd[4] = K; jd[5] = N; jd[6] = ldd; jd[7] = kind; jd[8] = nb; jd[9] = sstride; jd[10] = dstride;
    const int nKt = (K + 63) / 64, nNt = (N + 63) / 64;
    const int i0 = (j == 0) ? 0 : ctl[256 + 16 * (j - 1) + 11] + ctl[256 + 16 * (j - 1) + 12] * ctl[256 + 16 * (j - 1) + 8];
    jd[11] = i0; jd[12] = nKt * nNt; jd[13] = nNt;
    ctl[2] = j + 1; ctl[3] = i0 + nKt * nNt * nb;
}

__device__ __forceinline__ void phase0(const Args& a, LAS unsigned char* lds, int tid, int lane, int wave, int G) {
    unsigned char* ws = a.ws;
    LAS int* ctl = (LAS int*)(lds + CTL_OFF);
    if (tid == 0) {
        cvt_set(ctl, 0, a.in[8], ws + WS_WR, D, D, D, 0, 3, D * D, D * D);
        cvt_set(ctl, 1, a.in[10], ws + WS_WW1, D, 64, D, 0 | 0x100 | (5 << 16), 2, D * 64, 64 * D / 2);
        cvt_set(ctl, 2, a.in[13], ws + WS_WA1, D, 64, D, 0 | 0x100 | (5 << 16), 2, D * 64, 64 * D / 2);
        cvt_set(ctl, 3, a.in[15], ws + WS_WG1, D, 160, D, 0, 1, 0, 0);
        cvt_set(ctl, 4, a.in[11], ws + WS_W2W, 64, D, 64, 0x200, 2, 64 * D, D * 64);
        cvt_set(ctl, 5, a.in[14], ws + WS_W2A, 64, D, 64, 0x200, 2, 64 * D, D * 64);
        cvt_set(ctl, 6, a.in[16], ws + WS_W2G, 160, D, 160, 0, 1, 0, 0);
        cvt_set(ctl, 7, a.in[22], ws + WS_WOUT, D, D, D, 0, 1, 0, 0);
        cvt_set(ctl, 8, a.in[26], ws + WS_WGU, D, 2 * FF, D, 1 | 0x100 | (5 << 16), 1, 0, 0);
        cvt_set(ctl, 9, a.in[27], ws + WS_WDN, FF, D, FF, 0 | 0x100 | (6 << 16), 1, 0, 0);
        cvt_set(ctl, 10, a.in[23], ws + WS_WCI, D, 3 * D, D, 2, 1, 0, 0);
        cvt_set(ctl, 11, a.in[25], ws + WS_WCO, D, D, D, 0, 1, 0, 0);
        cvt_set(ctl, 12, a.in[29], ws + WS_MGU, D, 2 * FF, D, 1 | 0x100 | (5 << 16), NE, D * 2 * FF, FF * D);
        cvt_set(ctl, 13, a.in[30], ws + WS_MDN, FF, D, FF, 0 | 0x100 | (6 << 16), NE, FF * D, D * FF / 2);
    }
    if (blockIdx.x == 0 && tid < 64) ((int*)(ws + WS_CTL))[tid] = 0;
    {
        LAS float* s = (LAS float*)lds; LAS float* red = (LAS float*)(lds + 36864);
        for (int u = blockIdx.x; u < 192; u += G) {
            const int layer = u / 96, n0 = (u % 96) * 64;
            for (int idx = tid; idx < 9 * D; idx += NTHREADS) { const int b = idx >> 10, k = idx & 1023; const float cv = b < 8 ? a.in[1][b * D + k] : a.in[3][k]; s[idx] = siluf_(cv); }
            __syncthreads();
            const float* W = a.in[4] + (size_t)layer * D * 6 * D + n0 + lane;
            float acc[9];
#pragma unroll
            for (int b = 0; b < 9; ++b) acc[b] = 0.f;
#pragma unroll 4
            for (int k = 128 * wave; k < 128 * wave + 128; k += 4) {
                const float w0 = W[(size_t)k * 6144], w1 = W[(size_t)(k + 1) * 6144], w2 = W[(size_t)(k + 2) * 6144], w3 = W[(size_t)(k + 3) * 6144];
#pragma unroll
                for (int b = 0; b < 9; ++b) { const f32x4 sv = *(const LAS f32x4*)(s + b * D + k); acc[b] += sv[0] * w0 + sv[1] * w1 + sv[2] * w2 + sv[3] * w3; }
            }
#pragma unroll
            for (int b = 0; b < 9; ++b) red[(wave * 9 + b) * 64 + lane] = acc[b];
            __syncthreads();
            for (int idx = tid; idx < 9 * 64; idx += NTHREADS) { const int b = idx >> 6, l = idx & 63; float t = 0.f;
#pragma unroll
                for (int w = 0; w < 8; ++w) t += red[(w * 9 + b) * 64 + l];
                ((float*)(ws + WS_MODS))[(size_t)(layer * 9 + b) * 6144 + n0 + l] = t + a.in[5][layer * 6144 + n0 + l]; }
            __syncthreads();
        }
    }
    const int gw = blockIdx.x * NWAVES + wave, NGW = G * NWAVES;
    for (int row = gw; row < MT; row += NGW) {
        const float* xr = row < M ? a.in[0] + (size_t)row * D : a.in[2] + (size_t)(row - M) * D;
        float ss = 0.f;
#pragma unroll
        for (int j = 0; j < 4; ++j) { const f32x4 v = ld4(xr + 4 * lane + 256 * j); ss += v[0] * v[0] + v[1] * v[1] + v[2] * v[2] + v[3] * v[3]; }
        ss = wave_sum(ss);
        if (lane == 0) ((float*)(ws + WS_RSTD))[row] = rsqrtf(ss * (1.0f / D) + NORM_EPS);
    }
    {
        const int gt = blockIdx.x * NTHREADS + tid, NGT = G * NTHREADS;
        const u32x4 z = (u32x4){0u, 0u, 0u, 0u};
        for (int i = gt; i < 128 * D / 16; i += NGT) { ((u32x4*)(ws + WS_WW1 + 128 * D))[i] = z; ((u32x4*)(ws + WS_WA1 + 128 * D))[i] = z; }
        for (int i = gt; i < 96 * D / 8; i += NGT) ((u32x4*)(ws + WS_WG1 + 160 * D * 2))[i] = z;
    }
    __syncthreads();
    {
        LAS float* scr = (LAS float*)(lds + wave * 16640);
        const int nitems = rfl(ctl[3]);
        f32x4 v[16]; CvtIt cur, nxt;
        int it = gw;
        if (it < nitems) { cvt_decode(ctl, it, cur); cvt_load(cur, v, lane); }
        for (; it < nitems; it += NGW) {
            cvt_to_lds(v, scr, lane);
            const bool more = it + NGW < nitems;
            if (more) { cvt_decode(ctl, it + NGW, nxt); cvt_load(nxt, v, lane); }
            cvt_store(cur, scr, lane);
            if (more) cur = nxt;
        }
    }
}

__device__ __forceinline__ void phase_mix(const Args& a, int gw, int NGW, int lane) {
    unsigned char* ws = a.ws;
    const float* g = a.in[6];
    const float* mu = a.in[7];
    const float* mods = (const float*)(ws + WS_MODS);
    const float* rstd = (const float*)(ws + WS_RSTD);
    bf16_t* XN = (bf16_t*)(ws + WS_XN);
    const int rpw = (MT + NGW - 1) / NGW;
    const int rbeg = gw * rpw, rend = (rbeg + rpw) < MT ? (rbeg + rpw) : MT;
    float muv[6][2][8], gs[2][8], sh[2][8];
#pragma unroll
    for (int n = 0; n < 6; ++n)
#pragma unroll
        for (int j = 0; j < 2; ++j) { const f32x4 t0 = ld4(mu + n * D + 512 * j + 8 * lane), t1 = ld4(mu + n * D + 512 * j + 8 * lane + 4);
#pragma unroll
            for (int e = 0; e < 4; ++e) { muv[n][j][e] = t0[e]; muv[n][j][4 + e] = t1[e]; } }
    int curb = -1;
    f32x4 ps[2][2], pn_[2][2]; float prs = 0.f, prn[2] = {0.f, 0.f};
#define MIX_LOAD(rowv) do { const int row_ = (rowv); const bool ic_ = row_ >= M; const int r2_ = ic_ ? row_ - M : row_; const int t_ = ic_ ? r2_ % TCX : r2_ % T; \
        const float* base_ = ic_ ? a.in[2] : a.in[0]; prs = rstd[row_]; \
        _Pragma("unroll") for (int j = 0; j < 2; ++j) { int d_; \
            if (!ic_) { const int col = t_ & 63, gr = t_ >> 6, qd = 2 * j + (lane >> 5); \
                d_ = qd == 0 ? (col > 0 ? -1 : 0) : qd == 1 ? (col < 63 ? 1 : 0) : qd == 2 ? (gr > 0 ? -64 : 0) : (gr < 31 ? 64 : 0); \
            } else d_ = j == 0 ? (t_ > 0 ? -1 : 0) : (t_ < TCX - 1 ? 1 : 0); \
            const int c = 512 * j + 8 * lane; const float* p0_ = base_ + (size_t)r2_ * D + c; const float* p1_ = base_ + (size_t)(r2_ + d_) * D + c; \
            ps[j][0] = ld4(p0_); ps[j][1] = ld4(p0_ + 4); pn_[j][0] = ld4(p1_); pn_[j][1] = ld4(p1_ + 4); prn[j] = d_ != 0 ? rstd[row_ + d_] : 0.f; } } while (0)
    if (rbeg < rend) MIX_LOAD(rbeg);
    for (int row = rbeg; row < rend; ++row) {
        const bool isctx = row >= M;
        const int r2 = isctx ? row - M : row;
        const int b = isctx ? r2 / TCX : r2 / T;
        const int mb = isctx ? 8 : b;
        if (mb != curb) { curb = mb; const float* md = mods + (size_t)mb * 6144;
#pragma unroll
            for (int j = 0; j < 2; ++j) { const int c = 512 * j + 8 * lane;
#pragma unroll
                for (int e = 0; e < 8; e += 4) { const f32x4 gv = ld4(g + c + e), shv = ld4(md + c + e), scv = ld4(md + D + c + e);
#pragma unroll
                    for (int i = 0; i < 4; ++i) { gs[j][e + i] = gv[i] * (1.0f + scv[i]); sh[j][e + i] = shv[i]; } } } }
        f32x4 cs[2][2], cn[2][2]; const float rs = prs; float rn[2];
#pragma unroll
        for (int j = 0; j < 2; ++j) { cs[j][0] = ps[j][0]; cs[j][1] = ps[j][1]; cn[j][0] = pn_[j][0]; cn[j][1] = pn_[j][1]; rn[j] = prn[j]; }
        if (row + 1 < rend) MIX_LOAD(row + 1);
#pragma unroll
        for (int j = 0; j < 2; ++j) {
            const int c = 512 * j + 8 * lane;
            const float msk = rn[j] != 0.f ? 1.0f : 0.0f;
            float hs[8], dx[8];
#pragma unroll
            for (int e = 0; e < 8; ++e) { const float xs_ = cs[j][e >> 2][e & 3], xn_ = cn[j][e >> 2][e & 3];
                hs[e] = xs_ * rs * gs[j][e] + sh[j][e];
                const float hn = xn_ * rn[j] * gs[j][e] + sh[j][e] * msk;
                dx[e] = hn - hs[e]; }
#pragma unroll
            for (int n = 0; n < 6; ++n) { float o[8];
#pragma unroll
                for (int e = 0; e < 8; ++e) o[e] = hs[e] + dx[e] * muv[n][j][e];
                if (n == 1 || n == 4) {
                    int w0 = __builtin_amdgcn_cvt_pk_fp8_f32(o[0], o[1], 0, false); w0 = __builtin_amdgcn_cvt_pk_fp8_f32(o[2], o[3], w0, true);
                    int w1 = __builtin_amdgcn_cvt_pk_fp8_f32(o[4], o[5], 0, false); w1 = __builtin_amdgcn_cvt_pk_fp8_f32(o[6], o[7], w1, true);
                    *(u32x2*)((unsigned char*)(XN + (size_t)n * MT * D) + (size_t)row * D + c) = (u32x2){(unsigned)w0, (unsigned)w1};
                } else *(u32x4*)(XN + ((size_t)n * MT + row) * D + c) = pack8(o); }
        }
    }
#undef MIX_LOAD
}

__device__ __forceinline__ void phase_fin(const Args& a, LAS unsigned char* lds, int tid, int lane, int wave, int G) {
    unsigned char* ws = a.ws;
    const int q = lane >> 4, rho = lane & 15;
    const bf16_t* W2W = (const bf16_t*)(ws + WS_W2W); const bf16_t* W2A = (const bf16_t*)(ws + WS_W2A); const bf16_t* W2G = (const bf16_t*)(ws + WS_W2G);
    const bf16_t* L1W = (const bf16_t*)(ws + WS_L1W); const bf16_t* L1A = (const bf16_t*)(ws + WS_L1A); const bf16_t* L1G = (const bf16_t*)(ws + WS_L1G);
    const bf16_t* KR = (const bf16_t*)(ws + WS_KRAW); const bf16_t* RB = (const bf16_t*)(ws + WS_R);
    bf16_t* AT = (bf16_t*)(ws + WS_AT); bf16_t* BT = (bf16_t*)(ws + WS_BT); bf16_t* KT = (bf16_t*)(ws + WS_KT); bf16_t* RT = (bf16_t*)(ws + WS_RT); float* GC = (float*)(ws + WS_GC); bf16_t* GATE = (bf16_t*)(ws + WS_GATE);
    float* BONUS = (float*)(ws + WS_BONUS);
    const int nparts = G / NH;
    {
        const int h = blockIdx.x % NH;
        const int part = blockIdx.x / NH;
        if (part >= nparts) return;
        __syncthreads();
        for (int f = wave; f < 52; f += NWAVES) {
            int mat, p, n, s;
            if (f < 32) { mat = f >> 3; p = (f >> 2) & 1; n = (f >> 1) & 1; s = f & 1; } else { const int r = f - 32; mat = 4; p = r / 10; n = (r % 10) / 5; s = r % 5; }
            const int ch = h * 64 + p * 32 + 8 * (rho >> 2) + 4 * n + (rho & 3), k = 32 * s + 8 * q;
            const bf16_t* src = mat < 2 ? W2W + ((size_t)mat * D + ch) * 64 + k : mat < 4 ? W2A + ((size_t)(mat - 2) * D + ch) * 64 + k : W2G + (size_t)ch * 160 + k;
            *(LAS u32x4*)(lds + f * 1024 + lane * 16) = *(const u32x4*)src;
        }
        LAS float* PRM = (LAS float*)(lds + 53248);
        if (tid < 448) { const int arr = tid >> 6, c = tid & 63;
            PRM[tid] = arr < 2 ? a.in[9][arr * D + h * 64 + c] : arr < 4 ? a.in[12][(arr - 2) * D + h * 64 + c] : arr == 4 ? a.in[17][h * 64 + c] : arr == 5 ? a.in[18][h * 64 + c] : a.in[19][h * 64 + c]; }
        __syncthreads();
        bf16x8 n_tw[2][2], n_ta[2][2], n_tg[5]; u32x4 n_kv[2], n_rv[2];
#define FIN_LOAD(rbv) do { const int trow_ = (rbv) * 128 + wave * 16 + rho; const bool lat_ = ((rbv) * 128) < M; \
            _Pragma("unroll") for (int z = 0; z < 2; ++z) _Pragma("unroll") for (int s_ = 0; s_ < 2; ++s_) { n_tw[z][s_] = *(const bf16x8*)(L1W + (size_t)trow_ * 256 + z * 64 + 32 * s_ + 8 * q); n_ta[z][s_] = *(const bf16x8*)(L1A + (size_t)trow_ * 256 + z * 64 + 32 * s_ + 8 * q); } \
            if (lat_) { _Pragma("unroll") for (int s_ = 0; s_ < 5; ++s_) n_tg[s_] = *(const bf16x8*)(L1G + (size_t)trow_ * 256 + 32 * s_ + 8 * q); } \
            const size_t hb_ = ((size_t)(hm_row(trow_) + h * NPOS)) * 64; \
            _Pragma("unroll") for (int p_ = 0; p_ < 2; ++p_) { n_kv[p_] = *(const u32x4*)(KR + hb_ + p_ * 32 + 8 * q); if (lat_) n_rv[p_] = *(const u32x4*)(RB + hb_ + p_ * 32 + 8 * q); } } while (0)
        if (part < MT / 128) FIN_LOAD(part);
        for (int rb = part; rb < MT / 128; rb += nparts) {
            const int trow = rb * 128 + wave * 16 + rho;
            const bool lat = (rb * 128) < M;
            f32x4 aw[2][2][2], aa[2][2][2]; u32x4 gpk[2];
#pragma unroll
            for (int p = 0; p < 2; ++p)
#pragma unroll
                for (int n = 0; n < 2; ++n) {
#pragma unroll
                    for (int z = 0; z < 2; ++z) { aw[p][z][n] = (f32x4){0.f, 0.f, 0.f, 0.f}; aa[p][z][n] = (f32x4){0.f, 0.f, 0.f, 0.f};
#pragma unroll
                        for (int s = 0; s < 2; ++s) {
                            const bf16x8 fw = *(const LAS bf16x8*)(lds + ((z) * 8 + p * 4 + n * 2 + s) * 1024 + lane * 16);
                            const bf16x8 fa = *(const LAS bf16x8*)(lds + ((2 + z) * 8 + p * 4 + n * 2 + s) * 1024 + lane * 16);
                            aw[p][z][n] = __builtin_amdgcn_mfma_f32_16x16x32_bf16(fw, n_tw[z][s], aw[p][z][n], 0, 0, 0);
                            aa[p][z][n] = __builtin_amdgcn_mfma_f32_16x16x32_bf16(fa, n_ta[z][s], aa[p][z][n], 0, 0, 0); } }
                    if (lat) {
                        f32x4 ag = (f32x4){0.f, 0.f, 0.f, 0.f};
#pragma unroll
                        for (int s = 0; s < 5; ++s) { const bf16x8 fg = *(const LAS bf16x8*)(lds + (32 + p * 10 + n * 5 + s) * 1024 + lane * 16);
                            ag = __builtin_amdgcn_mfma_f32_16x16x32_bf16(fg, n_tg[s], ag, 0, 0, 0); }
                        if (n == 0) { gpk[p].x = cvt_pk_bf16(ag[0], ag[1]); gpk[p].y = cvt_pk_bf16(ag[2], ag[3]); } else { gpk[p].z = cvt_pk_bf16(ag[0], ag[1]); gpk[p].w = cvt_pk_bf16(ag[2], ag[3]); }
                    }
                }
            const u32x4 c_kv0 = n_kv[0], c_kv1 = n_kv[1], c_rv0 = n_rv[0], c_rv1 = n_rv[1];
            asm volatile("" :: "v"(c_kv0), "v"(c_kv1), "v"(c_rv0), "v"(c_rv1));
            if (rb + nparts < MT / 128) FIN_LOAD(rb + nparts);
            const int hr = hm_row(trow), bb = hr / (NH * NPOS), pos = hr - bb * (NH * NPOS);
            const size_t hbase = ((size_t)(hr + h * NPOS)) * 64;
            float ssq = 0.f, bon = 0.f;
#pragma unroll
            for (int p = 0; p < 2; ++p) { float kvt[8]; unpack8(p ? c_kv1 : c_kv0, kvt);
#pragma unroll
                for (int e = 0; e < 8; ++e) { const float kr = kvt[e] * PRM[4 * 64 + p * 32 + 8 * q + e]; ssq += kr * kr; } }
            ssq += __shfl_xor(ssq, 16); ssq += __shfl_xor(ssq, 32);
            const float inv = rsqrtf(fmaxf(ssq, 1e-24f));
#pragma unroll
            for (int p = 0; p < 2; ++p) {
                const int cl = p * 32 + 8 * q, cb = h * 64 + cl;
                const LAS float* pp = PRM + cl;
                float kv[8], rv[8], kds[8];
                unpack8(p ? c_kv1 : c_kv0, kv);
                if (lat) unpack8(p ? c_rv1 : c_rv0, rv); else { for (int e = 0; e < 8; ++e) rv[e] = 0.f; }
#pragma unroll
                for (int e = 0; e < 8; ++e) kds[e] = 0.f;
#pragma unroll
                for (int z = 0; z < 2; ++z) {
                    float oA[8], oB[8], oK[8], oR[8], gc[8];
#pragma unroll
                    for (int e = 0; e < 8; ++e) {
                        const int n = e >> 2, i = e & 3;
                        const float dl = -0.60653066f * sigmoidf_(aw[p][z][n][i] + pp[z * 64 + e]);
                        const float ic = sigmoidf_(aa[p][z][n][i] + pp[(2 + z) * 64 + e]);
                        float cum = dl, epv;
                        if (z == 0) { cum += dpp_mov<0x111>(cum); cum += dpp_mov<0x112>(cum); cum += dpp_mov<0x114>(cum); cum += dpp_mov<0x118>(cum); }
                        else        { cum += dpp_mov<0x101>(cum); cum += dpp_mov<0x102>(cum); cum += dpp_mov<0x104>(cum); cum += dpp_mov<0x108>(cum); }
                        const float ec = __builtin_amdgcn_exp2f(cum * 1.44269504f), en = __builtin_amdgcn_rcpf(ec);
                        if (z == 0) { epv = dpp_mov<0x111>(ec); if (rho == 0) epv = 1.0f; } else { epv = dpp_mov<0x101>(ec); if (rho == 15) epv = 1.0f; }
                        const float kk = kv[e] * pp[4 * 64 + e] * inv, bq = kk * ic, kd = kv[e] * (1.0f + (ic - 1.0f) * pp[5 * 64 + e]);
                        oA[e] = -kk * epv; oB[e] = bq * en; oK[e] = kd * en; oR[e] = rv[e] * ec; gc[e] = ec; kds[e] += kd;
                    }
                    *(u32x4*)(AT + (size_t)z * HMA + hbase + cl) = pack8(oA); *(u32x4*)(BT + (size_t)z * HMA + hbase + cl) = pack8(oB);
                    *(u32x4*)(KT + (size_t)z * HMA + hbase + cl) = pack8(oK); *(u32x4*)(RT + (size_t)z * HMA + hbase + cl) = pack8(oR);
                    if (rho == (z == 0 ? 15 : 0)) { float* gp = GC + (((size_t)z * NB * NH + bb * NH + h) * NCHK + (pos >> 4)) * 64 + cl;
                        *(f32x4*)gp = (f32x4){gc[0], gc[1], gc[2], gc[3]}; *(f32x4*)(gp + 4) = (f32x4){gc[4], gc[5], gc[6], gc[7]}; }
                }
                if (lat) {
#pragma unroll
                    for (int e = 0; e < 8; ++e) bon += rv[e] * 0.5f * kds[e] * pp[6 * 64 + e];
                    *(u32x4*)(GATE + (size_t)trow * D + cb) = gpk[p];
                }
            }
            if (lat) { bon += __shfl_xor(bon, 16); bon += __shfl_xor(bon, 32); if (q == 0) BONUS[(size_t)trow * NH + h] = bon; }
        }
    }
}

#undef FIN_LOAD
typedef unsigned short u16;
typedef short s16x4 __attribute__((ext_vector_type(4)));
constexpr int SC_PITCHB = 144;
constexpr int SET_R = 0, SET_P = 2304, SET_BH = 4608, SET_KH = 6912, SET_V = 9216, SET_TLM = 11520, SET_G = 13312, SET_BYTES = 13568;
constexpr int TLM_PITCHB = 112;
constexpr int SCR_OFF = 8 * SET_BYTES, SCR_BYTES = 2304;
static_assert(SCR_OFF + 4 * SCR_BYTES <= CTL_OFF, "scan LDS map");

__device__ __forceinline__ f32x4 mfma16(u32x4 a, u32x4 b, f32x4 c) {
    return __builtin_amdgcn_mfma_f32_16x16x32_bf16(__builtin_bit_cast(bf16x8, a), __builtin_bit_cast(bf16x8, b), c, 0, 0, 0);
}
__device__ __forceinline__ u32x4 opnd(f32x4 d) { u32x4 w; w.x = cvt_pk_bf16(d[0], d[1]); w.y = cvt_pk_bf16(d[2], d[3]); w.z = 0u; w.w = 0u; return w; }
__device__ __forceinline__ f32x4 mfma16h(u32x2 a, u32x2 b, f32x4 c) { return __builtin_amdgcn_mfma_f32_16x16x16bf16_1k(__builtin_bit_cast(s16x4, a), __builtin_bit_cast(s16x4, b), c, 0, 0, 0); }
__device__ __forceinline__ u32x2 opnd2(f32x4 d) { u32x2 w; w.x = cvt_pk_bf16(d[0], d[1]); w.y = cvt_pk_bf16(d[2], d[3]); return w; }
__device__ __forceinline__ unsigned tr_addr(unsigned matbase, int pitchb, int r0, int c0, int rho) { return matbase + (unsigned)((r0 + (rho >> 2)) * pitchb + (c0 + 4 * (rho & 3)) * 2); }

__device__ __forceinline__ int scan_row(int b, int dir, int s) {
    if (s < TCX) return M + b * TCX + (dir ? (TCX - 1 - s) : s);
    const int u = s - TCX; return b * T + (dir ? (T - 1 - u) : u);
}

__device__ __forceinline__ void scan_produce_tail(LAS unsigned char* set, LAS unsigned char* scr, int rho, int q) {
                asm volatile("s_waitcnt lgkmcnt(0)" ::: "memory");
                u32x4 fA[2], fB[2], fK[2], fR[2];
#pragma unroll
                for (int ks = 0; ks < 2; ++ks) { const int fo = rho * SC_PITCHB + (32 * ks + 8 * q) * 2;
                    fA[ks] = *(const LAS u32x4*)(scr + fo); fB[ks] = *(const LAS u32x4*)(set + SET_BH + fo); fK[ks] = *(const LAS u32x4*)(set + SET_KH + fo); fR[ks] = *(const LAS u32x4*)(set + SET_R + fo); }
                const f32x4 z4 = (f32x4){0.f, 0.f, 0.f, 0.f};
                f32x4 Lt = mfma16(fB[1], fA[1], mfma16(fB[0], fA[0], z4));
                f32x4 L  = mfma16(fA[1], fB[1], mfma16(fA[0], fB[0], z4));
                f32x4 Lk = mfma16(fA[1], fK[1], mfma16(fA[0], fK[0], z4));
                f32x4 Mb = mfma16(fB[1], fR[1], mfma16(fB[0], fR[0], z4));
                f32x4 Mk = mfma16(fK[1], fR[1], mfma16(fK[0], fR[0], z4));
                f32x4 Tt;
#pragma unroll
                for (int r = 0; r < 4; ++r) { const int rr_ = 4 * q + r;
                    Lt[r] = rr_ < rho ? Lt[r] : 0.f; Mb[r] = rr_ <= rho ? Mb[r] : 0.f; Mk[r] = rr_ <= rho ? Mk[r] : 0.f;
                    L[r] = rho < rr_ ? L[r] : 0.f; Lk[r] = rho < rr_ ? Lk[r] : 0.f;
                    Tt[r] = Lt[r] + (rr_ == rho ? 1.0f : 0.f); }
                { u32x2 w; w.x = cvt_pk_bf16(Mb[0], Mb[1]); w.y = cvt_pk_bf16(Mb[2], Mb[3]); *(LAS u32x2*)(set + SET_TLM + rho * TLM_PITCHB + (16 + 4 * q) * 2) = w;
                  w.x = cvt_pk_bf16(Mk[0], Mk[1]); w.y = cvt_pk_bf16(Mk[2], Mk[3]); *(LAS u32x2*)(set + SET_TLM + rho * TLM_PITCHB + (32 + 4 * q) * 2) = w; }
                const u32x2 oL = opnd2(L), oLt = opnd2(Lt);
                f32x4 X = mfma16h(oLt, oL, z4), Xt = mfma16h(oL, oLt, z4);
                u32x2 oX = opnd2(X), oXt = opnd2(Xt);
                Tt = mfma16h(oX, opnd2(Tt), Tt);
                X = mfma16h(oXt, oX, z4); Xt = mfma16h(oX, oXt, z4);
                oX = opnd2(X); oXt = opnd2(Xt);
                Tt = mfma16h(oX, opnd2(Tt), Tt);
                X = mfma16h(oXt, oX, z4);
                oX = opnd2(X);
                Tt = mfma16h(oX, opnd2(Tt), Tt);
                const u32x2 oT = opnd2(Tt);
                { const f32x4 tl = mfma16h(opnd2(Lk), oT, z4);
                  u32x2 w; w.x = cvt_pk_bf16(tl[0], tl[1]); w.y = cvt_pk_bf16(tl[2], tl[3]); *(LAS u32x2*)(set + SET_TLM + rho * TLM_PITCHB + (4 * q) * 2) = w; }
                {
                    const LAS unsigned char* ab = scr + (4 * q + (rho >> 2)) * SC_PITCHB + (4 * (rho & 3)) * 2;
                    const u32x2 t0 = __builtin_bit_cast(u32x2, __builtin_amdgcn_ds_read_tr16_b64_v4i16((LAS s16x4*)(ab))), t1 = __builtin_bit_cast(u32x2, __builtin_amdgcn_ds_read_tr16_b64_v4i16((LAS s16x4*)(ab + 32))),
                                t2 = __builtin_bit_cast(u32x2, __builtin_amdgcn_ds_read_tr16_b64_v4i16((LAS s16x4*)(ab + 64))), t3 = __builtin_bit_cast(u32x2, __builtin_amdgcn_ds_read_tr16_b64_v4i16((LAS s16x4*)(ab + 96)));
                    const f32x4 p0 = mfma16h(t0, oT, z4), p1 = mfma16h(t1, oT, z4);
                    const f32x4 p2 = mfma16h(t2, oT, z4), p3 = mfma16h(t3, oT, z4);
                    LAS unsigned char* pr = set + SET_P + rho * SC_PITCHB + (4 * q) * 2;
                    u32x2 w;
                    w.x = cvt_pk_bf16(p0[0], p0[1]); w.y = cvt_pk_bf16(p0[2], p0[3]); *(LAS u32x2*)(pr + 0) = w;
                    w.x = cvt_pk_bf16(p1[0], p1[1]); w.y = cvt_pk_bf16(p1[2], p1[3]); *(LAS u32x2*)(pr + 32) = w;
                    w.x = cvt_pk_bf16(p2[0], p2[1]); w.y = cvt_pk_bf16(p2[2], p2[3]); *(LAS u32x2*)(pr + 64) = w;
                    w.x = cvt_pk_bf16(p3[0], p3[1]); w.y = cvt_pk_bf16(p3[2], p3[3]); *(LAS u32x2*)(pr + 96) = w;
                }
                asm volatile("s_waitcnt lgkmcnt(0)" ::: "memory");
}

constexpr int WF_OFF = SCR_OFF + 8 * 2304, GF_OFF = WF_OFF + 16384, PRM_OFF = GF_OFF + 10240, FLG_OFF = PRM_OFF + 5 * 64 * 4;
static_assert(FLG_OFF + 64 <= CTL_OFF, "fused scan LDS map");
template <int DIR>
__device__ __forceinline__ void scan_producer(const Args& a, LAS unsigned char* lds, int lane, int p, int b, int h) {
    unsigned char* ws = a.ws;
    const int rho = lane & 15, q = lane >> 4, nr0 = lane >> 3, cc = lane & 7, bh = b * NH + h;
    constexpr int NR = NCHK / 4;
    const LAS float* PRM = (const LAS float*)(lds + PRM_OFF);
    const bf16_t* L1W = (const bf16_t*)(ws + WS_L1W); const bf16_t* L1A = (const bf16_t*)(ws + WS_L1A); const bf16_t* L1G = (const bf16_t*)(ws + WS_L1G);
    const bf16_t* KR = (const bf16_t*)(ws + WS_KRAW); const bf16_t* RB = (const bf16_t*)(ws + WS_R); const bf16_t* VB = (const bf16_t*)(ws + WS_V);
    bf16_t* GATE = (bf16_t*)(ws + WS_GATE); float* BON = (float*)(ws + (DIR ? WS_BONUS1 : WS_BONUS));
    bf16x8 n_tw[2], n_ta[2], n_tg[5]; u32x4 n_kv[2], n_rv[2], n_vv[2];
#define FS_NATC(chv) (DIR ? ((chv) < TCX / 16 ? TCX / 16 - 1 - (chv) : NCHK + TCX / 16 - 1 - (chv)) : (chv))
#define FS_TROW(natc) ((natc) < TCX / 16 ? M + b * TCX + 16 * (natc) + rho : b * T + 16 * (natc) - TCX + rho)
#define FS_LOAD_A(chv) do { const int natc_ = FS_NATC(chv); const bool lat_ = natc_ >= TCX / 16; const int trow_ = FS_TROW(natc_); \
        _Pragma("unroll") for (int s_ = 0; s_ < 2; ++s_) { n_tw[s_] = *(const bf16x8*)(L1W + (size_t)trow_ * 256 + DIR * 64 + 32 * s_ + 8 * q); n_ta[s_] = *(const bf16x8*)(L1A + (size_t)trow_ * 256 + DIR * 64 + 32 * s_ + 8 * q); } \
        { const int trg_ = lat_ ? trow_ : rho; _Pragma("unroll") for (int s_ = 0; s_ < 5; ++s_) n_tg[s_] = *(const bf16x8*)(L1G + (size_t)trg_ * 256 + 32 * s_ + 8 * q); } } while (0)
#define FS_LOAD_B(chv) do { const int natc_ = FS_NATC(chv); \
        const size_t hb_ = ((size_t)bh * NPOS + 16 * natc_ + rho) * 64; \
        _Pragma("unroll") for (int p_ = 0; p_ < 2; ++p_) { n_kv[p_] = *(const u32x4*)(KR + hb_ + p_ * 32 + 8 * q); n_rv[p_] = *(const u32x4*)(RB + hb_ + p_ * 32 + 8 * q); } \
        const size_t vo_ = ((size_t)bh * NPOS + 16 * natc_ + nr0) * 64 + 8 * cc; \
        n_vv[0] = *(const u32x4*)(VB + vo_); n_vv[1] = *(const u32x4*)(VB + vo_ + 512); } while (0)
    FS_LOAD_A(p); FS_LOAD_B(p);
    for (int n = 0; n < NR; ++n) {
        const int ch = 4 * n + p, natc = FS_NATC(ch); const bool lat = natc >= TCX / 16; const int trow = FS_TROW(natc);
        LAS unsigned char* set = lds + ((n & 1) * 4 + p) * SET_BYTES;
        LAS unsigned char* scr = lds + SCR_OFF + ((n & 1) * 4 + p) * 2304;
        f32x4 aw[2][2], aa[2][2]; u32x4 gpk = (u32x4){0u, 0u, 0u, 0u};
#pragma unroll
        for (int pp = 0; pp < 2; ++pp)
#pragma unroll
            for (int nn = 0; nn < 2; ++nn) { aw[pp][nn] = (f32x4){0.f, 0.f, 0.f, 0.f}; aa[pp][nn] = (f32x4){0.f, 0.f, 0.f, 0.f};
#pragma unroll
                for (int s = 0; s < 2; ++s) {
                    const bf16x8 fw = *(const LAS bf16x8*)(lds + WF_OFF + (pp * 4 + nn * 2 + s) * 1024 + lane * 16);
                    const bf16x8 fa = *(const LAS bf16x8*)(lds + WF_OFF + (8 + pp * 4 + nn * 2 + s) * 1024 + lane * 16);
                    aw[pp][nn] = __builtin_amdgcn_mfma_f32_16x16x32_bf16(fw, n_tw[s], aw[pp][nn], 0, 0, 0);
                    aa[pp][nn] = __builtin_amdgcn_mfma_f32_16x16x32_bf16(fa, n_ta[s], aa[pp][nn], 0, 0, 0); } }
        if (lat) {
#pragma unroll
            for (int nn = 0; nn < 2; ++nn) { f32x4 ag = (f32x4){0.f, 0.f, 0.f, 0.f};
#pragma unroll
                for (int s = 0; s < 5; ++s) { const bf16x8 fg = *(const LAS bf16x8*)(lds + GF_OFF + (nn * 5 + s) * 1024 + lane * 16);
                    ag = __builtin_amdgcn_mfma_f32_16x16x32_bf16(fg, n_tg[s], ag, 0, 0, 0); }
                if (nn == 0) { gpk.x = cvt_pk_bf16(ag[0], ag[1]); gpk.y = cvt_pk_bf16(ag[2], ag[3]); } else { gpk.z = cvt_pk_bf16(ag[0], ag[1]); gpk.w = cvt_pk_bf16(ag[2], ag[3]); } }
        }
        const int chn = n + 1 < NR ? ch + 4 : ch;
        FS_LOAD_A(chn);
        float ssq = 0.f, bon = 0.f;
#pragma unroll
        for (int pp = 0; pp < 2; ++pp) { float kvt[8]; unpack8(pp ? n_kv[1] : n_kv[0], kvt);
#pragma unroll
            for (int e = 0; e < 8; ++e) { const float kr = kvt[e] * PRM[2 * 64 + pp * 32 + 8 * q + e]; ssq += kr * kr; } }
        ssq += __shfl_xor(ssq, 16); ssq += __shfl_xor(ssq, 32);
        const float inv = rsqrtf(fmaxf(ssq, 1e-24f));
        const int tau = DIR ? 15 - rho : rho;
#pragma unroll
        for (int pp = 0; pp < 2; ++pp) {
            const int cl = pp * 32 + 8 * q;
            const LAS float* pr = PRM + cl;
            float kv[8], rv[8], oA[8], oB[8], oK[8], oR[8], gc[8];
            unpack8(pp ? n_kv[1] : n_kv[0], kv);
            if (lat) unpack8(pp ? n_rv[1] : n_rv[0], rv); else { for (int e = 0; e < 8; ++e) rv[e] = 0.f; }
#pragma unroll
            for (int e = 0; e < 8; ++e) {
                const int nn = e >> 2, i = e & 3;
                const float dl = -0.87503877f * __builtin_amdgcn_rcpf(1.0f + __builtin_amdgcn_exp2f(aw[pp][nn][i] + pr[e]));
                const float ic = __builtin_amdgcn_rcpf(1.0f + __builtin_amdgcn_exp2f(aa[pp][nn][i] + pr[64 + e]));
                float cum = dl, epv;
                if (DIR == 0) { cum += dpp_mov<0x111>(cum); cum += dpp_mov<0x112>(cum); cum += dpp_mov<0x114>(cum); cum += dpp_mov<0x118>(cum); }
                else          { cum += dpp_mov<0x101>(cum); cum += dpp_mov<0x102>(cum); cum += dpp_mov<0x104>(cum); cum += dpp_mov<0x108>(cum); }
                const float ec = __builtin_amdgcn_exp2f(cum), en = __builtin_amdgcn_rcpf(ec);
                if (DIR == 0) { epv = dpp_mov<0x111>(ec); if (rho == 0) epv = 1.0f; } else { epv = dpp_mov<0x101>(ec); if (rho == 15) epv = 1.0f; }
                const float kk = kv[e] * pr[2 * 64 + e] * inv, bq = kk * ic, kd = kv[e] * (1.0f + (ic - 1.0f) * pr[3 * 64 + e]);
                oA[e] = -kk * epv; oB[e] = bq * en; oK[e] = kd * en; oR[e] = rv[e] * ec; gc[e] = ec;
                bon += rv[e] * kd * pr[4 * 64 + e];
            }
            const int ro = tau * SC_PITCHB + cl * 2;
            *(LAS u32x4*)(scr + ro) = pack8v(oA); *(LAS u32x4*)(set + SET_BH + ro) = pack8v(oB); *(LAS u32x4*)(set + SET_KH + ro) = pack8v(oK); *(LAS u32x4*)(set + SET_R + ro) = pack8v(oR);
            if (rho == (DIR ? 0 : 15)) { *(LAS f32x4*)(set + SET_G + cl * 4) = (f32x4){gc[0], gc[1], gc[2], gc[3]}; *(LAS f32x4*)(set + SET_G + cl * 4 + 16) = (f32x4){gc[4], gc[5], gc[6], gc[7]}; }
            asm volatile("" ::: "memory");
        }
        { const int t0 = DIR ? 15 - nr0 : nr0, t1 = DIR ? 7 - nr0 : nr0 + 8;
          *(LAS u32x4*)(set + SET_V + t0 * SC_PITCHB + 16 * cc) = n_vv[0]; *(LAS u32x4*)(set + SET_V + t1 * SC_PITCHB + 16 * cc) = n_vv[1]; }
        FS_LOAD_B(chn);
        {
            bf16_t* gd = lat ? GATE + (size_t)trow * D + h * 64 + DIR * 32 + 8 * q : (bf16_t*)(ws + WS_DUMP) + 8 * lane;
            *(u32x4*)gd = gpk;
            bon += __shfl_xor(bon, 16); bon += __shfl_xor(bon, 32);
            float* bd = (lat && q == 0) ? BON + (size_t)trow * NH + h : (float*)(ws + WS_DUMP + 1024) + lane;
            *bd = bon;
        }
        asm volatile("s_waitcnt lgkmcnt(0)" ::: "memory");
        __syncthreads();
    }
#undef FS_LOAD_A
#undef FS_LOAD_B
#undef FS_TROW
#undef FS_NATC
}

__device__ __forceinline__ void phase_scan_chunked(const Args& a, LAS unsigned char* lds, int tid, int lane, int wave, int G) {
    unsigned char* ws = a.ws;
    const bf16_t* VB = (const bf16_t*)(ws + WS_V);
    const int rho = lane & 15, q = lane >> 4;
    const unsigned ldsb = (unsigned)(size_t)lds;
    constexpr int NCH = NPOS / 16, NR = NCH / 4;
    for (int unit = blockIdx.x; unit < 2 * NB * NH; unit += G) {
        const int b = unit & 7, h = (unit >> 3) & 15, dir = unit >> 7, bh = b * NH + h;
        bf16_t* Yout = (bf16_t*)(ws + (dir ? WS_YB : WS_YF));
        __syncthreads();
        {
            const bf16_t* W2W = (const bf16_t*)(ws + WS_W2W); const bf16_t* W2A = (const bf16_t*)(ws + WS_W2A); const bf16_t* W2G = (const bf16_t*)(ws + WS_W2G);
            for (int f = wave; f < 26; f += NWAVES) {
                const bf16_t* src;
                if (f < 16) { const int mat = f >> 3, pp = (f >> 2) & 1, nn = (f >> 1) & 1, sx = f & 1; const int chn = h * 64 + pp * 32 + 8 * (rho >> 2) + 4 * nn + (rho & 3);
                    src = (mat ? W2A : W2W) + ((size_t)dir * D + chn) * 64 + 32 * sx + 8 * q; }
                else { const int r = f - 16, nn = r / 5, sx = r % 5; const int chn = h * 64 + dir * 32 + 8 * (rho >> 2) + 4 * nn + (rho & 3); src = W2G + (size_t)chn * 160 + 32 * sx + 8 * q; }
                *(LAS u32x4*)(lds + WF_OFF + f * 1024 + lane * 16) = *(const u32x4*)src;
            }
            if (tid < 4) ((LAS int*)(lds + FLG_OFF))[tid] = 0;
            if (tid < 320) { const int arr = tid >> 6, c = tid & 63;
                ((LAS float*)(lds + PRM_OFF))[tid] = arr == 0 ? -1.44269504f * a.in[9][dir * D + h * 64 + c] : arr == 1 ? -1.44269504f * a.in[12][dir * D + h * 64 + c] : arr == 2 ? a.in[17][h * 64 + c] : arr == 3 ? a.in[18][h * 64 + c] : 0.5f * a.in[19][h * 64 + c]; }
            __syncthreads();
        }
        if (wave >= 4) {
            if (dir == 0) scan_producer<0>(a, lds, lane, wave - 4, b, h); else scan_producer<1>(a, lds, lane, wave - 4, b, h);
            __syncthreads();
        } else {
            f32x4 S[4];
#pragma unroll
            for (int jb = 0; jb < 4; ++jb) S[jb] = (f32x4){0.f, 0.f, 0.f, 0.f};
            const f32x4 z4 = (f32x4){0.f, 0.f, 0.f, 0.f};
            const int trb = (4 * q + (rho >> 2)) * SC_PITCHB + (4 * (rho & 3)) * 2;
            const int rowb = rho * SC_PITCHB + (4 * q) * 2, tlmb = SET_TLM + rho * TLM_PITCHB + (4 * q) * 2;
#define TRRD(p) __builtin_bit_cast(u32x2, __builtin_amdgcn_ds_read_tr16_b64_v4i16((LAS s16x4*)(p)))
#define C_LOAD(X, st) \
            LAS unsigned char* const X##bptr = (st); \
            const u32x2 X##tv = TRRD((st) + SET_V + trb + 32 * wave); \
            const u32x2 X##tb0 = TRRD((st) + SET_BH + trb), X##tb1 = TRRD((st) + SET_BH + trb + 32), X##tb2 = TRRD((st) + SET_BH + trb + 64), X##tb3 = TRRD((st) + SET_BH + trb + 96); \
            const u32x2 X##tk0 = TRRD((st) + SET_KH + trb), X##tk1 = TRRD((st) + SET_KH + trb + 32), X##tk2 = TRRD((st) + SET_KH + trb + 64), X##tk3 = TRRD((st) + SET_KH + trb + 96); \
            const u32x2 X##pa = *(const LAS u32x2*)((st) + SET_P + rowb), X##pb = *(const LAS u32x2*)((st) + SET_P + rowb + 32), X##pc = *(const LAS u32x2*)((st) + SET_P + rowb + 64), X##pd = *(const LAS u32x2*)((st) + SET_P + rowb + 96); \
            const u32x2 X##tl = *(const LAS u32x2*)((st) + tlmb);
#define C_COMPUTE(X, chv) do { const int ch_ = (chv); \
            const f32x4 X##g0 = *(const LAS f32x4*)(X##bptr + SET_G + 16 * q), X##g1 = *(const LAS f32x4*)(X##bptr + SET_G + 16 * q + 64), X##g2 = *(const LAS f32x4*)(X##bptr + SET_G + 16 * q + 128), X##g3 = *(const LAS f32x4*)(X##bptr + SET_G + 16 * q + 192); \
            u32x4 bs0, bs1; \
            bs0.x = cvt_pk_bf16(S[0][0], S[0][1]); bs0.y = cvt_pk_bf16(S[0][2], S[0][3]); bs0.z = cvt_pk_bf16(S[1][0], S[1][1]); bs0.w = cvt_pk_bf16(S[1][2], S[1][3]); \
            bs1.x = cvt_pk_bf16(S[2][0], S[2][1]); bs1.y = cvt_pk_bf16(S[2][2], S[2][3]); bs1.z = cvt_pk_bf16(S[3][0], S[3][1]); bs1.w = cvt_pk_bf16(S[3][2], S[3][3]); \
            f32x4 U = mfma16h(X##tl, X##tv, z4); \
            U = mfma16((u32x4){X##pa.x, X##pa.y, X##pb.x, X##pb.y}, bs0, U); \
            U = mfma16((u32x4){X##pc.x, X##pc.y, X##pd.x, X##pd.y}, bs1, U); \
            u32x4 buv; buv.x = cvt_pk_bf16(U[0], U[1]); buv.y = cvt_pk_bf16(U[2], U[3]); buv.z = X##tv.x; buv.w = X##tv.y; \
            S[0] = mfma16((u32x4){X##tb0.x, X##tb0.y, X##tk0.x, X##tk0.y}, buv, S[0]) * X##g0; \
            S[1] = mfma16((u32x4){X##tb1.x, X##tb1.y, X##tk1.x, X##tk1.y}, buv, S[1]) * X##g1; \
            S[2] = mfma16((u32x4){X##tb2.x, X##tb2.y, X##tk2.x, X##tk2.y}, buv, S[2]) * X##g2; \
            S[3] = mfma16((u32x4){X##tb3.x, X##tb3.y, X##tk3.x, X##tk3.y}, buv, S[3]) * X##g3; \
            if (ch_ >= TCX / 16) { \
                const u32x2 X##ra = *(const LAS u32x2*)(X##bptr + SET_R + rowb), X##rb = *(const LAS u32x2*)(X##bptr + SET_R + rowb + 32), X##rc = *(const LAS u32x2*)(X##bptr + SET_R + rowb + 64), X##rd = *(const LAS u32x2*)(X##bptr + SET_R + rowb + 96); \
                const u32x2 X##mrb = *(const LAS u32x2*)(X##bptr + tlmb + 32), X##mrk = *(const LAS u32x2*)(X##bptr + tlmb + 64); \
                f32x4 Yv = mfma16((u32x4){X##ra.x, X##ra.y, X##rb.x, X##rb.y}, bs0, z4); \
                Yv = mfma16((u32x4){X##rc.x, X##rc.y, X##rd.x, X##rd.y}, bs1, Yv); \
                Yv = mfma16((u32x4){X##mrb.x, X##mrb.y, X##mrk.x, X##mrk.y}, buv, Yv); \
                _Pragma("unroll") for (int r = 0; r < 4; ++r) { const int row = scan_row(b, dir, 16 * ch_ + 4 * q + r); \
                    Yout[(size_t)row * D + h * 64 + 16 * wave + rho] = (bf16_t)(cvt_pk_bf16(Yv[r], 0.f) & 0xffffu); } } } while (0)
            volatile LAS int* flg = (volatile LAS int*)(lds + FLG_OFF);
            __syncthreads();
            for (int n = 1; n <= NR; ++n) {
                LAS unsigned char* sbase = lds + (((n - 1) & 1) * 4) * SET_BYTES;
                const int ch0 = 4 * (n - 1);
                scan_produce_tail(sbase + wave * SET_BYTES, lds + SCR_OFF + (((n - 1) & 1) * 4 + wave) * 2304, rho, q);
                asm volatile("s_waitcnt lgkmcnt(0)" ::: "memory");
                if (lane == 0) flg[wave] = n;
                asm volatile("s_waitcnt lgkmcnt(0)" ::: "memory");
#define C_WAIT(c) do { while (flg[(c)] < n) __builtin_amdgcn_s_sleep(1); asm volatile("" ::: "memory"); } while (0)
#pragma unroll 1
                for (int cc = 0; cc < 4; ++cc) { C_WAIT(cc); { C_LOAD(a_, sbase + cc * SET_BYTES) C_COMPUTE(a_, ch0 + cc); } }
                __syncthreads();
            }
#undef C_WAIT
#undef C_LOAD
#undef C_COMPUTE
#undef TRRD
        }
    }
}

__device__ __forceinline__ void phase_readout(const Args& a, int gw, int NGW, int lane) {
    unsigned char* ws = a.ws;
    const bf16_t* YF = (const bf16_t*)(ws + WS_YF); const bf16_t* YB = (const bf16_t*)(ws + WS_YB); const bf16_t* VB = (const bf16_t*)(ws + WS_V); const bf16_t* GATE = (const bf16_t*)(ws + WS_GATE);
    const float* BONUS = (const float*)(ws + WS_BONUS); const float* BONUS1 = (const float*)(ws + WS_BONUS1); bf16_t* OG = (bf16_t*)(ws + WS_OG);
    float lw[16], lb[16];
#pragma unroll
    for (int e = 0; e < 16; e += 4) { const f32x4 w4 = ld4(a.in[20] + 16 * lane + e), b4 = ld4(a.in[21] + 16 * lane + e);
#pragma unroll
        for (int i = 0; i < 4; ++i) { lw[e + i] = w4[i]; lb[e + i] = b4[i]; } }
    u32x4 pyf[2], pyb[2], pv[2], pg[2]; float pbon = 0.f;
#define RO_LOAD(rowv) do { const int row_ = (rowv); const size_t off_ = (size_t)row_ * D + 16 * lane; \
        const size_t vo_ = ((size_t)(hm_row(row_) + (lane >> 2) * NPOS)) * 64 + 16 * (lane & 3); \
        pyf[0] = *(const u32x4*)(YF + off_); pyf[1] = *(const u32x4*)(YF + off_ + 8); pyb[0] = *(const u32x4*)(YB + off_); pyb[1] = *(const u32x4*)(YB + off_ + 8); \
        pv[0] = *(const u32x4*)(VB + vo_); pv[1] = *(const u32x4*)(VB + vo_ + 8); pg[0] = *(const u32x4*)(GATE + off_); pg[1] = *(const u32x4*)(GATE + off_ + 8); \
        pbon = BONUS[(size_t)row_ * NH + (lane >> 2)] + BONUS1[(size_t)row_ * NH + (lane >> 2)]; } while (0)
    if (gw < M) RO_LOAD(gw);
    for (int row = gw; row < M; row += NGW) {
        const size_t off = (size_t)row * D + 16 * lane;
        float y[16], t8[8], vv[16], gg[16], o[16];
        unpack8(pyf[0], y); unpack8(pyf[1], y + 8);
        unpack8(pyb[0], t8);
#pragma unroll
        for (int e = 0; e < 8; ++e) y[e] += t8[e];
        unpack8(pyb[1], t8);
#pragma unroll
        for (int e = 0; e < 8; ++e) y[8 + e] += t8[e];
        unpack8(pv[0], vv); unpack8(pv[1], vv + 8); unpack8(pg[0], gg); unpack8(pg[1], gg + 8);
        const float bon = pbon;
        if (row + NGW < M) RO_LOAD(row + NGW);
        float sm = 0.f;
#pragma unroll
        for (int e = 0; e < 16; ++e) sm += y[e];
        sm += __shfl_xor(sm, 1); sm += __shfl_xor(sm, 2);
        const float mean = sm * (1.0f / 64.0f);
        float vr = 0.f;
#pragma unroll
        for (int e = 0; e < 16; ++e) { y[e] -= mean; vr += y[e] * y[e]; }
        vr += __shfl_xor(vr, 1); vr += __shfl_xor(vr, 2);
        const float rs = rsqrtf(vr * (1.0f / 64.0f) + GN_EPS);
#pragma unroll
        for (int e = 0; e < 16; ++e) o[e] = (y[e] * rs * lw[e] + lb[e] + bon * vv[e]) * gg[e];
        *(u32x4*)(OG + off) = pack8(o); *(u32x4*)(OG + off + 8) = pack8(o + 8);
    }
#undef RO_LOAD
}

template <int MODE>
__device__ __forceinline__ void phase_rowpass(const Args& a, LAS unsigned char* lds, int tid, int lane, int wave, int G) {
    unsigned char* ws = a.ws;
    const float* mods = (const float*)(ws + WS_MODS);
    const float* ng = a.in[6];
    const bf16_t* Y0 = (const bf16_t*)(ws + WS_Y0); bf16_t* XR = (bf16_t*)(ws + WS_XR); bf16_t* HB = (bf16_t*)(ws + WS_HB);
    const bf16_t* YS = (const bf16_t*)(ws + WS_YS);
    const int lpost = MODE < 2 ? 0 : 1, gtoff = (MODE == 0 || MODE == 2) ? 2048 : 5120, gpost = (MODE == 0 || MODE == 2) ? 1 : 3;
    const int lpre = MODE == 0 ? 0 : 1, gpre = MODE == 0 ? 2 : (MODE == 1 ? 0 : 2), shoff = MODE == 1 ? 0 : 3072, scoff = MODE == 1 ? 1024 : 4096;
    LAS int* lcnt = (LAS int*)lds;
    LAS int* linfo = (LAS int*)(lds + 256);
    LAS float* lwr = (LAS float*)(lds + 4096);
    int* CNT = (int*)(ws + WS_CTL);
    if (MODE == 2) {
        if (tid < 16) lcnt[tid] = 0;
        for (int i = tid; i < D * NE / 4; i += NTHREADS) *(LAS f32x4*)(lwr + 4 * i) = ld4(a.in[28] + 4 * i);
        __syncthreads();
    }
    const int rpb = (M + G - 1) / G;
    const int r0 = blockIdx.x * rpb, r1 = (r0 + rpb) < M ? (r0 + rpb) : M;
    const int nrw = (r1 - r0 - wave + NWAVES - 1) / NWAVES;
    const int bt = r0 / T;
    const float* mdp = mods + (size_t)(lpost * 9 + bt) * 6144;
    const float* mdn = mods + (size_t)(lpre * 9 + bt) * 6144;
    f32x4 cgt[4], cgp[4], cgn[4], csh[4];
#pragma unroll
    for (int j = 0; j < 4; ++j) { const int c = 4 * lane + 256 * j;
        cgt[j] = ld4(mdp + gtoff + c) * ld4(ng + (lpost * 4 + gpost) * D + c);
        if (MODE != 3) { cgn[j] = ld4(ng + (lpre * 4 + gpre) * D + c) * (1.0f + ld4(mdn + scoff + c)); csh[j] = ld4(mdn + shoff + c); } }
    int sl1 = 0, sl2 = 0; float gg1 = 0.f, gg2 = 0.f;
    if (MODE == 3) {
        int pst[NE]; int acc = 0;
#pragma unroll
        for (int e = 0; e < NE; ++e) { pst[e] = acc; acc += (CNT[e] + 255) & ~255; }
        if (lane < nrw) { const int row = r0 + wave + NWAVES * lane;
            const int* TP = (const int*)(ws + WS_TPOS); const int* TE = (const int*)(ws + WS_TOPE); const float* TG = (const float*)(ws + WS_TOPG);
            const int e1 = TE[2 * row], e2 = TE[2 * row + 1]; sl1 = TP[2 * row]; sl2 = TP[2 * row + 1];
#pragma unroll
            for (int e = 0; e < NE; ++e) { if (e == e1) sl1 += pst[e]; if (e == e2) sl2 += pst[e]; }
            gg1 = TG[2 * row]; gg2 = TG[2 * row + 1]; }
    }
    u32x2 pf[4], pf2[4], pxb[4]; f32x4 pxf[4];
#define RP_LOAD(k) do { const int row_ = r0 + wave + NWAVES * (k); \
        if (MODE == 3) { const int s1_ = __builtin_amdgcn_readlane(sl1, (k)), s2_ = __builtin_amdgcn_readlane(sl2, (k)); \
            _Pragma("unroll") for (int j = 0; j < 4; ++j) { pf[j] = *(const u32x2*)(YS + (size_t)s1_ * D + 4 * lane + 256 * j); pf2[j] = *(const u32x2*)(YS + (size_t)s2_ * D + 4 * lane + 256 * j); } } \
        else { _Pragma("unroll") for (int j = 0; j < 4; ++j) pf[j] = *(const u32x2*)(Y0 + (size_t)row_ * D + 4 * lane + 256 * j); } \
        if (MODE == 0) { _Pragma("unroll") for (int j = 0; j < 4; ++j) pxf[j] = ld4(a.in[0] + (size_t)row_ * D + 4 * lane + 256 * j); } \
        else { _Pragma("unroll") for (int j = 0; j < 4; ++j) pxb[j] = *(const u32x2*)(XR + (size_t)row_ * D + 4 * lane + 256 * j); } } while (0)
    if (nrw > 0) RP_LOAD(0);
    for (int k = 0; k < nrw; ++k) {
        const int row = r0 + wave + NWAVES * k;
        f32x4 f[4], xr[4];
#pragma unroll
        for (int j = 0; j < 4; ++j) { float y1[4]; unpack4(pf[j], y1);
            if (MODE == 3) { float y2[4]; unpack4(pf2[j], y2);
                const float g1 = __builtin_bit_cast(float, __builtin_amdgcn_readlane(__builtin_bit_cast(int, gg1), k)), g2 = __builtin_bit_cast(float, __builtin_amdgcn_readlane(__builtin_bit_cast(int, gg2), k));
                f[j] = (f32x4){g1 * y1[0] + g2 * y2[0], g1 * y1[1] + g2 * y2[1], g1 * y1[2] + g2 * y2[2], g1 * y1[3] + g2 * y2[3]}; }
            else f[j] = (f32x4){y1[0], y1[1], y1[2], y1[3]};
            if (MODE == 0) xr[j] = pxf[j]; else { float x1[4]; unpack4(pxb[j], x1); xr[j] = (f32x4){x1[0], x1[1], x1[2], x1[3]}; } }
        if (k + 1 < nrw) RP_LOAD(k + 1);
        float ss = 0.f;
#pragma unroll
        for (int j = 0; j < 4; ++j) ss += f[j][0] * f[j][0] + f[j][1] * f[j][1] + f[j][2] * f[j][2] + f[j][3] * f[j][3];
        ss = wave_sum(ss);
        const float rs = rsqrtf(ss * (1.0f / D) + NORM_EPS);
        float ss2 = 0.f;
#pragma unroll
        for (int j = 0; j < 4; ++j) {
            xr[j] = xr[j] + cgt[j] * (f[j] * rs);
            ss2 += xr[j][0] * xr[j][0] + xr[j][1] * xr[j][1] + xr[j][2] * xr[j][2] + xr[j][3] * xr[j][3]; }
        if (MODE == 3) {
#pragma unroll
            for (int j = 0; j < 4; ++j) *(f32x4*)(a.out + (size_t)row * D + 4 * lane + 256 * j) = xr[j];
            continue;
        }
#pragma unroll
        for (int j = 0; j < 4; ++j) { u32x2 w; w.x = cvt_pk_bf16_asm(xr[j][0], xr[j][1]); w.y = cvt_pk_bf16_asm(xr[j][2], xr[j][3]); *(u32x2*)(XR + (size_t)row * D + 4 * lane + 256 * j) = w; }
        ss2 = wave_sum(ss2);
        const float rs2 = rsqrtf(ss2 * (1.0f / D) + NORM_EPS);
        float lg[NE];
#pragma unroll
        for (int e = 0; e < NE; ++e) lg[e] = 0.f;
#pragma unroll
        for (int j = 0; j < 4; ++j) { const int c = 4 * lane + 256 * j;
            const f32x4 hv = xr[j] * rs2 * cgn[j] + csh[j];
            if (MODE == 1) { u32x2 w; w.x = cvt_pk_bf16_asm(hv[0], hv[1]); w.y = cvt_pk_bf16_asm(hv[2], hv[3]); *(u32x2*)(HB + (size_t)row * D + c) = w; }
            else { int w = __builtin_amdgcn_cvt_pk_fp8_f32(hv[0], hv[1], 0, false); w = __builtin_amdgcn_cvt_pk_fp8_f32(hv[2], hv[3], w, true);
                if (MODE == 0) *(int*)((unsigned char*)HB + (size_t)row * D + c) = w; else *(LAS int*)(lds + 40960 + (row - r0) * D + c) = w; }
            if (MODE == 2) {
                const LAS float* wr = lwr + (size_t)c * NE;
#pragma unroll
                for (int i = 0; i < 4; ++i) { const f32x4 wa = *(const LAS f32x4*)(wr + i * NE), wb = *(const LAS f32x4*)(wr + i * NE + 4);
                    lg[0] += hv[i] * wa[0]; lg[1] += hv[i] * wa[1]; lg[2] += hv[i] * wa[2]; lg[3] += hv[i] * wa[3];
                    lg[4] += hv[i] * wb[0]; lg[5] += hv[i] * wb[1]; lg[6] += hv[i] * wb[2]; lg[7] += hv[i] * wb[3]; }
            }
        }
        if (MODE == 2) {
#pragma unroll
            for (int e = 0; e < NE; ++e) lg[e] = wave_sum(lg[e]);
            if (lane == 0) {
                int e1 = 0; float v1 = lg[0];
#pragma unroll
                for (int e = 1; e < NE; ++e) if (lg[e] > v1) { v1 = lg[e]; e1 = e; }
                int e2 = -1; float v2 = -3.0e38f;
#pragma unroll
                for (int e = 0; e < NE; ++e) if (e != e1 && lg[e] > v2) { v2 = lg[e]; e2 = e; }
                const float g1 = 1.0f / (1.0f + __expf(v2 - v1));
                ((int*)(ws + WS_TOPE))[2 * row] = e1; ((int*)(ws + WS_TOPE))[2 * row + 1] = e2;
                ((float*)(ws + WS_TOPG))[2 * row] = g1; ((float*)(ws + WS_TOPG))[2 * row + 1] = 1.0f - g1;
                const int p1 = atomicAdd((int*)(lcnt + e1), 1), p2 = atomicAdd((int*)(lcnt + e2), 1);
                const int lr = row - r0;
                linfo[4 * lr] = e1; linfo[4 * lr + 1] = e2; linfo[4 * lr + 2] = p1; linfo[4 * lr + 3] = p2;
            }
        }
    }
#undef RP_LOAD
    if (MODE == 2) {
        __syncthreads();
        if (tid < NE) lcnt[8 + tid] = atomicAdd(CNT + tid, lcnt[tid]);
        __syncthreads();
        int* TP = (int*)(ws + WS_TPOS);
        for (int lr = tid; lr < r1 - r0; lr += NTHREADS) {
            const int e1 = linfo[4 * lr], e2 = linfo[4 * lr + 1];
            TP[2 * (r0 + lr)] = lcnt[8 + e1] + linfo[4 * lr + 2]; TP[2 * (r0 + lr) + 1] = lcnt[8 + e2] + linfo[4 * lr + 3];
        }
        unsigned char* XS = ws + WS_XS;
        for (int pr = wave; pr < 2 * (r1 - r0); pr += NWAVES) { const int lr = pr >> 1, k = pr & 1;
            const int e = linfo[4 * lr + k], pos = lcnt[8 + e] + linfo[4 * lr + 2 + k];
            *(u32x4*)(XS + ((size_t)e * M + pos) * D + 16 * lane) = *(const LAS u32x4*)(lds + 40960 + lr * D + 16 * lane); }
    }
}

__device__ __forceinline__ void phase_conv(const Args& a, int tid, int G) {
    unsigned char* ws = a.ws;
    const bf16_t* BG = (const bf16_t*)(ws + WS_BG); const bf16_t* Z = (const bf16_t*)(ws + WS_Z); bf16_t* CV = (bf16_t*)(ws + WS_CV);
    const float* cw = a.in[24];
    const int gt = blockIdx.x * NTHREADS + tid, NGT = G * NTHREADS;
    const int c = (gt & 127) * 8;
    float w0[8], w1[8], w2[8];
#pragma unroll
    for (int e = 0; e < 8; ++e) { w0[e] = cw[c + e]; w1[e] = cw[D + c + e]; w2[e] = cw[2 * D + c + e]; }
    u32x4 pz, pp, pn, pb;
#define CV_LOAD(idxv) do { const int row_ = (idxv) >> 7, t_ = row_ % T; \
        pz = *(const u32x4*)(Z + (size_t)row_ * D + c); pb = *(const u32x4*)(BG + (size_t)row_ * D + c); \
        pp = *(const u32x4*)(Z + (size_t)(row_ - (t_ > 0 ? 1 : 0)) * D + c); pn = *(const u32x4*)(Z + (size_t)(row_ + (t_ < T - 1 ? 1 : 0)) * D + c); } while (0)
    if (gt < M * (D / 8)) CV_LOAD(gt);
    for (int idx = gt; idx < M * (D / 8); idx += NGT) {
        const int row = idx >> 7, t = row % T;
        float zc[8], zp[8], zn[8], bg[8], o[8];
        unpack8(pz, zc); unpack8(pb, bg); unpack8(pp, zp); unpack8(pn, zn);
        if (idx + NGT < M * (D / 8)) CV_LOAD(idx + NGT);
        const float mp = t > 0 ? 1.f : 0.f, mn = t < T - 1 ? 1.f : 0.f;
#pragma unroll
        for (int e = 0; e < 8; ++e) o[e] = bg[e] * (zp[e] * (w0[e] * mp) + zc[e] * w1[e] + zn[e] * (w2[e] * mn));
        *(u32x4*)(CV + (size_t)row * D + c) = pack8(o);
    }
#undef CV_LOAD
}

__device__ __forceinline__ void phase_gather(const Args& a, int gw, int NGW, int lane) {
    unsigned char* ws = a.ws;
    const int* CNT = (const int*)(ws + WS_CTL); const int* TE = (const int*)(ws + WS_TOPE); const int* TP = (const int*)(ws + WS_TPOS);
    const bf16_t* HB = (const bf16_t*)(ws + WS_HB); bf16_t* XS = (bf16_t*)(ws + WS_XS);
    int pst[NE]; { int acc = 0;
#pragma unroll
        for (int e = 0; e < NE; ++e) { pst[e] = acc; acc += (CNT[e] + 255) & ~255; } }
    for (int pr = gw; pr < 2 * M; pr += NGW) {
        const int e = TE[pr]; int slot = TP[pr];
#pragma unroll
        for (int q = 0; q < NE; ++q) if (q == e) slot += pst[q];
        const u32x4* src = (const u32x4*)((const unsigned char*)HB + (size_t)(pr >> 1) * D); u32x4* dst = (u32x4*)((unsigned char*)XS + (size_t)slot * D);
        dst[lane] = src[lane];
    }
}

#define XB_TMO      128
#define XB_XCNT(j)  (256  + 64 * (j))
#define XB_XSUB(j)  (1280 + 64 * (j))
#define XB_XGEN(j)  (2304 + 64 * (j))
#define XB_TOP      3328
#define XB_TOPGEN   3392
#define XCD_BAR_WORDS 3456
#define XB_SPIN_CAP (1u << 20)
__device__ __forceinline__ unsigned xb_ld(unsigned* p)              { return __hip_atomic_load(p, __ATOMIC_RELAXED, __HIP_MEMORY_SCOPE_AGENT); }
__device__ __forceinline__ unsigned xb_add(unsigned* p, unsigned v) { return __hip_atomic_fetch_add(p, v, __ATOMIC_RELAXED, __HIP_MEMORY_SCOPE_AGENT); }
__device__ __forceinline__ unsigned xb_xcc_id() { return (unsigned)__builtin_amdgcn_s_getreg((3 << 11) | 20) & 0xFu; }
#define XB_SPIN(cond, bar) do { unsigned _sp = 0; while (cond) { __builtin_amdgcn_s_sleep(1); \
    if ((++_sp & 255u) == 0u) { if (xb_ld(&(bar)[XB_TMO])) break; if (_sp > XB_SPIN_CAP) { atomicAdd(&(bar)[XB_TMO], 1u); break; } } } } while (0)
struct XcdBarrier { unsigned* bar; unsigned x, rank; volatile LAS unsigned* st; };
__device__ __forceinline__ void xb_st(unsigned* p, unsigned v) { __hip_atomic_store(p, v, __ATOMIC_RELAXED, __HIP_MEMORY_SCOPE_AGENT); }
__device__ __forceinline__ XcdBarrier xcd_barrier_post(unsigned* bar, volatile LAS unsigned* st) {
    XcdBarrier b; b.bar = bar; b.x = xb_xcc_id(); b.st = st; b.rank = 0u;
    if (threadIdx.x == 0) b.rank = xb_add(&bar[XB_XCNT(b.x)], 1u);
    b.rank = (unsigned)__builtin_amdgcn_readfirstlane((int)b.rank);
    return b;
}
__device__ __forceinline__ void xcd_barrier_complete(unsigned* bar, unsigned x, unsigned& nloc, unsigned& mask) {
    const unsigned G = gridDim.x * gridDim.y * gridDim.z;
    unsigned sum, mk, mine, sp = 0u;
    for (;;) {
        sum = 0u; mk = 0u; mine = 0u;
#pragma unroll
        for (unsigned j = 0; j < 16; ++j) { const unsigned c = xb_ld(&bar[XB_XCNT(j)]); sum += c; mk |= (c > 0u) ? (1u << j) : 0u; mine = (j == x) ? c : mine; }
        if (sum == G) break;
        __builtin_amdgcn_s_sleep(1);
        if ((++sp & 255u) == 0u) { if (xb_ld(&bar[XB_TMO])) break; if (sp > XB_SPIN_CAP) { atomicAdd(&bar[XB_TMO], 1u); break; } }
    }
    nloc = mine > 0u ? mine : 1u; mask = mk;
}
__device__ __forceinline__ void xcd_barrier(const XcdBarrier& b) {
    asm volatile("s_waitcnt vmcnt(0)" ::: "memory");
    __syncthreads();
    if (threadIdx.x < 64) {
        const unsigned lane = threadIdx.x;
        unsigned* bar = b.bar;
        if (b.st[0] == 0u) { if (lane == 0) { unsigned nl, mk; xcd_barrier_complete(bar, b.x, nl, mk); b.st[0] = nl; b.st[1] = mk; } }
        const unsigned nloc = b.st[0], mask = b.st[1], gen = b.st[2] + 1u;
        if (lane == 0) b.st[2] = gen;
        if (b.rank != 0u) { if (lane == 0) xb_st(&bar[XB_XSUB(b.x) + b.rank], gen); }
        else {
            for (unsigned base = 0; base < nloc; base += 64u) {
                const unsigned r = base + lane; unsigned sp = 0u;
                for (;;) {
                    const unsigned v = (r > 0u && r < nloc) ? xb_ld(&bar[XB_XSUB(b.x) + r]) : gen;
                    if (__builtin_amdgcn_ballot_w64((int)(v - gen) < 0) == 0ull) break;
                    __builtin_amdgcn_s_sleep(1);
                    if ((++sp & 255u) == 0u) { if (xb_ld(&bar[XB_TMO])) break; if (sp > XB_SPIN_CAP) { if (lane == 0) atomicAdd(&bar[XB_TMO], 1u); break; } }
                }
            }
            __builtin_amdgcn_fence(__ATOMIC_RELEASE, "agent");
            asm volatile("s_waitcnt vmcnt(0)" ::: "memory");
            if (lane == 0) xb_st(&bar[XB_TOP + b.x], gen);
        }
        { unsigned sp = 0u;
          for (;;) {
              const unsigned v = (lane < 16u && ((mask >> lane) & 1u)) ? xb_ld(&bar[XB_TOP + lane]) : gen;
              if (__builtin_amdgcn_ballot_w64((int)(v - gen) < 0) == 0ull) break;
              __builtin_amdgcn_s_sleep(1);
              if ((++sp & 255u) == 0u) { if (xb_ld(&bar[XB_TMO])) break; if (sp > XB_SPIN_CAP) { if (lane == 0) atomicAdd(&bar[XB_TMO], 1u); break; } }
          } }
        __builtin_amdgcn_fence(__ATOMIC_ACQUIRE, "agent");
        asm volatile("s_waitcnt vmcnt(0)" ::: "memory");
    }
    __syncthreads();
}

__global__ void __launch_bounds__(NTHREADS, 2) mk_fwd(Args args) {
    extern __shared__ __attribute__((aligned(16))) unsigned char lds_raw[];
    LAS unsigned char* lds = (LAS unsigned char*)lds_raw;
    LAS int* ctl = (LAS int*)(lds + CTL_OFF);
    const int tid = threadIdx.x, lane = tid & 63, wave = __builtin_amdgcn_readfirstlane(tid >> 6);
    const int G = gridDim.x;
    const int gw = blockIdx.x * NWAVES + wave, NGW = G * NWAVES;
    unsigned char* ws = args.ws;
    const int lo = args.ph_lo, hi = args.ph_hi;
    if (tid < 16) ((LAS unsigned*)(lds + CTL_OFF + 4096))[tid] = 0u;
    __syncthreads();
    XcdBarrier xbar; xbar.bar = (unsigned*)(ws + WS_CTL + 4096); xbar.x = 0; xbar.st = (volatile LAS unsigned*)(lds + CTL_OFF + 4096);
    if (blockIdx.x == 0) { for (int i = tid; i < XCD_BAR_WORDS; i += NTHREADS) ((unsigned*)(ws + WS_CTL + 4096))[i] = 0u; }
#ifndef PH_MASK
#define PH_MASK 0x7ffff
#endif
#define PH_ON(k) ((PH_MASK >> (k)) & 1)
#define IN(k) (PH_ON(k) && lo <= (k) && (k) < hi)
#ifndef REP_MASK
#define REP_MASK 0
#endif
#define PHASE(k, ...) if (IN(k)) { __VA_ARGS__ if ((REP_MASK >> (k)) & 1) { __syncthreads(); __VA_ARGS__ } }
#ifndef XB_REP
#define XB_REP 1
#endif
#ifndef CG_SEAM_MASK
#define CG_SEAM_MASK 0x1
#endif
#define SEAM(k) do { if (lo <= (k) && (k) + 1 < hi) { if ((CG_SEAM_MASK >> (k)) & 1) cg::this_grid().sync(); else { for (int _s = 0; _s < XB_REP; ++_s) xcd_barrier(xbar); } } } while (0)
#define RUN_GEMM(KK, LDA, LDB) do { __syncthreads(); pg8::gemm_phase<false>(lds, ctl, (KK), (LDA), (LDB), G, (int)blockIdx.x); } while (0)
#define RUN_GEMM8(KK, LDA, LDB, SW, SA) do { __syncthreads(); pg8::gemm_phase<true>(lds, ctl, (KK) / 2, (LDA) / 2, (LDB) / 2, G, (int)blockIdx.x, (SW), (SA)); } while (0)
    PHASE(0,  phase0(args, lds, tid, lane, wave, G); ) SEAM(0);
    xbar = xcd_barrier_post((unsigned*)(ws + WS_CTL + 4096), (volatile LAS unsigned*)(lds + CTL_OFF + 4096));
    PHASE(1,  phase_mix(args, gw, NGW, lane); ) SEAM(1);
    PHASE(2,
        if (tid == 0) {
            const bf16_t* XN = (const bf16_t*)(ws + WS_XN);
            pg8::set_job(ctl, 0, XN + (size_t)0 * MT * D, ws + WS_WR, ws + WS_R, M / 256, 4, pg8::EPI_BF16_HM, D, 0);
            pg8::set_job(ctl, 1, XN + (size_t)2 * MT * D, ws + WS_WK, ws + WS_KRAW, MT / 256, 4, pg8::EPI_BF16_HM, D, 0);
            pg8::set_job(ctl, 2, XN + (size_t)3 * MT * D, ws + WS_WV, ws + WS_V, MT / 256, 4, pg8::EPI_BF16_HM, D, 0);
            pg8::set_job(ctl, 3, XN + (size_t)5 * MT * D, ws + WS_WG1, ws + WS_L1G, M / 256, 1, pg8::EPI_BF16, 256, 2);
        }
        RUN_GEMM(D, D, D);
        __syncthreads();
        if (tid == 0) { const bf16_t* XN = (const bf16_t*)(ws + WS_XN); ctl[0] = 0; ctl[1] = 0;
            pg8::set_job(ctl, 0, XN + (size_t)1 * MT * D, ws + WS_WW1, ws + WS_L1W, MT / 256, 1, pg8::EPI_BF16, 256, 1);
            pg8::set_job(ctl, 1, XN + (size_t)4 * MT * D, ws + WS_WA1, ws + WS_L1A, MT / 256, 1, pg8::EPI_BF16, 256, 0); }
        __syncthreads();
        if ((int)blockIdx.x >= G / 2) pg8::gemm_phase<true>(lds, ctl, D / 2, D / 2, D / 2, G - G / 2, (int)blockIdx.x - G / 2, 127 - 5, 127);
    ) SEAM(2);
    PHASE(4,  phase_scan_chunked(args, lds, tid, lane, wave, G); ) SEAM(4);
    PHASE(5,  phase_readout(args, gw, NGW, lane); ) SEAM(5);
    PHASE(6,  if (tid == 0) pg8::set_job(ctl, 0, ws + WS_OG, ws + WS_WOUT, ws + WS_Y0, M / 256, 4, pg8::EPI_BF16, D, 0); RUN_GEMM(D, D, D); ) SEAM(6);
    PHASE(7,  phase_rowpass<0>(args, lds, tid, lane, wave, G); ) SEAM(7);
    PHASE(8,  if (tid == 0) pg8::set_job(ctl, 0, ws + WS_HB, ws + WS_WGU, ws + WS_ACT, M / 256, 2 * FF / 256, pg8::EPI_SWIGLU8, FF, 0); RUN_GEMM8(D, D, D, 127 - 5, 127); ) SEAM(8);
    PHASE(9,  if (tid == 0) pg8::set_job(ctl, 0, ws + WS_ACT, ws + WS_WDN, ws + WS_Y0, M / 256, 4, pg8::EPI_BF16, D, 0); RUN_GEMM8(FF, FF, FF, 127 - 6, 127 - 2); ) SEAM(9);
    PHASE(10,  phase_rowpass<1>(args, lds, tid, lane, wave, G); ) SEAM(10);
    PHASE(11,
        if (tid == 0) {
            pg8::set_job(ctl, 0, ws + WS_HB, ws + WS_WCI, ws + WS_BG, M / 256, 4, pg8::EPI_BF16, D, 0);
            pg8::set_job(ctl, 1, ws + WS_HB, ws + WS_WCI + (size_t)D * D * 2, ws + WS_Z, M / 256, 8, pg8::EPI_MUL, D, 0);
        }
        RUN_GEMM(D, D, D);
    ) SEAM(11);
    PHASE(12,  phase_conv(args, tid, G); ) SEAM(12);
    PHASE(13,  if (tid == 0) pg8::set_job(ctl, 0, ws + WS_CV, ws + WS_WCO, ws + WS_Y0, M / 256, 4, pg8::EPI_BF16, D, 0); RUN_GEMM(D, D, D); ) SEAM(13);
    PHASE(14,  phase_rowpass<2>(args, lds, tid, lane, wave, G); ) SEAM(14);
    PHASE(16,
        if (tid == 0) { const int* CNT = (const int*)(ws + WS_CTL); int ps = 0, j = 0; ctl[0] = 0; ctl[1] = 0;
            for (int e = 0; e < NE; ++e) { const int nM = (CNT[e] + 255) >> 8;
                if (nM > 0) { pg8::set_job(ctl, j, ws + WS_XS + (size_t)e * M * D, ws + WS_MGU + (size_t)e * 2 * FF * D, ws + WS_MACT + (size_t)ps * FF, nM, 2 * FF / 256, pg8::EPI_SWIGLU8, FF, 0); ++j; }
                ps += nM * 256; } }
        RUN_GEMM8(D, D, D, 127 - 5, 127);
    ) SEAM(16);
    PHASE(17,
        if (tid == 0) { const int* CNT = (const int*)(ws + WS_CTL); int ps = 0, j = 0; ctl[0] = 0; ctl[1] = 0;
            for (int e = 0; e < NE; ++e) { const int nM = (CNT[e] + 255) >> 8;
                if (nM > 0) { pg8::set_job(ctl, j, ws + WS_MACT + (size_t)ps * FF, ws + WS_MDN + (size_t)e * D * FF, ws + WS_YS + (size_t)ps * D * 2, nM, 4, pg8::EPI_BF16, D, 0); ++j; }
                ps += nM * 256; } }
        RUN_GEMM8(FF, FF, FF, 127 - 6, 127 - 2);
    ) SEAM(17);
    PHASE(18,  phase_rowpass<3>(args, lds, tid, lane, wave, G); )
}

extern "C" void kernel_launch(void* const* d_in, const int* in_sizes, int n_in, void* d_out, int out_size, void* d_ws, size_t ws_size, hipStream_t stream) {
    static int grid = 0;
    if (grid == 0) {
        int dev = 0, cus = 0, per_cu = 0;
        if (n_in != 31 || ws_size < WS_END) { fprintf(stderr, "kernel_launch: unexpected n_in %d or ws_size %zu (< %zu)\n", n_in, ws_size, (size_t)WS_END); grid = -1; return; }
        hipGetDevice(&dev);
        hipDeviceGetAttribute(&cus, hipDeviceAttributeMultiprocessorCount, dev);
        if (hipFuncSetAttribute((const void*)mk_fwd, hipFuncAttributeMaxDynamicSharedMemorySize, LDS_BYTES) != hipSuccess) { fprintf(stderr, "kernel_launch: hipFuncSetAttribute failed\n"); grid = -1; return; }
        if (hipOccupancyMaxActiveBlocksPerMultiprocessor(&per_cu, (const void*)mk_fwd, NTHREADS, LDS_BYTES) != hipSuccess || per_cu < 1) { fprintf(stderr, "kernel_launch: occupancy query says %d\n", per_cu); per_cu = 1; }
        (void)hipGetLastError();
        grid = cus;
        fprintf(stderr, "kernel_launch: cus %d per_cu %d grid %d ws %zu\n", cus, per_cu, grid, ws_size);
    }
    if (grid < 0) return;
    Args a{};
    for (int i = 0; i < 31; ++i) a.in[i] = (const float*)d_in[i];
    a.out = (float*)d_out; a.ws = (unsigned char*)d_ws;
#if MK_ONE_LAUNCH
    a.ph_lo = 0; a.ph_hi = NPH;
    void* kargs[] = {&a};
    hipError_t e = hipLaunchCooperativeKernel((const void*)mk_fwd, dim3(grid), dim3(NTHREADS), kargs, LDS_BYTES, stream);
    if (e != hipSuccess) fprintf(stderr, "cooperative launch failed: %s (grid %d)\n", hipGetErrorString(e), grid);
#else
    for (int p = 0; p < NPH; ++p) {
        a.ph_lo = p; a.ph_hi = p + 1;
        hipLaunchKernelGGL(mk_fwd, dim3(grid), dim3(NTHREADS), LDS_BYTES, stream, a);
    }
#endif
}
```

```cpp
#include <hip/hip_runtime.h>
#include <hip/hip_cooperative_groups.h>
#include <cstdio>
#include <cstdint>
namespace cg = cooperative_groups;

#ifndef MK_ONE_LAUNCH
#define MK_ONE_LAUNCH 1
#endif

#define LAS __attribute__((address_space(3)))
typedef unsigned short bf16_t;
typedef short bf16x8 __attribute__((ext_vector_type(8)));
typedef float f32x4 __attribute__((ext_vector_type(4)));
typedef float f32x2 __attribute__((ext_vector_type(2)));
typedef unsigned u32x4 __attribute__((ext_vector_type(4)));
typedef unsigned u32x2 __attribute__((ext_vector_type(2)));
typedef int i32x8 __attribute__((ext_vector_type(8)));
typedef int i32x4 __attribute__((ext_vector_type(4)));

constexpr int D = 1024, NB = 8, T = 2048, TCX = 256, M = NB * T, MC = NB * TCX, MT = M + MC, NH = 16, HS = 64, FF = 3584, NE = 8;
constexpr float NORM_EPS = 1e-6f, GN_EPS = 64e-5f;
constexpr int NPH = 19;

constexpr size_t MiB = 1u << 20;
constexpr size_t WS_WR = 0, WS_WK = 2 * MiB, WS_WV = 4 * MiB, WS_WW1 = 6 * MiB, WS_WA1 = 6 * MiB + 512 * 1024, WS_WG1 = 7 * MiB;
constexpr size_t WS_W2W = 7 * MiB + 512 * 1024, WS_W2A = WS_W2W + 256 * 1024, WS_W2G = 8 * MiB;
constexpr size_t WS_WOUT = 9 * MiB, WS_WGU = 11 * MiB, WS_WDN = 25 * MiB, WS_WCI = 32 * MiB, WS_WCO = 38 * MiB, WS_MGU = 40 * MiB, WS_MDN = 152 * MiB;
constexpr size_t WS_MODS = 208 * MiB, WS_RSTD = 209 * MiB, WS_BONUS = 210 * MiB, WS_TOPE = 211 * MiB, WS_TOPG = WS_TOPE + 128 * 1024, WS_TPOS = WS_TOPG + 128 * 1024;
constexpr size_t WS_SLOT = 211 * MiB + 512 * 1024, WS_CTL = 212 * MiB;
constexpr size_t WS_XR = 214 * MiB, WS_HB = 278 * MiB, WS_GATE = 310 * MiB, WS_OG = 342 * MiB, WS_YF = 374 * MiB, WS_YB = 406 * MiB, WS_Y0 = 374 * MiB;
constexpr size_t WS_S2 = 438 * MiB, WS_R = WS_S2, WS_KRAW = WS_S2 + 36 * MiB, WS_V = WS_S2 + 72 * MiB, WS_L1W = WS_S2 + 108 * MiB, WS_L1A = WS_S2 + 117 * MiB, WS_L1G = WS_S2 + 126 * MiB;
constexpr size_t WS_BG = WS_S2, WS_Z = WS_S2 + 32 * MiB, WS_CV = WS_S2 + 64 * MiB, WS_XS = WS_S2, WS_YS = WS_S2;
constexpr size_t WS_S1 = 574 * MiB, WS_XN = WS_S1, WS_AT = WS_S1, WS_BT = WS_S1 + 72 * MiB, WS_KT = WS_S1 + 144 * MiB, WS_ACT = WS_S1, WS_MACT = WS_S1;
constexpr size_t WS_BONUS1 = 213 * MiB;
constexpr size_t WS_RT = WS_XR, WS_GC = WS_XR + 72 * MiB;
constexpr size_t HMA = (size_t)NB * NH * (TCX + T) * HS;
constexpr int NPOS = TCX + T, NCHK = NPOS / 16;
constexpr size_t WS_END = 812 * MiB;
constexpr size_t WS_DUMP = 209 * MiB + 512 * 1024;
constexpr int MAXSLOT = 2 * M + NE * 256;

constexpr int LDS_BYTES = 163840;
constexpr int CTL_OFF = 155648;
constexpr int NTHREADS = 512, NWAVES = 8;

struct Args { const float* in[31]; float* out; unsigned char* ws; int ph_lo, ph_hi; };

__device__ __forceinline__ float bf2f(unsigned h) { return __uint_as_float(h << 16); }
typedef __bf16 bf16x2_t __attribute__((ext_vector_type(2)));
__device__ __forceinline__ unsigned cvt_pk_bf16_asm(float lo, float hi) { unsigned r; asm volatile("v_cvt_pk_bf16_f32 %0, %1, %2" : "=v"(r) : "v"(lo), "v"(hi)); return r; }
__device__ __forceinline__ unsigned cvt_pk_bf16(float lo, float hi) { const f32x2 v = {lo, hi}; return __builtin_bit_cast(unsigned, __builtin_convertvector(v, bf16x2_t)); }
__device__ __forceinline__ float sigmoidf_(float x) { return __builtin_amdgcn_rcpf(1.0f + __expf(-x)); }
__device__ __forceinline__ float siluf_(float x) { return x * sigmoidf_(x); }
__device__ __forceinline__ float tanhf_(float x) { return 2.0f * sigmoidf_(2.0f * x) - 1.0f; }
__device__ __forceinline__ float wave_sum(float v) {
#pragma unroll
    for (int o = 1; o < 64; o <<= 1) v += __shfl_xor(v, o);
    return v;
}
__device__ __forceinline__ int rfl(int v) { return __builtin_amdgcn_readfirstlane(v); }
__device__ __forceinline__ f32x4 ld4(const float* p) { return *(const f32x4*)p; }
__device__ __forceinline__ void unpack4(u32x2 w, float* o) { o[0] = bf2f(w.x & 0xffffu); o[1] = bf2f(w.x >> 16); o[2] = bf2f(w.y & 0xffffu); o[3] = bf2f(w.y >> 16); }
__device__ __forceinline__ void unpack8(u32x4 w, float* o) {
    o[0] = bf2f(w.x & 0xffffu); o[1] = bf2f(w.x >> 16); o[2] = bf2f(w.y & 0xffffu); o[3] = bf2f(w.y >> 16);
    o[4] = bf2f(w.z & 0xffffu); o[5] = bf2f(w.z >> 16); o[6] = bf2f(w.w & 0xffffu); o[7] = bf2f(w.w >> 16);
}
__device__ __forceinline__ u32x4 pack8(const float* v) { u32x4 w; w.x = cvt_pk_bf16_asm(v[0], v[1]); w.y = cvt_pk_bf16_asm(v[2], v[3]); w.z = cvt_pk_bf16_asm(v[4], v[5]); w.w = cvt_pk_bf16_asm(v[6], v[7]); return w; }
__device__ __forceinline__ u32x4 pack8v(const float* v) { u32x4 w; w.x = cvt_pk_bf16(v[0], v[1]); w.y = cvt_pk_bf16(v[2], v[3]); w.z = cvt_pk_bf16(v[4], v[5]); w.w = cvt_pk_bf16(v[6], v[7]); return w; }
template <int CTRL> __device__ __forceinline__ float dpp_mov(float v) { return __builtin_bit_cast(float, __builtin_amdgcn_update_dpp(0, __builtin_bit_cast(int, v), CTRL, 0xF, 0xF, true)); }
__device__ __forceinline__ int hm_row(int row) { return row < M ? (row >> 11) * (NH * NPOS) + TCX + (row & (T - 1)) : ((row - M) >> 8) * (NH * NPOS) + ((row - M) & (TCX - 1)); }
__device__ __forceinline__ float red8(float v) {
    v += __builtin_bit_cast(float, __builtin_amdgcn_update_dpp(0, __builtin_bit_cast(int, v), 0xB1, 0xF, 0xF, true));
    v += __builtin_bit_cast(float, __builtin_amdgcn_update_dpp(0, __builtin_bit_cast(int, v), 0x4E, 0xF, 0xF, true));
    v += __builtin_bit_cast(float, __builtin_amdgcn_update_dpp(0, __builtin_bit_cast(int, v), 0x141, 0xF, 0xF, true));
    return v;
}

namespace pg8 {
constexpr int BM = 256, BK = 64, HALF = 128, HTB = HALF * BK * 2, STAGE_BYTES = 8 * HTB, NXCD = 8, WGM = 8;
__device__ __forceinline__ int lds_byte(int r, int c) { const int st = (r >> 4) * 2 + (c >> 5), rr = r & 15, cc = c & 31, ob = rr * 64 + cc * 2; return st * 1024 + (ob ^ (((ob >> 9) & 1) << 5)); }
__device__ __forceinline__ void stage_rc(int b, int& R, int& C) { const int st = b / 1024, sb = b % 1024, swz = sb ^ (((sb >> 9) & 1) << 5); R = (st >> 1) * 16 + swz / 64; C = (st & 1) * 32 + (swz % 64) / 2; }
__device__ __forceinline__ int perm32(int rho) { const int n = rho >> 4, i = rho & 15; return 8 * (i >> 2) + 4 * n + (i & 3); }

enum { EPI_BF16 = 0, EPI_F32 = 1, EPI_SWIGLU = 2, EPI_MUL = 3, EPI_BF16_HM = 4, EPI_SWIGLU8 = 5 };
struct Unit { const char* A; const char* B; int pm, pn, job; };

__device__ __forceinline__ void set_job(LAS int* ctl, int j, const void* A, const void* B, void* O, int nM, int nN, int mode, int ldo, int act) {
    LAS int* jd = ctl + 16 + 16 * j;
    const unsigned long long a = (unsigned long long)A, b = (unsigned long long)B, o = (unsigned long long)O;
    jd[0] = (int)(unsigned)a; jd[1] = (int)(unsigned)(a >> 32); jd[2] = (int)(unsigned)b; jd[3] = (int)(unsigned)(b >> 32); jd[4] = (int)(unsigned)o; jd[5] = (int)(unsigned)(o >> 32);
    jd[6] = nM; jd[7] = nN; jd[9] = mode; jd[10] = ldo; jd[11] = act;
    const int u0 = (j == 0) ? 0 : ctl[16 + 16 * (j - 1) + 8] + ctl[16 + 16 * (j - 1) + 6] * ctl[16 + 16 * (j - 1) + 7];
    jd[8] = u0; ctl[0] = j + 1; ctl[1] = u0 + nM * nN;
}

__device__ __forceinline__ bool sched_next(LAS const int* ctl, int i, int G, int c, size_t tstepA, size_t tstepB, Unit& u) {
    const int total = rfl(ctl[1]), nj = rfl(ctl[0]);
    const long L = (long)i * G + c; if (L >= total) return false;
    int j = 0;
    for (int q = 1; q < nj; ++q) if ((int)L >= rfl(ctl[16 + 16 * q + 8])) j = q;
    LAS const int* jd = ctl + 16 + 16 * j;
    const int nM = rfl(jd[6]), nN = rfl(jd[7]); int wgid = (int)L - rfl(jd[8]);
    const int nwg = nM * nN;
    { const int q = nwg / NXCD, r = nwg % NXCD, xcd = wgid % NXCD, off = wgid / NXCD; wgid = (xcd < r ? xcd * (q + 1) : r * (q + 1) + (xcd - r) * q) + off; }
    const int nig = WGM * nN, gid = wgid / nig, fm = gid * WGM, gsz = (nM - fm) < WGM ? (nM - fm) : WGM;
    u.pm = fm + ((wgid % nig) % gsz); u.pn = (wgid % nig) / gsz; u.job = j;
    const unsigned long long a = ((unsigned long long)(unsigned)rfl(jd[1]) << 32) | (unsigned)rfl(jd[0]);
    const unsigned long long b = ((unsigned long long)(unsigned)rfl(jd[3]) << 32) | (unsigned)rfl(jd[2]);
    u.A = (const char*)a + (size_t)u.pm * tstepA; u.B = (const char*)b + (size_t)u.pn * tstepB;
    return true;
}

__device__ __forceinline__ void epilogue(const f32x4 (&acc)[2][2][4][2], LAS const int* ctl, const Unit& u, int wr, int wc, int fr, int fq) {
    LAS const int* jd = ctl + 16 + 16 * u.job;
    const int mode = rfl(jd[9]), ldo = rfl(jd[10]), act = rfl(jd[11]);
    char* O = (char*)(((unsigned long long)(unsigned)rfl(jd[5]) << 32) | (unsigned)rfl(jd[4]));
    const int row0 = u.pm * BM + wr * 64 + fr;
    if (mode == EPI_BF16) {
        bf16_t* base = (bf16_t*)O; const int col0 = u.pn * BM + wc * 32 + 8 * fq;
#pragma unroll
        for (int ai = 0; ai < 2; ++ai)
#pragma unroll
            for (int m = 0; m < 4; ++m) { bf16_t* rowp = base + (size_t)(row0 + ai * HALF + m * 16) * ldo + col0;
#pragma unroll
                for (int bj = 0; bj < 2; ++bj) { f32x4 v0 = acc[ai][bj][m][0], v1 = acc[ai][bj][m][1];
                    if (act == 1) { _Pragma("unroll") for (int e = 0; e < 4; ++e) { v0[e] = tanhf_(v0[e]); v1[e] = tanhf_(v1[e]); } }
                    else if (act == 2) { _Pragma("unroll") for (int e = 0; e < 4; ++e) { v0[e] = sigmoidf_(v0[e]); v1[e] = sigmoidf_(v1[e]); } }
                    u32x4 w; w.x = cvt_pk_bf16_asm(v0[0], v0[1]); w.y = cvt_pk_bf16_asm(v0[2], v0[3]); w.z = cvt_pk_bf16_asm(v1[0], v1[1]); w.w = cvt_pk_bf16_asm(v1[2], v1[3]);
                    *(u32x4*)(rowp + bj * HALF) = w; } }
    } else if (mode == EPI_BF16_HM) {
        bf16_t* base = (bf16_t*)O; const int col0 = u.pn * BM + wc * 32 + 8 * fq;
#pragma unroll
        for (int ai = 0; ai < 2; ++ai)
#pragma unroll
            for (int m = 0; m < 4; ++m) { const int hr = hm_row(row0 + ai * HALF + m * 16);
#pragma unroll
                for (int bj = 0; bj < 2; ++bj) { const int col = col0 + bj * HALF; const f32x4 v0 = acc[ai][bj][m][0], v1 = acc[ai][bj][m][1];
                    u32x4 w; w.x = cvt_pk_bf16_asm(v0[0], v0[1]); w.y = cvt_pk_bf16_asm(v0[2], v0[3]); w.z = cvt_pk_bf16_asm(v1[0], v1[1]); w.w = cvt_pk_bf16_asm(v1[2], v1[3]);
                    *(u32x4*)(base + ((size_t)(hr + (col >> 6) * NPOS)) * 64 + (col & 63)) = w; } }
    } else if (mode == EPI_F32) {
        float* base = (float*)O; const int col0 = u.pn * BM + wc * 32 + 8 * fq;
#pragma unroll
        for (int ai = 0; ai < 2; ++ai)
#pragma unroll
            for (int m = 0; m < 4; ++m) { float* rowp = base + (size_t)(row0 + ai * HALF + m * 16) * ldo + col0;
#pragma unroll
                for (int bj = 0; bj < 2; ++bj) { *(f32x4*)(rowp + bj * HALF) = acc[ai][bj][m][0]; *(f32x4*)(rowp + bj * HALF + 4) = acc[ai][bj][m][1]; } }
    } else if (mode == EPI_SWIGLU8) {
        unsigned char* base = (unsigned char*)O; const int colb = u.pn * HALF + wc * 16;
#pragma unroll
        for (int ai = 0; ai < 2; ++ai)
#pragma unroll
            for (int bj = 0; bj < 2; ++bj) { int w[4];
#pragma unroll
                for (int m = 0; m < 4; ++m) { const f32x4 g = acc[ai][bj][m][0], uu = acc[ai][bj][m][1]; f32x4 r;
                    _Pragma("unroll") for (int e = 0; e < 4; ++e) r[e] = 4.0f * siluf_(g[e]) * uu[e];
                    w[m] = __builtin_amdgcn_cvt_pk_fp8_f32(r[0], r[1], 0, false); w[m] = __builtin_amdgcn_cvt_pk_fp8_f32(r[2], r[3], w[m], true); }
                const auto s02 = __builtin_amdgcn_permlane32_swap(w[0], w[2], false, false), s13 = __builtin_amdgcn_permlane32_swap(w[1], w[3], false, false);
                const auto t01 = __builtin_amdgcn_permlane16_swap(s02[0], s13[0], false, false), t23 = __builtin_amdgcn_permlane16_swap(s02[1], s13[1], false, false);
                const u32x4 o = {(unsigned)t01[0], (unsigned)t01[1], (unsigned)t23[0], (unsigned)t23[1]};
                *(u32x4*)(base + (size_t)(u.pm * BM + wr * 64 + ai * HALF + 16 * fq + fr) * ldo + colb + bj * 64) = o; }
    } else {
        bf16_t* base = (bf16_t*)O; const int col0 = u.pn * HALF + wc * 16 + 4 * (fq & 2);
#pragma unroll
        for (int ai = 0; ai < 2; ++ai)
#pragma unroll
            for (int bj = 0; bj < 2; ++bj) { u32x2 w[4];
#pragma unroll
                for (int m = 0; m < 4; ++m) { const f32x4 g = acc[ai][bj][m][0], uu = acc[ai][bj][m][1]; f32x4 r;
                    if (mode == EPI_SWIGLU) { _Pragma("unroll") for (int e = 0; e < 4; ++e) r[e] = siluf_(g[e]) * uu[e]; } else { r = g * uu; }
                    w[m].x = cvt_pk_bf16(r[0], r[1]); w[m].y = cvt_pk_bf16(r[2], r[3]); }
#pragma unroll
                for (int mp = 0; mp < 4; mp += 2) {
                    const auto sx = __builtin_amdgcn_permlane16_swap((int)w[mp].x, (int)w[mp + 1].x, false, false), sy = __builtin_amdgcn_permlane16_swap((int)w[mp].y, (int)w[mp + 1].y, false, false);
                    const u32x4 o = {(unsigned)sx[0], (unsigned)sy[0], (unsigned)sx[1], (unsigned)sy[1]};
                    *(u32x4*)(base + (size_t)(row0 + ai * HALF + (mp + (fq & 1)) * 16) * ldo + col0 + bj * 64) = o; } }
    }
}

template <bool FP8>
__device__ __forceinline__ void gemm_phase(LAS unsigned char* lds, LAS const int* ctl, int K, int lda, int ldb, int G, int c, int sW = 127, int sA = 127) {
    const int tid = threadIdx.x, wid = __builtin_amdgcn_readfirstlane(tid >> 6), lane = tid & 63, wr = wid >> 2, wc = wid & 3, fr = lane & 15, fq = lane >> 4;
    const int nt = K / BK;
    sW = sW * 0x01010101; sA = sA * 0x01010101;
    unsigned voffA[2], voffB[2];
#pragma unroll
    for (int i = 0; i < 2; ++i) { int R, C; stage_rc(tid * 16 + i * 8192, R, C); const int Rb = (R & ~31) + perm32(R & 31);
        voffA[i] = (unsigned)(R * lda + C) * 2u; voffB[i] = (unsigned)(Rb * ldb + C) * 2u; }
    const size_t kstep = (size_t)(BK * 2);
    const size_t hsA = (size_t)HALF * lda * 2, hsB = (size_t)HALF * ldb * 2;
    const size_t tsA = 2 * hsA, tsB = 2 * hsB;
    const unsigned ldsw = (unsigned)wid * 1024u;
    const int aoff = lds_byte(wr * 64 + fr, fq * 8), boff = lds_byte(wc * 32 + fr, fq * 8);
#define PG8_SA(b, h) (((b) * 2 + (h)) * HTB)
#define PG8_SB(b, h) ((4 + (b) * 2 + (h)) * HTB)
#define PG8_STAGE(bufoff, gbase, voff) do { _Pragma("unroll") for (int _i = 0; _i < 2; ++_i) \
        __builtin_amdgcn_global_load_lds((const unsigned*)((const char*)(gbase) + (voff)[_i]), (LAS unsigned*)(lds + (bufoff) + ldsw + _i * 8192), 16, 0, 0); } while (0)
#define PG8_LDA(dst, b, h) do { _Pragma("unroll") for (int m = 0; m < 4; ++m) { const i32x4 lo_ = *(const LAS i32x4*)(lds + PG8_SA(b, h) + aoff + m * 2048), hi_ = *(const LAS i32x4*)(lds + PG8_SA(b, h) + aoff + m * 2048 + 1024); \
        dst[m] = __builtin_shufflevector(lo_, hi_, 0, 1, 2, 3, 4, 5, 6, 7); } } while (0)
#define PG8_LDB(dst, b, h) do { _Pragma("unroll") for (int n = 0; n < 2; ++n) { const i32x4 lo_ = *(const LAS i32x4*)(lds + PG8_SB(b, h) + boff + n * 2048), hi_ = *(const LAS i32x4*)(lds + PG8_SB(b, h) + boff + n * 2048 + 1024); \
        dst[n] = __builtin_shufflevector(lo_, hi_, 0, 1, 2, 3, 4, 5, 6, 7); } } while (0)
#define PG8_LO(v) __builtin_bit_cast(bf16x8, __builtin_shufflevector(v, v, 0, 1, 2, 3))
#define PG8_HI(v) __builtin_bit_cast(bf16x8, __builtin_shufflevector(v, v, 4, 5, 6, 7))
#define PG8_MMA16(ai, bj, At, Bt) do { __builtin_amdgcn_s_setprio(1); _Pragma("unroll") for (int m = 0; m < 4; ++m) _Pragma("unroll") for (int n = 0; n < 2; ++n) { \
        acc[ai][bj][m][n] = __builtin_amdgcn_mfma_f32_16x16x32_bf16(PG8_LO(Bt[n]), PG8_LO(At[m]), acc[ai][bj][m][n], 0, 0, 0); \
        acc[ai][bj][m][n] = __builtin_amdgcn_mfma_f32_16x16x32_bf16(PG8_HI(Bt[n]), PG8_HI(At[m]), acc[ai][bj][m][n], 0, 0, 0); } __builtin_amdgcn_s_setprio(0); } while (0)
#define PG8_MMA8(ai, bj, At, Bt) do { __builtin_amdgcn_s_setprio(1); _Pragma("unroll") for (int m = 0; m < 4; ++m) _Pragma("unroll") for (int n = 0; n < 2; ++n) \
        asm volatile("v_mfma_scale_f32_16x16x128_f8f6f4 %0, %1, %2, %0, %3, %4 op_sel_hi:[0,0,0]" : "+v"(acc[ai][bj][m][n]) : "v"(Bt[n]), "v"(At[m]), "v"(sW), "v"(sA)); __builtin_amdgcn_s_setprio(0); } while (0)
#define PG8_MMA(ai, bj, At, Bt) do { if constexpr (FP8) PG8_MMA8(ai, bj, At, Bt); else PG8_MMA16(ai, bj, At, Bt); } while (0)
#define PG8_WAIT_V(n) asm volatile("s_waitcnt vmcnt(" #n ")" ::: "memory")
#define PG8_WAIT_L(n) asm volatile("s_waitcnt lgkmcnt(" #n ")" ::: "memory")
#define PG8_BAR __builtin_amdgcn_s_barrier()
#define PG8_SCHED __builtin_amdgcn_sched_barrier(0)
    Unit cur, nxt; int ui = 0;
    if (!sched_next(ctl, 0, G, c, tsA, tsB, cur)) return;
    f32x4 acc[2][2][4][2];
#pragma unroll
    for (int a = 0; a < 2; ++a)
#pragma unroll
        for (int b = 0; b < 2; ++b)
#pragma unroll
            for (int m = 0; m < 4; ++m)
#pragma unroll
                for (int n = 0; n < 2; ++n) acc[a][b][m][n] = (f32x4){0.f, 0.f, 0.f, 0.f};
    i32x8 At[4], B0[2], B1[2];
    const char* cA = cur.A; const char* cB = cur.B;
    PG8_STAGE(PG8_SB(0, 0), cB, voffB); PG8_STAGE(PG8_SB(0, 1), cB + hsB, voffB); PG8_STAGE(PG8_SA(0, 0), cA, voffA); PG8_STAGE(PG8_SA(0, 1), cA + hsA, voffA);
    if (wr == 1) PG8_BAR;
    PG8_WAIT_V(2); PG8_BAR;
    PG8_STAGE(PG8_SB(1, 0), cB + kstep, voffB); PG8_STAGE(PG8_SA(1, 0), cA + kstep, voffA); PG8_STAGE(PG8_SB(1, 1), cB + hsB + kstep, voffB);
    PG8_WAIT_V(6); PG8_BAR;
    for (;;) {
        const bool has_next = sched_next(ctl, ui + 1, G, c, tsA, tsB, nxt);
        const char* nA = has_next ? nxt.A : cA; const char* nB = has_next ? nxt.B : cB;
        for (int t = 0; t < nt; t += 2) {
            const bool last = (t == nt - 2);
            const char* a1 = cA + (size_t)(t + 1) * kstep;
            const char* a2 = last ? nA : cA + (size_t)(t + 2) * kstep; const char* b2 = last ? nB : cB + (size_t)(t + 2) * kstep;
            const char* a3 = a2 + kstep; const char* b3 = b2 + kstep;
            PG8_LDB(B0, 0, 0); PG8_LDB(B1, 0, 1); PG8_SCHED; PG8_LDA(At, 0, 0); PG8_STAGE(PG8_SA(1, 1), a1 + hsA, voffA);
            PG8_WAIT_V(8); PG8_WAIT_L(0); PG8_BAR; PG8_MMA(0, 0, At, B0); PG8_MMA(0, 1, At, B1); PG8_BAR; PG8_SCHED;
            PG8_LDA(At, 0, 1); PG8_STAGE(PG8_SB(0, 0), b2, voffB); PG8_STAGE(PG8_SB(0, 1), b2 + hsB, voffB); PG8_STAGE(PG8_SA(0, 0), a2, voffA);
            PG8_WAIT_V(8); PG8_WAIT_L(0); PG8_BAR; PG8_MMA(1, 0, At, B0); PG8_MMA(1, 1, At, B1); PG8_BAR; PG8_SCHED;
            PG8_LDB(B0, 1, 0); PG8_LDB(B1, 1, 1); PG8_SCHED; PG8_LDA(At, 1, 0); PG8_STAGE(PG8_SA(0, 1), a2 + hsA, voffA);
            PG8_WAIT_V(8); PG8_WAIT_L(0); PG8_BAR; PG8_MMA(0, 0, At, B0); PG8_MMA(0, 1, At, B1); PG8_BAR; PG8_SCHED;
            PG8_LDA(At, 1, 1); PG8_STAGE(PG8_SB(1, 0), b3, voffB); PG8_STAGE(PG8_SB(1, 1), b3 + hsB, voffB); PG8_STAGE(PG8_SA(1, 0), a3, voffA);
            PG8_WAIT_V(8); PG8_WAIT_L(0); PG8_BAR; PG8_MMA(1, 0, At, B0); PG8_MMA(1, 1, At, B1); PG8_BAR; PG8_SCHED;
        }
        if (wr == 0) PG8_BAR;
        if constexpr (FP8) asm volatile("s_nop 15\n\ts_nop 15" ::: "memory");
        epilogue(acc, ctl, cur, wr, wc, fr, fq);
        if (!has_next) break;
#pragma unroll
        for (int a = 0; a < 2; ++a)
#pragma unroll
            for (int b = 0; b < 2; ++b)
#pragma unroll
                for (int m = 0; m < 4; ++m)
#pragma unroll
                    for (int n = 0; n < 2; ++n) acc[a][b][m][n] = (f32x4){0.f, 0.f, 0.f, 0.f};
        cur = nxt; cA = nA; cB = nB; ++ui;
        if (wr == 1) PG8_BAR;
    }
    PG8_WAIT_V(0);
    PG8_BAR;
#undef PG8_SA
#undef PG8_SB
#undef PG8_STAGE
#undef PG8_LDA
#undef PG8_LDB
#undef PG8_MMA
#undef PG8_MMA8
#undef PG8_MMA16
#undef PG8_LO
#undef PG8_HI
#undef PG8_WAIT_V
#undef PG8_WAIT_L
#undef PG8_BAR
#undef PG8_SCHED
}
}

__device__ __forceinline__ int cvt_rowmap(int kind, int n) {
    if (kind == 1) { if (n < FF) return 8 * (n >> 2) + (n & 3); const int j = n - FF; return 8 * (j >> 2) + 4 + (j & 3); }
    if (kind == 2) { if (n < D) return n; if (n < 2 * D) { const int j = n - D; return D + 8 * (j >> 2) + (j & 3); } const int j = n - 2 * D; return D + 8 * (j >> 2) + 4 + (j & 3); }
    return n;
}
struct CvtIt { const float* src; bf16_t* dst; int K, N, ldd, kind, k0, n0; };
__device__ __forceinline__ void cvt_decode(LAS const int* ctl, int it, CvtIt& c) {
    const int nj = rfl(ctl[2]);
    int j = 0;
    for (int q = 1; q < nj; ++q) if (it >= rfl(ctl[256 + 16 * q + 11])) j = q;
    LAS const int* jd = ctl + 256 + 16 * j;
    const int loc = it - rfl(jd[11]), ipb = rfl(jd[12]), nNt = rfl(jd[13]);
    const int bat = loc / ipb, rem = loc % ipb, kb = rem / nNt, nb = rem % nNt;
    c.src = (const float*)(((unsigned long long)(unsigned)rfl(jd[1]) << 32) | (unsigned)rfl(jd[0])) + (size_t)bat * (size_t)(unsigned)rfl(jd[9]);
    c.dst = (bf16_t*)(((unsigned long long)(unsigned)rfl(jd[3]) << 32) | (unsigned)rfl(jd[2])) + (size_t)bat * (size_t)(unsigned)rfl(jd[10]);
    c.K = rfl(jd[4]); c.N = rfl(jd[5]); c.ldd = rfl(jd[6]); c.kind = rfl(jd[7]); c.k0 = 64 * kb; c.n0 = 64 * nb;
}
__device__ __forceinline__ void cvt_load(const CvtIt& c, f32x4 (&v)[16], int lane) {
    const int nn = 4 * (lane & 15);
    const int n = (c.n0 + nn) < c.N ? (c.n0 + nn) : (c.N - 4);
#pragma unroll
    for (int i = 0; i < 16; ++i) { const int k_ = c.k0 + 4 * i + (lane >> 4); const int k = k_ < c.K ? k_ : c.K - 1;
        v[i] = *(const f32x4*)(c.src + (size_t)k * c.N + n); }
}
__device__ __forceinline__ void cvt_to_lds(const f32x4 (&v)[16], LAS float* scr, int lane) {
    const int nn = 4 * (lane & 15);
#pragma unroll
    for (int i = 0; i < 16; ++i) { const int kk = 4 * i + (lane >> 4); LAS float* s = scr + kk * 65 + nn; s[0] = v[i][0]; s[1] = v[i][1]; s[2] = v[i][2]; s[3] = v[i][3]; }
    asm volatile("s_waitcnt lgkmcnt(0)" ::: "memory");
}
__device__ __forceinline__ void cvt_store(const CvtIt& ci, LAS const float* scr, int lane) {
    const int c = lane & 7; const int K = ci.K, N = ci.N, ldd = ci.ldd, kind = ci.kind, k0 = ci.k0, n0 = ci.n0; bf16_t* dst = ci.dst;
    if (kind & 0x100) {
        const float sc = (float)(1 << (kind >> 16));
#pragma unroll
        for (int j = 0; j < 8; ++j) { const int nl = (lane >> 3) + 8 * j; const LAS float* s = scr + (8 * c) * 65 + nl;
            int w0 = __builtin_amdgcn_cvt_pk_fp8_f32(s[0] * sc, s[65] * sc, 0, false); w0 = __builtin_amdgcn_cvt_pk_fp8_f32(s[2 * 65] * sc, s[3 * 65] * sc, w0, true);
            int w1 = __builtin_amdgcn_cvt_pk_fp8_f32(s[4 * 65] * sc, s[5 * 65] * sc, 0, false); w1 = __builtin_amdgcn_cvt_pk_fp8_f32(s[6 * 65] * sc, s[7 * 65] * sc, w1, true);
            const int n = n0 + nl, k = k0 + 8 * c;
            if (n < N && k < K) *(u32x2*)((unsigned char*)dst + (size_t)cvt_rowmap(kind & 15, n) * ldd + k) = (u32x2){(unsigned)w0, (unsigned)w1}; }
    } else {
        const float sc = (kind & 0x200) ? -1.44269504f : 1.0f;
#pragma unroll
        for (int j = 0; j < 8; ++j) { const int nl = (lane >> 3) + 8 * j; const LAS float* s = scr + (8 * c) * 65 + nl;
            u32x4 o; o.x = cvt_pk_bf16_asm(s[0] * sc, s[65] * sc); o.y = cvt_pk_bf16_asm(s[2 * 65] * sc, s[3 * 65] * sc); o.z = cvt_pk_bf16_asm(s[4 * 65] * sc, s[5 * 65] * sc); o.w = cvt_pk_bf16_asm(s[6 * 65] * sc, s[7 * 65] * sc);
            const int n = n0 + nl, k = k0 + 8 * c;
            if (n < N && k < K) *(u32x4*)(dst + (size_t)cvt_rowmap(kind & 15, n) * ldd + k) = o; }
    }
    asm volatile("s_waitcnt lgkmcnt(0)" ::: "memory");
}
__device__ __forceinline__ void cvt_set(LAS int* ctl, int j, const float* src, void* dst, int K, int N, int ldd, int kind, int nb, int sstride, int dstride) {
    LAS int* jd = ctl + 256 + 16 * j;
    const unsigned long long a = (unsigned long long)src, b = (unsigned long long)dst;
    jd[0] = (int)(unsigned)a; jd[1] = (int)(unsigned)(a >> 32); jd[2] = (int)(unsigned)b; jd[3] = (int)(unsigned)(b >> 32);
    jd[4] = K; jd[5] = N; jd[6] = ldd; jd[7] = kind; jd[8] = nb; jd[9] = sstride; jd[10] = dstride;
    const int nKt = (K + 63) / 64, nNt = (N + 63) / 64;
    const int i0 = (j == 0) ? 0 : ctl[256 + 16 * (j - 1) + 11] + ctl[256 + 16 * (j - 1) + 12] * ctl[256 + 16 * (j - 1) + 8];
    jd[11] = i0; jd[12] = nKt * nNt; jd[13] = nNt;
    ctl[2] = j + 1; ctl[3] = i0 + nKt * nNt * nb;
}

__device__ __forceinline__ void phase0(const Args& a, LAS unsigned char* lds, int tid, int lane, int wave, int G) {
    unsigned char* ws = a.ws;
    LAS int* ctl = (LAS int*)(lds + CTL_OFF);
    if (tid == 0) {
        cvt_set(ctl, 0, a.in[8], ws + WS_WR, D, D, D, 0, 3, D * D, D * D);
        cvt_set(ctl, 1, a.in[10], ws + WS_WW1, D, 64, D, 0 | 0x100 | (5 << 16), 2, D * 64, 64 * D / 2);
        cvt_set(ctl, 2, a.in[13], ws + WS_WA1, D, 64, D, 0 | 0x100 | (5 << 16), 2, D * 64, 64 * D / 2);
        cvt_set(ctl, 3, a.in[15], ws + WS_WG1, D, 160, D, 0, 1, 0, 0);
        cvt_set(ctl, 4, a.in[11], ws + WS_W2W, 64, D, 64, 0x200, 2, 64 * D, D * 64);
        cvt_set(ctl, 5, a.in[14], ws + WS_W2A, 64, D, 64, 0x200, 2, 64 * D, D * 64);
        cvt_set(ctl, 6, a.in[16], ws + WS_W2G, 160, D, 160, 0, 1, 0, 0);
        cvt_set(ctl, 7, a.in[22], ws + WS_WOUT, D, D, D, 0, 1, 0, 0);
        cvt_set(ctl, 8, a.in[26], ws + WS_WGU, D, 2 * FF, D, 1 | 0x100 | (5 << 16), 1, 0, 0);
        cvt_set(ctl, 9, a.in[27], ws + WS_WDN, FF, D, FF, 0 | 0x100 | (6 << 16), 1, 0, 0);
        cvt_set(ctl, 10, a.in[23], ws + WS_WCI, D, 3 * D, D, 2, 1, 0, 0);
        cvt_set(ctl, 11, a.in[25], ws + WS_WCO, D, D, D, 0, 1, 0, 0);
        cvt_set(ctl, 12, a.in[29], ws + WS_MGU, D, 2 * FF, D, 1 | 0x100 | (5 << 16), NE, D * 2 * FF, FF * D);
        cvt_set(ctl, 13, a.in[30], ws + WS_MDN, FF, D, FF, 0 | 0x100 | (6 << 16), NE, FF * D, D * FF / 2);
    }
    if (blockIdx.x == 0 && tid < 64) ((int*)(ws + WS_CTL))[tid] = 0;
    {
        LAS float* s = (LAS float*)lds; LAS float* red = (LAS float*)(lds + 36864);
        for (int u = blockIdx.x; u < 192; u += G) {
            const int layer = u / 96, n0 = (u % 96) * 64;
            for (int idx = tid; idx < 9 * D; idx += NTHREADS) { const int b = idx >> 10, k = idx & 1023; const float cv = b < 8 ? a.in[1][b * D + k] : a.in[3][k]; s[idx] = siluf_(cv); }
            __syncthreads();
            const float* W = a.in[4] + (size_t)layer * D * 6 * D + n0 + lane;
            float acc[9];
#pragma unroll
            for (int b = 0; b < 9; ++b) acc[b] = 0.f;
#pragma unroll 4
            for (int k = 128 * wave; k < 128 * wave + 128; k += 4) {
                const float w0 = W[(size_t)k * 6144], w1 = W[(size_t)(k + 1) * 6144], w2 = W[(size_t)(k + 2) * 6144], w3 = W[(size_t)(k + 3) * 6144];
#pragma unroll
                for (int b = 0; b < 9; ++b) { const f32x4 sv = *(const LAS f32x4*)(s + b * D + k); acc[b] += sv[0] * w0 + sv[1] * w1 + sv[2] * w2 + sv[3] * w3; }
            }
#pragma unroll
            for (int b = 0; b < 9; ++b) red[(wave * 9 + b) * 64 + lane] = acc[b];
            __syncthreads();
            for (int idx = tid; idx < 9 * 64; idx += NTHREADS) { const int b = idx >> 6, l = idx & 63; float t = 0.f;
#pragma unroll
                for (int w = 0; w < 8; ++w) t += red[(w * 9 + b) * 64 + l];
                ((float*)(ws + WS_MODS))[(size_t)(layer * 9 + b) * 6144 + n0 + l] = t + a.in[5][layer * 6144 + n0 + l]; }
            __syncthreads();
        }
    }
    const int gw = blockIdx.x * NWAVES + wave, NGW = G * NWAVES;
    for (int row = gw; row < MT; row += NGW) {
        const float* xr = row < M ? a.in[0] + (size_t)row * D : a.in[2] + (size_t)(row - M) * D;
        float ss = 0.f;
#pragma unroll
        for (int j = 0; j < 4; ++j) { const f32x4 v = ld4(xr + 4 * lane + 256 * j); ss += v[0] * v[0] + v[1] * v[1] + v[2] * v[2] + v[3] * v[3]; }
        ss = wave_sum(ss);
        if (lane == 0) ((float*)(ws + WS_RSTD))[row] = rsqrtf(ss * (1.0f / D) + NORM_EPS);
    }
    {
        const int gt = blockIdx.x * NTHREADS + tid, NGT = G * NTHREADS;
        const u32x4 z = (u32x4){0u, 0u, 0u, 0u};
        for (int i = gt; i < 128 * D / 16; i += NGT) { ((u32x4*)(ws + WS_WW1 + 128 * D))[i] = z; ((u32x4*)(ws + WS_WA1 + 128 * D))[i] = z; }
        for (int i = gt; i < 96 * D / 8; i += NGT) ((u32x4*)(ws + WS_WG1 + 160 * D * 2))[i] = z;
    }
    __syncthreads();
    {
        LAS float* scr = (LAS float*)(lds + wave * 16640);
        const int nitems = rfl(ctl[3]);
        f32x4 v[16]; CvtIt cur, nxt;
        int it = gw;
        if (it < nitems) { cvt_decode(ctl, it, cur); cvt_load(cur, v, lane); }
        for (; it < nitems; it += NGW) {
            cvt_to_lds(v, scr, lane);
            const bool more = it + NGW < nitems;
            if (more) { cvt_decode(ctl, it + NGW, nxt); cvt_load(nxt, v, lane); }
            cvt_store(cur, scr, lane);
            if (more) cur = nxt;
        }
    }
}

__device__ __forceinline__ void phase_mix(const Args& a, int gw, int NGW, int lane) {
    unsigned char* ws = a.ws;
    const float* g = a.in[6];
    const float* mu = a.in[7];
    const float* mods = (const float*)(ws + WS_MODS);
    const float* rstd = (const float*)(ws + WS_RSTD);
    bf16_t* XN = (bf16_t*)(ws + WS_XN);
    const int rpw = (MT + NGW - 1) / NGW;
    const int rbeg = gw * rpw, rend = (rbeg + rpw) < MT ? (rbeg + rpw) : MT;
    float muv[6][2][8], gs[2][8], sh[2][8];
#pragma unroll
    for (int n = 0; n < 6; ++n)
#pragma unroll
        for (int j = 0; j < 2; ++j) { const f32x4 t0 = ld4(mu + n * D + 512 * j + 8 * lane), t1 = ld4(mu + n * D + 512 * j + 8 * lane + 4);
#pragma unroll
            for (int e = 0; e < 4; ++e) { muv[n][j][e] = t0[e]; muv[n][j][4 + e] = t1[e]; } }
    int curb = -1;
    f32x4 ps[2][2], pn_[2][2]; float prs = 0.f, prn[2] = {0.f, 0.f};
#define MIX_LOAD(rowv) do { const int row_ = (rowv); const bool ic_ = row_ >= M; const int r2_ = ic_ ? row_ - M : row_; const int t_ = ic_ ? r2_ % TCX : r2_ % T; \
        const float* base_ = ic_ ? a.in[2] : a.in[0]; prs = rstd[row_]; \
        _Pragma("unroll") for (int j = 0; j < 2; ++j) { int d_; \
            if (!ic_) { const int col = t_ & 63, gr = t_ >> 6, qd = 2 * j + (lane >> 5); \
                d_ = qd == 0 ? (col > 0 ? -1 : 0) : qd == 1 ? (col < 63 ? 1 : 0) : qd == 2 ? (gr > 0 ? -64 : 0) : (gr < 31 ? 64 : 0); \
            } else d_ = j == 0 ? (t_ > 0 ? -1 : 0) : (t_ < TCX - 1 ? 1 : 0); \
            const int c = 512 * j + 8 * lane; const float* p0_ = base_ + (size_t)r2_ * D + c; const float* p1_ = base_ + (size_t)(r2_ + d_) * D + c; \
            ps[j][0] = ld4(p0_); ps[j][1] = ld4(p0_ + 4); pn_[j][0] = ld4(p1_); pn_[j][1] = ld4(p1_ + 4); prn[j] = d_ != 0 ? rstd[row_ + d_] : 0.f; } } while (0)
    if (rbeg < rend) MIX_LOAD(rbeg);
    for (int row = rbeg; row < rend; ++row) {
        const bool isctx = row >= M;
        const int r2 = isctx ? row - M : row;
        const int b = isctx ? r2 / TCX : r2 / T;
        const int mb = isctx ? 8 : b;
        if (mb != curb) { curb = mb; const float* md = mods + (size_t)mb * 6144;
#pragma unroll
            for (int j = 0; j < 2; ++j) { const int c = 512 * j + 8 * lane;
#pragma unroll
                for (int e = 0; e < 8; e += 4) { const f32x4 gv = ld4(g + c + e), shv = ld4(md + c + e), scv = ld4(md + D + c + e);
#pragma unroll
                    for (int i = 0; i < 4; ++i) { gs[j][e + i] = gv[i] * (1.0f + scv[i]); sh[j][e + i] = shv[i]; } } } }
        f32x4 cs[2][2], cn[2][2]; const float rs = prs; float rn[2];
#pragma unroll
        for (int j = 0; j < 2; ++j) { cs[j][0] = ps[j][0]; cs[j][1] = ps[j][1]; cn[j][0] = pn_[j][0]; cn[j][1] = pn_[j][1]; rn[j] = prn[j]; }
        if (row + 1 < rend) MIX_LOAD(row + 1);
#pragma unroll
        for (int j = 0; j < 2; ++j) {
            const int c = 512 * j + 8 * lane;
            const float msk = rn[j] != 0.f ? 1.0f : 0.0f;
            float hs[8], dx[8];
#pragma unroll
            for (int e = 0; e < 8; ++e) { const float xs_ = cs[j][e >> 2][e & 3], xn_ = cn[j][e >> 2][e & 3];
                hs[e] = xs_ * rs * gs[j][e] + sh[j][e];
                const float hn = xn_ * rn[j] * gs[j][e] + sh[j][e] * msk;
                dx[e] = hn - hs[e]; }
#pragma unroll
            for (int n = 0; n < 6; ++n) { float o[8];
#pragma unroll
                for (int e = 0; e < 8; ++e) o[e] = hs[e] + dx[e] * muv[n][j][e];
                if (n == 1 || n == 4) {
                    int w0 = __builtin_amdgcn_cvt_pk_fp8_f32(o[0], o[1], 0, false); w0 = __builtin_amdgcn_cvt_pk_fp8_f32(o[2], o[3], w0, true);
                    int w1 = __builtin_amdgcn_cvt_pk_fp8_f32(o[4], o[5], 0, false); w1 = __builtin_amdgcn_cvt_pk_fp8_f32(o[6], o[7], w1, true);
                    *(u32x2*)((unsigned char*)(XN + (size_t)n * MT * D) + (size_t)row * D + c) = (u32x2){(unsigned)w0, (unsigned)w1};
                } else *(u32x4*)(XN + ((size_t)n * MT + row) * D + c) = pack8(o); }
        }
    }
#undef MIX_LOAD
}

__device__ __forceinline__ void phase_fin(const Args& a, LAS unsigned char* lds, int tid, int lane, int wave, int G) {
    unsigned char* ws = a.ws;
    const int q = lane >> 4, rho = lane & 15;
    const bf16_t* W2W = (const bf16_t*)(ws + WS_W2W); const bf16_t* W2A = (const bf16_t*)(ws + WS_W2A); const bf16_t* W2G = (const bf16_t*)(ws + WS_W2G);
    const bf16_t* L1W = (const bf16_t*)(ws + WS_L1W); const bf16_t* L1A = (const bf16_t*)(ws + WS_L1A); const bf16_t* L1G = (const bf16_t*)(ws + WS_L1G);
    const bf16_t* KR = (const bf16_t*)(ws + WS_KRAW); const bf16_t* RB = (const bf16_t*)(ws + WS_R);
    bf16_t* AT = (bf16_t*)(ws + WS_AT); bf16_t* BT = (bf16_t*)(ws + WS_BT); bf16_t* KT = (bf16_t*)(ws + WS_KT); bf16_t* RT = (bf16_t*)(ws + WS_RT); float* GC = (float*)(ws + WS_GC); bf16_t* GATE = (bf16_t*)(ws + WS_GATE);
    float* BONUS = (float*)(ws + WS_BONUS);
    const int nparts = G / NH;
    {
        const int h = blockIdx.x % NH;
        const int part = blockIdx.x / NH;
        if (part >= nparts) return;
        __syncthreads();
        for (int f = wave; f < 52; f += NWAVES) {
            int mat, p, n, s;
            if (f < 32) { mat = f >> 3; p = (f >> 2) & 1; n = (f >> 1) & 1; s = f & 1; } else { const int r = f - 32; mat = 4; p = r / 10; n = (r % 10) / 5; s = r % 5; }
            const int ch = h * 64 + p * 32 + 8 * (rho >> 2) + 4 * n + (rho & 3), k = 32 * s + 8 * q;
            const bf16_t* src = mat < 2 ? W2W + ((size_t)mat * D + ch) * 64 + k : mat < 4 ? W2A + ((size_t)(mat - 2) * D + ch) * 64 + k : W2G + (size_t)ch * 160 + k;
            *(LAS u32x4*)(lds + f * 1024 + lane * 16) = *(const u32x4*)src;
        }
        LAS float* PRM = (LAS float*)(lds + 53248);
        if (tid < 448) { const int arr = tid >> 6, c = tid & 63;
            PRM[tid] = arr < 2 ? a.in[9][arr * D + h * 64 + c] : arr < 4 ? a.in[12][(arr - 2) * D + h * 64 + c] : arr == 4 ? a.in[17][h * 64 + c] : arr == 5 ? a.in[18][h * 64 + c] : a.in[19][h * 64 + c]; }
        __syncthreads();
        bf16x8 n_tw[2][2], n_ta[2][2], n_tg[5]; u32x4 n_kv[2], n_rv[2];
#define FIN_LOAD(rbv) do { const int trow_ = (rbv) * 128 + wave * 16 + rho; const bool lat_ = ((rbv) * 128) < M; \
            _Pragma("unroll") for (int z = 0; z < 2; ++z) _Pragma("unroll") for (int s_ = 0; s_ < 2; ++s_) { n_tw[z][s_] = *(const bf16x8*)(L1W + (size_t)trow_ * 256 + z * 64 + 32 * s_ + 8 * q); n_ta[z][s_] = *(const bf16x8*)(L1A + (size_t)trow_ * 256 + z * 64 + 32 * s_ + 8 * q); } \
            if (lat_) { _Pragma("unroll") for (int s_ = 0; s_ < 5; ++s_) n_tg[s_] = *(const bf16x8*)(L1G + (size_t)trow_ * 256 + 32 * s_ + 8 * q); } \
            const size_t hb_ = ((size_t)(hm_row(trow_) + h * NPOS)) * 64; \
            _Pragma("unroll") for (int p_ = 0; p_ < 2; ++p_) { n_kv[p_] = *(const u32x4*)(KR + hb_ + p_ * 32 + 8 * q); if (lat_) n_rv[p_] = *(const u32x4*)(RB + hb_ + p_ * 32 + 8 * q); } } while (0)
        if (part < MT / 128) FIN_LOAD(part);
        for (int rb = part; rb < MT / 128; rb += nparts) {
            const int trow = rb * 128 + wave * 16 + rho;
            const bool lat = (rb * 128) < M;
            f32x4 aw[2][2][2], aa[2][2][2]; u32x4 gpk[2];
#pragma unroll
            for (int p = 0; p < 2; ++p)
#pragma unroll
                for (int n = 0; n < 2; ++n) {
#pragma unroll
                    for (int z = 0; z < 2; ++z) { aw[p][z][n] = (f32x4){0.f, 0.f, 0.f, 0.f}; aa[p][z][n] = (f32x4){0.f, 0.f, 0.f, 0.f};
#pragma unroll
                        for (int s = 0; s < 2; ++s) {
                            const bf16x8 fw = *(const LAS bf16x8*)(lds + ((z) * 8 + p * 4 + n * 2 + s) * 1024 + lane * 16);
                            const bf16x8 fa = *(const LAS bf16x8*)(lds + ((2 + z) * 8 + p * 4 + n * 2 + s) * 1024 + lane * 16);
                            aw[p][z][n] = __builtin_amdgcn_mfma_f32_16x16x32_bf16(fw, n_tw[z][s], aw[p][z][n], 0, 0, 0);
                            aa[p][z][n] = __builtin_amdgcn_mfma_f32_16x16x32_bf16(fa, n_ta[z][s], aa[p][z][n], 0, 0, 0); } }
                    if (lat) {
                        f32x4 ag = (f32x4){0.f, 0.f, 0.f, 0.f};
#pragma unroll
                        for (int s = 0; s < 5; ++s) { const bf16x8 fg = *(const LAS bf16x8*)(lds + (32 + p * 10 + n * 5 + s) * 1024 + lane * 16);
                            ag = __builtin_amdgcn_mfma_f32_16x16x32_bf16(fg, n_tg[s], ag, 0, 0, 0); }
                        if (n == 0) { gpk[p].x = cvt_pk_bf16(ag[0], ag[1]); gpk[p].y = cvt_pk_bf16(ag[2], ag[3]); } else { gpk[p].z = cvt_pk_bf16(ag[0], ag[1]); gpk[p].w = cvt_pk_bf16(ag[2], ag[3]); }
                    }
                }
            const u32x4 c_kv0 = n_kv[0], c_kv1 = n_kv[1], c_rv0 = n_rv[0], c_rv1 = n_rv[1];
            asm volatile("" :: "v"(c_kv0), "v"(c_kv1), "v"(c_rv0), "v"(c_rv1));
            if (rb + nparts < MT / 128) FIN_LOAD(rb + nparts);
            const int hr = hm_row(trow), bb = hr / (NH * NPOS), pos = hr - bb * (NH * NPOS);
            const size_t hbase = ((size_t)(hr + h * NPOS)) * 64;
            float ssq = 0.f, bon = 0.f;
#pragma unroll
            for (int p = 0; p < 2; ++p) { float kvt[8]; unpack8(p ? c_kv1 : c_kv0, kvt);
#pragma unroll
                for (int e = 0; e < 8; ++e) { const float kr = kvt[e] * PRM[4 * 64 + p * 32 + 8 * q + e]; ssq += kr * kr; } }
            ssq += __shfl_xor(ssq, 16); ssq += __shfl_xor(ssq, 32);
            const float inv = rsqrtf(fmaxf(ssq, 1e-24f));
#pragma unroll
            for (int p = 0; p < 2; ++p) {
                const int cl = p * 32 + 8 * q, cb = h * 64 + cl;
                const LAS float* pp = PRM + cl;
                float kv[8], rv[8], kds[8];
                unpack8(p ? c_kv1 : c_kv0, kv);
                if (lat) unpack8(p ? c_rv1 : c_rv0, rv); else { for (int e = 0; e < 8; ++e) rv[e] = 0.f; }
#pragma unroll
                for (int e = 0; e < 8; ++e) kds[e] = 0.f;
#pragma unroll
                for (int z = 0; z < 2; ++z) {
                    float oA[8], oB[8], oK[8], oR[8], gc[8];
#pragma unroll
                    for (int e = 0; e < 8; ++e) {
                        const int n = e >> 2, i = e & 3;
                        const float dl = -0.60653066f * sigmoidf_(aw[p][z][n][i] + pp[z * 64 + e]);
                        const float ic = sigmoidf_(aa[p][z][n][i] + pp[(2 + z) * 64 + e]);
                        float cum = dl, epv;
                        if (z == 0) { cum += dpp_mov<0x111>(cum); cum += dpp_mov<0x112>(cum); cum += dpp_mov<0x114>(cum); cum += dpp_mov<0x118>(cum); }
                        else        { cum += dpp_mov<0x101>(cum); cum += dpp_mov<0x102>(cum); cum += dpp_mov<0x104>(cum); cum += dpp_mov<0x108>(cum); }
                        const float ec = __builtin_amdgcn_exp2f(cum * 1.44269504f), en = __builtin_amdgcn_rcpf(ec);
                        if (z == 0) { epv = dpp_mov<0x111>(ec); if (rho == 0) epv = 1.0f; } else { epv = dpp_mov<0x101>(ec); if (rho == 15) epv = 1.0f; }
                        const float kk = kv[e] * pp[4 * 64 + e] * inv, bq = kk * ic, kd = kv[e] * (1.0f + (ic - 1.0f) * pp[5 * 64 + e]);
                        oA[e] = -kk * epv; oB[e] = bq * en; oK[e] = kd * en; oR[e] = rv[e] * ec; gc[e] = ec; kds[e] += kd;
                    }
                    *(u32x4*)(AT + (size_t)z * HMA + hbase + cl) = pack8(oA); *(u32x4*)(BT + (size_t)z * HMA + hbase + cl) = pack8(oB);
                    *(u32x4*)(KT + (size_t)z * HMA + hbase + cl) = pack8(oK); *(u32x4*)(RT + (size_t)z * HMA + hbase + cl) = pack8(oR);
                    if (rho == (z == 0 ? 15 : 0)) { float* gp = GC + (((size_t)z * NB * NH + bb * NH + h) * NCHK + (pos >> 4)) * 64 + cl;
                        *(f32x4*)gp = (f32x4){gc[0], gc[1], gc[2], gc[3]}; *(f32x4*)(gp + 4) = (f32x4){gc[4], gc[5], gc[6], gc[7]}; }
                }
                if (lat) {
#pragma unroll
                    for (int e = 0; e < 8; ++e) bon += rv[e] * 0.5f * kds[e] * pp[6 * 64 + e];
                    *(u32x4*)(GATE + (size_t)trow * D + cb) = gpk[p];
                }
            }
            if (lat) { bon += __shfl_xor(bon, 16); bon += __shfl_xor(bon, 32); if (q == 0) BONUS[(size_t)trow * NH + h] = bon; }
        }
    }
}

#undef FIN_LOAD
typedef unsigned short u16;
typedef short s16x4 __attribute__((ext_vector_type(4)));
constexpr int SC_PITCHB = 144;
constexpr int SET_R = 0, SET_P = 2304, SET_BH = 4608, SET_KH = 6912, SET_V = 9216, SET_TLM = 11520, SET_G = 13312, SET_BYTES = 13568;
constexpr int TLM_PITCHB = 112;
constexpr int SCR_OFF = 8 * SET_BYTES, SCR_BYTES = 2304;
static_assert(SCR_OFF + 4 * SCR_BYTES <= CTL_OFF, "scan LDS map");

__device__ __forceinline__ f32x4 mfma16(u32x4 a, u32x4 b, f32x4 c) {
    return __builtin_amdgcn_mfma_f32_16x16x32_bf16(__builtin_bit_cast(bf16x8, a), __builtin_bit_cast(bf16x8, b), c, 0, 0, 0);
}
__device__ __forceinline__ u32x4 opnd(f32x4 d) { u32x4 w; w.x = cvt_pk_bf16(d[0], d[1]); w.y = cvt_pk_bf16(d[2], d[3]); w.z = 0u; w.w = 0u; return w; }
__device__ __forceinline__ f32x4 mfma16h(u32x2 a, u32x2 b, f32x4 c) { return __builtin_amdgcn_mfma_f32_16x16x16bf16_1k(__builtin_bit_cast(s16x4, a), __builtin_bit_cast(s16x4, b), c, 0, 0, 0); }
__device__ __forceinline__ u32x2 opnd2(f32x4 d) { u32x2 w; w.x = cvt_pk_bf16(d[0], d[1]); w.y = cvt_pk_bf16(d[2], d[3]); return w; }
__device__ __forceinline__ unsigned tr_addr(unsigned matbase, int pitchb, int r0, int c0, int rho) { return matbase + (unsigned)((r0 + (rho >> 2)) * pitchb + (c0 + 4 * (rho & 3)) * 2); }

__device__ __forceinline__ int scan_row(int b, int dir, int s) {
    if (s < TCX) return M + b * TCX + (dir ? (TCX - 1 - s) : s);
    const int u = s - TCX; return b * T + (dir ? (T - 1 - u) : u);
}

__device__ __forceinline__ void scan_produce_tail(LAS unsigned char* set, LAS unsigned char* scr, int rho, int q) {
                asm volatile("s_waitcnt lgkmcnt(0)" ::: "memory");
                u32x4 fA[2], fB[2], fK[2], fR[2];
#pragma unroll
                for (int ks = 0; ks < 2; ++ks) { const int fo = rho * SC_PITCHB + (32 * ks + 8 * q) * 2;
                    fA[ks] = *(const LAS u32x4*)(scr + fo); fB[ks] = *(const LAS u32x4*)(set + SET_BH + fo); fK[ks] = *(const LAS u32x4*)(set + SET_KH + fo); fR[ks] = *(const LAS u32x4*)(set + SET_R + fo); }
                const f32x4 z4 = (f32x4){0.f, 0.f, 0.f, 0.f};
                f32x4 Lt = mfma16(fB[1], fA[1], mfma16(fB[0], fA[0], z4));
                f32x4 L  = mfma16(fA[1], fB[1], mfma16(fA[0], fB[0], z4));
                f32x4 Lk = mfma16(fA[1], fK[1], mfma16(fA[0], fK[0], z4));
                f32x4 Mb = mfma16(fB[1], fR[1], mfma16(fB[0], fR[0], z4));
                f32x4 Mk = mfma16(fK[1], fR[1], mfma16(fK[0], fR[0], z4));
                f32x4 Tt;
#pragma unroll
                for (int r = 0; r < 4; ++r) { const int rr_ = 4 * q + r;
                    Lt[r] = rr_ < rho ? Lt[r] : 0.f; Mb[r] = rr_ <= rho ? Mb[r] : 0.f; Mk[r] = rr_ <= rho ? Mk[r] : 0.f;
                    L[r] = rho < rr_ ? L[r] : 0.f; Lk[r] = rho < rr_ ? Lk[r] : 0.f;
                    Tt[r] = Lt[r] + (rr_ == rho ? 1.0f : 0.f); }
                { u32x2 w; w.x = cvt_pk_bf16(Mb[0], Mb[1]); w.y = cvt_pk_bf16(Mb[2], Mb[3]); *(LAS u32x2*)(set + SET_TLM + rho * TLM_PITCHB + (16 + 4 * q) * 2) = w;
                  w.x = cvt_pk_bf16(Mk[0], Mk[1]); w.y = cvt_pk_bf16(Mk[2], Mk[3]); *(LAS u32x2*)(set + SET_TLM + rho * TLM_PITCHB + (32 + 4 * q) * 2) = w; }
                const u32x2 oL = opnd2(L), oLt = opnd2(Lt);
                f32x4 X = mfma16h(oLt, oL, z4), Xt = mfma16h(oL, oLt, z4);
                u32x2 oX = opnd2(X), oXt = opnd2(Xt);
                Tt = mfma16h(oX, opnd2(Tt), Tt);
                X = mfma16h(oXt, oX, z4); Xt = mfma16h(oX, oXt, z4);
                oX = opnd2(X); oXt = opnd2(Xt);
                Tt = mfma16h(oX, opnd2(Tt), Tt);
                X = mfma16h(oXt, oX, z4);
                oX = opnd2(X);
                Tt = mfma16h(oX, opnd2(Tt), Tt);
                const u32x2 oT = opnd2(Tt);
                { const f32x4 tl = mfma16h(opnd2(Lk), oT, z4);
                  u32x2 w; w.x = cvt_pk_bf16(tl[0], tl[1]); w.y = cvt_pk_bf16(tl[2], tl[3]); *(LAS u32x2*)(set + SET_TLM + rho * TLM_PITCHB + (4 * q) * 2) = w; }
                {
                    const LAS unsigned char* ab = scr + (4 * q + (rho >> 2)) * SC_PITCHB + (4 * (rho & 3)) * 2;
                    const u32x2 t0 = __builtin_bit_cast(u32x2, __builtin_amdgcn_ds_read_tr16_b64_v4i16((LAS s16x4*)(ab))), t1 = __builtin_bit_cast(u32x2, __builtin_amdgcn_ds_read_tr16_b64_v4i16((LAS s16x4*)(ab + 32))),
                                t2 = __builtin_bit_cast(u32x2, __builtin_amdgcn_ds_read_tr16_b64_v4i16((LAS s16x4*)(ab + 64))), t3 = __builtin_bit_cast(u32x2, __builtin_amdgcn_ds_read_tr16_b64_v4i16((LAS s16x4*)(ab + 96)));
                    const f32x4 p0 = mfma16h(t0, oT, z4), p1 = mfma16h(t1, oT, z4);
                    const f32x4 p2 = mfma16h(t2, oT, z4), p3 = mfma16h(t3, oT, z4);
                    LAS unsigned char* pr = set + SET_P + rho * SC_PITCHB + (4 * q) * 2;
                    u32x2 w;
                    w.x = cvt_pk_bf16(p0[0], p0[1]); w.y = cvt_pk_bf16(p0[2], p0[3]); *(LAS u32x2*)(pr + 0) = w;
                    w.x = cvt_pk_bf16(p1[0], p1[1]); w.y = cvt_pk_bf16(p1[2], p1[3]); *(LAS u32x2*)(pr + 32) = w;
                    w.x = cvt_pk_bf16(p2[0], p2[1]); w.y = cvt_pk_bf16(p2[2], p2[3]); *(LAS u32x2*)(pr + 64) = w;
                    w.x = cvt_pk_bf16(p3[0], p3[1]); w.y = cvt_pk_bf16(p3[2], p3[3]); *(LAS u32x2*)(pr + 96) = w;
                }
                asm volatile("s_waitcnt lgkmcnt(0)" ::: "memory");
}

constexpr int WF_OFF = SCR_OFF + 8 * 2304, GF_OFF = WF_OFF + 16384, PRM_OFF = GF_OFF + 10240, FLG_OFF = PRM_OFF + 5 * 64 * 4;
static_assert(FLG_OFF + 64 <= CTL_OFF, "fused scan LDS map");
template <int DIR>
__device__ __forceinline__ void scan_producer(const Args& a, LAS unsigned char* lds, int lane, int p, int b, int h) {
    unsigned char* ws = a.ws;
    const int rho = lane & 15, q = lane >> 4, nr0 = lane >> 3, cc = lane & 7, bh = b * NH + h;
    constexpr int NR = NCHK / 4;
    const LAS float* PRM = (const LAS float*)(lds + PRM_OFF);
    const bf16_t* L1W = (const bf16_t*)(ws + WS_L1W); const bf16_t* L1A = (const bf16_t*)(ws + WS_L1A); const bf16_t* L1G = (const bf16_t*)(ws + WS_L1G);
    const bf16_t* KR = (const bf16_t*)(ws + WS_KRAW); const bf16_t* RB = (const bf16_t*)(ws + WS_R); const bf16_t* VB = (const bf16_t*)(ws + WS_V);
    bf16_t* GATE = (bf16_t*)(ws + WS_GATE); float* BON = (float*)(ws + (DIR ? WS_BONUS1 : WS_BONUS));
    bf16x8 n_tw[2], n_ta[2], n_tg[5]; u32x4 n_kv[2], n_rv[2], n_vv[2];
#define FS_NATC(chv) (DIR ? ((chv) < TCX / 16 ? TCX / 16 - 1 - (chv) : NCHK + TCX / 16 - 1 - (chv)) : (chv))
#define FS_TROW(natc) ((natc) < TCX / 16 ? M + b * TCX + 16 * (natc) + rho : b * T + 16 * (natc) - TCX + rho)
#define FS_LD16(T_, wsoff_, off_) (*(const T_*)(ws + (unsigned)((unsigned)(wsoff_) + (off_))))
#define FS_LOAD_A(chv) do { const int natc_ = FS_NATC(chv); const bool lat_ = natc_ >= TCX / 16; const int trow_ = FS_TROW(natc_); \
        const unsigned wo_ = (unsigned)(trow_ * 512 + DIR * 128 + 16 * q), go_ = (unsigned)((lat_ ? trow_ : rho) * 512 + 16 * q); \
        _Pragma("unroll") for (int s_ = 0; s_ < 2; ++s_) { n_tw[s_] = FS_LD16(bf16x8, WS_L1W, wo_ + 64 * s_); n_ta[s_] = FS_LD16(bf16x8, WS_L1A, wo_ + 64 * s_); } \
        _Pragma("unroll") for (int s_ = 0; s_ < 5; ++s_) n_tg[s_] = FS_LD16(bf16x8, WS_L1G, go_ + 64 * s_); } while (0)
#define FS_LOAD_B(chv) do { const int natc_ = FS_NATC(chv); \
        const unsigned hb_ = (unsigned)((bh * NPOS + 16 * natc_ + rho) * 128 + 16 * q); \
        _Pragma("unroll") for (int p_ = 0; p_ < 2; ++p_) { n_kv[p_] = FS_LD16(u32x4, WS_KRAW, hb_ + 64 * p_); n_rv[p_] = FS_LD16(u32x4, WS_R, hb_ + 64 * p_); } \
        const unsigned vo_ = (unsigned)((bh * NPOS + 16 * natc_ + nr0) * 128 + 16 * cc); \
        n_vv[0] = FS_LD16(u32x4, WS_V, vo_); n_vv[1] = FS_LD16(u32x4, WS_V, vo_ + 1024); } while (0)
    FS_LOAD_A(p); FS_LOAD_B(p);
    for (int n = 0; n < NR; ++n) {
        const int ch = 4 * n + p, natc = FS_NATC(ch); const bool lat = natc >= TCX / 16; const int trow = FS_TROW(natc);
        LAS unsigned char* set = lds + ((n & 1) * 4 + p) * SET_BYTES;
        LAS unsigned char* scr = lds + SCR_OFF + ((n & 1) * 4 + p) * 2304;
        f32x4 aw[2][2], aa[2][2]; u32x4 gpk = (u32x4){0u, 0u, 0u, 0u};
#pragma unroll
        for (int pp = 0; pp < 2; ++pp)
#pragma unroll
            for (int nn = 0; nn < 2; ++nn) { aw[pp][nn] = (f32x4){0.f, 0.f, 0.f, 0.f}; aa[pp][nn] = (f32x4){0.f, 0.f, 0.f, 0.f};
#pragma unroll
                for (int s = 0; s < 2; ++s) {
                    const bf16x8 fw = *(const LAS bf16x8*)(lds + WF_OFF + (pp * 4 + nn * 2 + s) * 1024 + lane * 16);
                    const bf16x8 fa = *(const LAS bf16x8*)(lds + WF_OFF + (8 + pp * 4 + nn * 2 + s) * 1024 + lane * 16);
                    aw[pp][nn] = __builtin_amdgcn_mfma_f32_16x16x32_bf16(fw, n_tw[s], aw[pp][nn], 0, 0, 0);
                    aa[pp][nn] = __builtin_amdgcn_mfma_f32_16x16x32_bf16(fa, n_ta[s], aa[pp][nn], 0, 0, 0); } }
        if (lat) {
#pragma unroll
            for (int nn = 0; nn < 2; ++nn) { f32x4 ag = (f32x4){0.f, 0.f, 0.f, 0.f};
#pragma unroll
                for (int s = 0; s < 5; ++s) { const bf16x8 fg = *(const LAS bf16x8*)(lds + GF_OFF + (nn * 5 + s) * 1024 + lane * 16);
                    ag = __builtin_amdgcn_mfma_f32_16x16x32_bf16(fg, n_tg[s], ag, 0, 0, 0); }
                if (nn == 0) { gpk.x = cvt_pk_bf16(ag[0], ag[1]); gpk.y = cvt_pk_bf16(ag[2], ag[3]); } else { gpk.z = cvt_pk_bf16(ag[0], ag[1]); gpk.w = cvt_pk_bf16(ag[2], ag[3]); } }
        }
        const int chn = n + 1 < NR ? ch + 4 : ch;
        FS_LOAD_A(chn);
        float ssq = 0.f, bon = 0.f;
#pragma unroll
        for (int pp = 0; pp < 2; ++pp) { float kvt[8]; unpack8(pp ? n_kv[1] : n_kv[0], kvt);
#pragma unroll
            for (int e = 0; e < 8; ++e) { const float kr = kvt[e] * PRM[2 * 64 + pp * 32 + 8 * q + e]; ssq += kr * kr; } }
        ssq += __shfl_xor(ssq, 16); ssq += __shfl_xor(ssq, 32);
        const float inv = rsqrtf(fmaxf(ssq, 1e-24f));
        const int tau = DIR ? 15 - rho : rho;
#pragma unroll
        for (int pp = 0; pp < 2; ++pp) {
            const int cl = pp * 32 + 8 * q;
            const LAS float* pr = PRM + cl;
            float kv[8], rv[8], oA[8], oB[8], oK[8], oR[8], gc[8];
            unpack8(pp ? n_kv[1] : n_kv[0], kv);
            if (lat) unpack8(pp ? n_rv[1] : n_rv[0], rv); else { for (int e = 0; e < 8; ++e) rv[e] = 0.f; }
#pragma unroll
            for (int e = 0; e < 8; ++e) {
                const int nn = e >> 2, i = e & 3;
                const float dl = -0.87503877f * __builtin_amdgcn_rcpf(1.0f + __builtin_amdgcn_exp2f(aw[pp][nn][i] + pr[e]));
                const float ic = __builtin_amdgcn_rcpf(1.0f + __builtin_amdgcn_exp2f(aa[pp][nn][i] + pr[64 + e]));
                float cum = dl, epv;
                if (DIR == 0) { cum += dpp_mov<0x111>(cum); cum += dpp_mov<0x112>(cum); cum += dpp_mov<0x114>(cum); cum += dpp_mov<0x118>(cum); }
                else          { cum += dpp_mov<0x101>(cum); cum += dpp_mov<0x102>(cum); cum += dpp_mov<0x104>(cum); cum += dpp_mov<0x108>(cum); }
                const float ec = __builtin_amdgcn_exp2f(cum), en = __builtin_amdgcn_rcpf(ec);
                if (DIR == 0) { epv = dpp_mov<0x111>(ec); if (rho == 0) epv = 1.0f; } else { epv = dpp_mov<0x101>(ec); if (rho == 15) epv = 1.0f; }
                const float kk = kv[e] * pr[2 * 64 + e] * inv, bq = kk * ic, kd = kv[e] * (1.0f + (ic - 1.0f) * pr[3 * 64 + e]);
                oA[e] = -kk * epv; oB[e] = bq * en; oK[e] = kd * en; oR[e] = rv[e] * ec; gc[e] = ec;
                bon += rv[e] * kd * pr[4 * 64 + e];
            }
            const int ro = tau * SC_PITCHB + cl * 2;
            *(LAS u32x4*)(scr + ro) = pack8v(oA); *(LAS u32x4*)(set + SET_BH + ro) = pack8v(oB); *(LAS u32x4*)(set + SET_KH + ro) = pack8v(oK); *(LAS u32x4*)(set + SET_R + ro) = pack8v(oR);
            if (rho == (DIR ? 0 : 15)) { *(LAS f32x4*)(set + SET_G + cl * 4) = (f32x4){gc[0], gc[1], gc[2], gc[3]}; *(LAS f32x4*)(set + SET_G + cl * 4 + 16) = (f32x4){gc[4], gc[5], gc[6], gc[7]}; }
            asm volatile("" ::: "memory");
        }
        { const int t0 = DIR ? 15 - nr0 : nr0, t1 = DIR ? 7 - nr0 : nr0 + 8;
          *(LAS u32x4*)(set + SET_V + t0 * SC_PITCHB + 16 * cc) = n_vv[0]; *(LAS u32x4*)(set + SET_V + t1 * SC_PITCHB + 16 * cc) = n_vv[1]; }
        FS_LOAD_B(chn);
        {
            const unsigned go = lat ? (unsigned)(WS_GATE + (size_t)(trow * D + h * 64 + DIR * 32 + 8 * q) * 2) : (unsigned)(WS_DUMP + 16 * lane);
            *(u32x4*)(ws + go) = gpk;
            bon += __shfl_xor(bon, 16); bon += __shfl_xor(bon, 32);
            const unsigned bo = (lat && q == 0) ? (unsigned)((DIR ? WS_BONUS1 : WS_BONUS) + (size_t)(trow * NH + h) * 4) : (unsigned)(WS_DUMP + 1024 + 4 * lane);
            *(float*)(ws + bo) = bon;
        }
        asm volatile("s_waitcnt lgkmcnt(0)" ::: "memory");
        __syncthreads();
    }
#undef FS_LOAD_A
#undef FS_LD16
#undef FS_LOAD_B
#undef FS_TROW
#undef FS_NATC
}

__device__ __forceinline__ void phase_scan_chunked(const Args& a, LAS unsigned char* lds, int tid, int lane, int wave, int G) {
    unsigned char* ws = a.ws;
    const bf16_t* VB = (const bf16_t*)(ws + WS_V);
    const int rho = lane & 15, q = lane >> 4;
    const unsigned ldsb = (unsigned)(size_t)lds;
    constexpr int NCH = NPOS / 16, NR = NCH / 4;
    for (int unit = blockIdx.x; unit < 2 * NB * NH; unit += G) {
        const int b = unit & 7, h = (unit >> 3) & 15, dir = unit >> 7, bh = b * NH + h;
        bf16_t* Yout = (bf16_t*)(ws + (dir ? WS_YB : WS_YF));
        __syncthreads();
        {
            const bf16_t* W2W = (const bf16_t*)(ws + WS_W2W); const bf16_t* W2A = (const bf16_t*)(ws + WS_W2A); const bf16_t* W2G = (const bf16_t*)(ws + WS_W2G);
            for (int f = wave; f < 26; f += NWAVES) {
                const bf16_t* src;
                if (f < 16) { const int mat = f >> 3, pp = (f >> 2) & 1, nn = (f >> 1) & 1, sx = f & 1; const int chn = h * 64 + pp * 32 + 8 * (rho >> 2) + 4 * nn + (rho & 3);
                    src = (mat ? W2A : W2W) + ((size_t)dir * D + chn) * 64 + 32 * sx + 8 * q; }
                else { const int r = f - 16, nn = r / 5, sx = r % 5; const int chn = h * 64 + dir * 32 + 8 * (rho >> 2) + 4 * nn + (rho & 3); src = W2G + (size_t)chn * 160 + 32 * sx + 8 * q; }
                *(LAS u32x4*)(lds + WF_OFF + f * 1024 + lane * 16) = *(const u32x4*)src;
            }
            if (tid < 4) ((LAS int*)(lds + FLG_OFF))[tid] = 0;
            if (tid < 320) { const int arr = tid >> 6, c = tid & 63;
                ((LAS float*)(lds + PRM_OFF))[tid] = arr == 0 ? -1.44269504f * a.in[9][dir * D + h * 64 + c] : arr == 1 ? -1.44269504f * a.in[12][dir * D + h * 64 + c] : arr == 2 ? a.in[17][h * 64 + c] : arr == 3 ? a.in[18][h * 64 + c] : 0.5f * a.in[19][h * 64 + c]; }
            __syncthreads();
        }
        if (wave >= 4) {
            if (dir == 0) scan_producer<0>(a, lds, lane, wave - 4, b, h); else scan_producer<1>(a, lds, lane, wave - 4, b, h);
            __syncthreads();
        } else {
            f32x4 S[4];
#pragma unroll
            for (int jb = 0; jb < 4; ++jb) S[jb] = (f32x4){0.f, 0.f, 0.f, 0.f};
            const f32x4 z4 = (f32x4){0.f, 0.f, 0.f, 0.f};
            const int trb = (4 * q + (rho >> 2)) * SC_PITCHB + (4 * (rho & 3)) * 2;
            const int rowb = rho * SC_PITCHB + (4 * q) * 2, tlmb = SET_TLM + rho * TLM_PITCHB + (4 * q) * 2;
#define TRRD(p) __builtin_bit_cast(u32x2, __builtin_amdgcn_ds_read_tr16_b64_v4i16((LAS s16x4*)(p)))
#define C_LOAD(X, st) \
            LAS unsigned char* const X##bptr = (st); \
            const u32x2 X##tv = TRRD((st) + SET_V + trb + 32 * wave); \
            const u32x2 X##tb0 = TRRD((st) + SET_BH + trb), X##tb1 = TRRD((st) + SET_BH + trb + 32), X##tb2 = TRRD((st) + SET_BH + trb + 64), X##tb3 = TRRD((st) + SET_BH + trb + 96); \
            const u32x2 X##tk0 = TRRD((st) + SET_KH + trb), X##tk1 = TRRD((st) + SET_KH + trb + 32), X##tk2 = TRRD((st) + SET_KH + trb + 64), X##tk3 = TRRD((st) + SET_KH + trb + 96); \
            const u32x2 X##pa = *(const LAS u32x2*)((st) + SET_P + rowb), X##pb = *(const LAS u32x2*)((st) + SET_P + rowb + 32), X##pc = *(const LAS u32x2*)((st) + SET_P + rowb + 64), X##pd = *(const LAS u32x2*)((st) + SET_P + rowb + 96); \
            const u32x2 X##tl = *(const LAS u32x2*)((st) + tlmb);
#define C_COMPUTE(X, chv) do { const int ch_ = (chv); \
            const f32x4 X##g0 = *(const LAS f32x4*)(X##bptr + SET_G + 16 * q), X##g1 = *(const LAS f32x4*)(X##bptr + SET_G + 16 * q + 64), X##g2 = *(const LAS f32x4*)(X##bptr + SET_G + 16 * q + 128), X##g3 = *(const LAS f32x4*)(X##bptr + SET_G + 16 * q + 192); \
            u32x4 bs0, bs1; \
            bs0.x = cvt_pk_bf16(S[0][0], S[0][1]); bs0.y = cvt_pk_bf16(S[0][2], S[0][3]); bs0.z = cvt_pk_bf16(S[1][0], S[1][1]); bs0.w = cvt_pk_bf16(S[1][2], S[1][3]); \
            bs1.x = cvt_pk_bf16(S[2][0], S[2][1]); bs1.y = cvt_pk_bf16(S[2][2], S[2][3]); bs1.z = cvt_pk_bf16(S[3][0], S[3][1]); bs1.w = cvt_pk_bf16(S[3][2], S[3][3]); \
            f32x4 U = mfma16h(X##tl, X##tv, z4); \
            U = mfma16((u32x4){X##pa.x, X##pa.y, X##pb.x, X##pb.y}, bs0, U); \
            U = mfma16((u32x4){X##pc.x, X##pc.y, X##pd.x, X##pd.y}, bs1, U); \
            u32x4 buv; buv.x = cvt_pk_bf16(U[0], U[1]); buv.y = cvt_pk_bf16(U[2], U[3]); buv.z = X##tv.x; buv.w = X##tv.y; \
            S[0] = mfma16((u32x4){X##tb0.x, X##tb0.y, X##tk0.x, X##tk0.y}, buv, S[0]) * X##g0; \
            S[1] = mfma16((u32x4){X##tb1.x, X##tb1.y, X##tk1.x, X##tk1.y}, buv, S[1]) * X##g1; \
            S[2] = mfma16((u32x4){X##tb2.x, X##tb2.y, X##tk2.x, X##tk2.y}, buv, S[2]) * X##g2; \
            S[3] = mfma16((u32x4){X##tb3.x, X##tb3.y, X##tk3.x, X##tk3.y}, buv, S[3]) * X##g3; \
            if (ch_ >= TCX / 16) { \
                const u32x2 X##ra = *(const LAS u32x2*)(X##bptr + SET_R + rowb), X##rb = *(const LAS u32x2*)(X##bptr + SET_R + rowb + 32), X##rc = *(const LAS u32x2*)(X##bptr + SET_R + rowb + 64), X##rd = *(const LAS u32x2*)(X##bptr + SET_R + rowb + 96); \
                const u32x2 X##mrb = *(const LAS u32x2*)(X##bptr + tlmb + 32), X##mrk = *(const LAS u32x2*)(X##bptr + tlmb + 64); \
                f32x4 Yv = mfma16((u32x4){X##ra.x, X##ra.y, X##rb.x, X##rb.y}, bs0, z4); \
                Yv = mfma16((u32x4){X##rc.x, X##rc.y, X##rd.x, X##rd.y}, bs1, Yv); \
                Yv = mfma16((u32x4){X##mrb.x, X##mrb.y, X##mrk.x, X##mrk.y}, buv, Yv); \
                const unsigned yo_ = (unsigned)(ybase + (16 * (ch_ - TCX / 16) + 4 * q) * ysign);        \
                _Pragma("unroll") for (int r = 0; r < 4; ++r) *(bf16_t*)((unsigned char*)Yout + (yo_ + (unsigned)(r * ysign))) = (bf16_t)(cvt_pk_bf16(Yv[r], 0.f) & 0xffffu); } } while (0)
            volatile LAS int* flg = (volatile LAS int*)(lds + FLG_OFF);
            const int ysign = dir ? -2 * D : 2 * D, ybase = 2 * ((b * T + (dir ? T - 1 : 0)) * D + h * 64 + 16 * wave + rho);
            __syncthreads();
            for (int n = 1; n <= NR; ++n) {
                LAS unsigned char* sbase = lds + (((n - 1) & 1) * 4) * SET_BYTES;
                const int ch0 = 4 * (n - 1);
                scan_produce_tail(sbase + wave * SET_BYTES, lds + SCR_OFF + (((n - 1) & 1) * 4 + wave) * 2304, rho, q);
                asm volatile("s_waitcnt lgkmcnt(0)" ::: "memory");
                if (lane == 0) flg[wave] = n;
                asm volatile("s_waitcnt lgkmcnt(0)" ::: "memory");
#define C_WAIT(c) do { while (flg[(c)] < n) __builtin_amdgcn_s_sleep(1); asm volatile("" ::: "memory"); } while (0)
#pragma unroll 1
                for (int cc = 0; cc < 4; ++cc) { C_WAIT(cc); { C_LOAD(a_, sbase + cc * SET_BYTES) C_COMPUTE(a_, ch0 + cc); } }
                __syncthreads();
            }
#undef C_WAIT
#undef C_LOAD
#undef C_COMPUTE
#undef TRRD
        }
    }
}

__device__ __forceinline__ void phase_readout(const Args& a, int gw, int NGW, int lane) {
    unsigned char* ws = a.ws;
    const bf16_t* YF = (const bf16_t*)(ws + WS_YF); const bf16_t* YB = (const bf16_t*)(ws + WS_YB); const bf16_t* VB = (const bf16_t*)(ws + WS_V); const bf16_t* GATE = (const bf16_t*)(ws + WS_GATE);
    const float* BONUS = (const float*)(ws + WS_BONUS); const float* BONUS1 = (const float*)(ws + WS_BONUS1); bf16_t* OG = (bf16_t*)(ws + WS_OG);
    float lw[16], lb[16];
#pragma unroll
    for (int e = 0; e < 16; e += 4) { const f32x4 w4 = ld4(a.in[20] + 16 * lane + e), b4 = ld4(a.in[21] + 16 * lane + e);
#pragma unroll
        for (int i = 0; i < 4; ++i) { lw[e + i] = w4[i]; lb[e + i] = b4[i]; } }
    u32x4 pyf[2], pyb[2], pv[2], pg[2]; float pbon = 0.f;
#define RO_LOAD(rowv) do { const int row_ = (rowv); const size_t off_ = (size_t)row_ * D + 16 * lane; \
        const size_t vo_ = ((size_t)(hm_row(row_) + (lane >> 2) * NPOS)) * 64 + 16 * (lane & 3); \
        pyf[0] = *(const u32x4*)(YF + off_); pyf[1] = *(const u32x4*)(YF + off_ + 8); pyb[0] = *(const u32x4*)(YB + off_); pyb[1] = *(const u32x4*)(YB + off_ + 8); \
        pv[0] = *(const u32x4*)(VB + vo_); pv[1] = *(const u32x4*)(VB + vo_ + 8); pg[0] = *(const u32x4*)(GATE + off_); pg[1] = *(const u32x4*)(GATE + off_ + 8); \
        pbon = BONUS[(size_t)row_ * NH + (lane >> 2)] + BONUS1[(size_t)row_ * NH + (lane >> 2)]; } while (0)
    if (gw < M) RO_LOAD(gw);
    for (int row = gw; row < M; row += NGW) {
        const size_t off = (size_t)row * D + 16 * lane;
        float y[16], t8[8], vv[16], gg[16], o[16];
        unpack8(pyf[0], y); unpack8(pyf[1], y + 8);
        unpack8(pyb[0], t8);
#pragma unroll
        for (int e = 0; e < 8; ++e) y[e] += t8[e];
        unpack8(pyb[1], t8);
#pragma unroll
        for (int e = 0; e < 8; ++e) y[8 + e] += t8[e];
        unpack8(pv[0], vv); unpack8(pv[1], vv + 8); unpack8(pg[0], gg); unpack8(pg[1], gg + 8);
        const float bon = pbon;
        if (row + NGW < M) RO_LOAD(row + NGW);
        float sm = 0.f;
#pragma unroll
        for (int e = 0; e < 16; ++e) sm += y[e];
        sm += __shfl_xor(sm, 1); sm += __shfl_xor(sm, 2);
        const float mean = sm * (1.0f / 64.0f);
        float vr = 0.f;
#pragma unroll
        for (int e = 0; e < 16; ++e) { y[e] -= mean; vr += y[e] * y[e]; }
        vr += __shfl_xor(vr, 1); vr += __shfl_xor(vr, 2);
        const float rs = rsqrtf(vr * (1.0f / 64.0f) + GN_EPS);
#pragma unroll
        for (int e = 0; e < 16; ++e) o[e] = (y[e] * rs * lw[e] + lb[e] + bon * vv[e]) * gg[e];
        *(u32x4*)(OG + off) = pack8(o); *(u32x4*)(OG + off + 8) = pack8(o + 8);
    }
#undef RO_LOAD
}

template <int MODE>
__device__ __forceinline__ void phase_rowpass(const Args& a, LAS unsigned char* lds, int tid, int lane, int wave, int G) {
    unsigned char* ws = a.ws;
    const float* mods = (const float*)(ws + WS_MODS);
    const float* ng = a.in[6];
    const bf16_t* Y0 = (const bf16_t*)(ws + WS_Y0); bf16_t* XR = (bf16_t*)(ws + WS_XR); bf16_t* HB = (bf16_t*)(ws + WS_HB);
    const bf16_t* YS = (const bf16_t*)(ws + WS_YS);
    const int lpost = MODE < 2 ? 0 : 1, gtoff = (MODE == 0 || MODE == 2) ? 2048 : 5120, gpost = (MODE == 0 || MODE == 2) ? 1 : 3;
    const int lpre = MODE == 0 ? 0 : 1, gpre = MODE == 0 ? 2 : (MODE == 1 ? 0 : 2), shoff = MODE == 1 ? 0 : 3072, scoff = MODE == 1 ? 1024 : 4096;
    LAS int* lcnt = (LAS int*)lds;
    LAS int* linfo = (LAS int*)(lds + 256);
    LAS float* lwr = (LAS float*)(lds + 4096);
    int* CNT = (int*)(ws + WS_CTL);
    if (MODE == 2) {
        if (tid < 16) lcnt[tid] = 0;
        for (int i = tid; i < D * NE / 4; i += NTHREADS) *(LAS f32x4*)(lwr + 4 * i) = ld4(a.in[28] + 4 * i);
        __syncthreads();
    }
    const int rpb = (M + G - 1) / G;
    const int r0 = blockIdx.x * rpb, r1 = (r0 + rpb) < M ? (r0 + rpb) : M;
    const int nrw = (r1 - r0 - wave + NWAVES - 1) / NWAVES;
    const int bt = r0 / T;
    const float* mdp = mods + (size_t)(lpost * 9 + bt) * 6144;
    const float* mdn = mods + (size_t)(lpre * 9 + bt) * 6144;
    f32x4 cgt[4], cgp[4], cgn[4], csh[4];
#pragma unroll
    for (int j = 0; j < 4; ++j) { const int c = 4 * lane + 256 * j;
        cgt[j] = ld4(mdp + gtoff + c) * ld4(ng + (lpost * 4 + gpost) * D + c);
        if (MODE != 3) { cgn[j] = ld4(ng + (lpre * 4 + gpre) * D + c) * (1.0f + ld4(mdn + scoff + c)); csh[j] = ld4(mdn + shoff + c); } }
    int sl1 = 0, sl2 = 0; float gg1 = 0.f, gg2 = 0.f;
    if (MODE == 3) {
        int pst[NE]; int acc = 0;
#pragma unroll
        for (int e = 0; e < NE; ++e) { pst[e] = acc; acc += (CNT[e] + 255) & ~255; }
        if (lane < nrw) { const int row = r0 + wave + NWAVES * lane;
            const int* TP = (const int*)(ws + WS_TPOS); const int* TE = (const int*)(ws + WS_TOPE); const float* TG = (const float*)(ws + WS_TOPG);
            const int e1 = TE[2 * row], e2 = TE[2 * row + 1]; sl1 = TP[2 * row]; sl2 = TP[2 * row + 1];
#pragma unroll
            for (int e = 0; e < NE; ++e) { if (e == e1) sl1 += pst[e]; if (e == e2) sl2 += pst[e]; }
            gg1 = TG[2 * row]; gg2 = TG[2 * row + 1]; }
    }
    u32x2 pf[4], pf2[4], pxb[4]; f32x4 pxf[4];
#define RP_LOAD(k) do { const int row_ = r0 + wave + NWAVES * (k); \
        if (MODE == 3) { const int s1_ = __builtin_amdgcn_readlane(sl1, (k)), s2_ = __builtin_amdgcn_readlane(sl2, (k)); \
            _Pragma("unroll") for (int j = 0; j < 4; ++j) { pf[j] = *(const u32x2*)(YS + (size_t)s1_ * D + 4 * lane + 256 * j); pf2[j] = *(const u32x2*)(YS + (size_t)s2_ * D + 4 * lane + 256 * j); } } \
        else { _Pragma("unroll") for (int j = 0; j < 4; ++j) pf[j] = *(const u32x2*)(Y0 + (size_t)row_ * D + 4 * lane + 256 * j); } \
        if (MODE == 0) { _Pragma("unroll") for (int j = 0; j < 4; ++j) pxf[j] = ld4(a.in[0] + (size_t)row_ * D + 4 * lane + 256 * j); } \
        else { _Pragma("unroll") for (int j = 0; j < 4; ++j) pxb[j] = *(const u32x2*)(XR + (size_t)row_ * D + 4 * lane + 256 * j); } } while (0)
    if (nrw > 0) RP_LOAD(0);
    for (int k = 0; k < nrw; ++k) {
        const int row = r0 + wave + NWAVES * k;
        f32x4 f[4], xr[4];
#pragma unroll
        for (int j = 0; j < 4; ++j) { float y1[4]; unpack4(pf[j], y1);
            if (MODE == 3) { float y2[4]; unpack4(pf2[j], y2);
                const float g1 = __builtin_bit_cast(float, __builtin_amdgcn_readlane(__builtin_bit_cast(int, gg1), k)), g2 = __builtin_bit_cast(float, __builtin_amdgcn_readlane(__builtin_bit_cast(int, gg2), k));
                f[j] = (f32x4){g1 * y1[0] + g2 * y2[0], g1 * y1[1] + g2 * y2[1], g1 * y1[2] + g2 * y2[2], g1 * y1[3] + g2 * y2[3]}; }
            else f[j] = (f32x4){y1[0], y1[1], y1[2], y1[3]};
            if (MODE == 0) xr[j] = pxf[j]; else { float x1[4]; unpack4(pxb[j], x1); xr[j] = (f32x4){x1[0], x1[1], x1[2], x1[3]}; } }
        if (k + 1 < nrw) RP_LOAD(k + 1);
        float ss = 0.f;
#pragma unroll
        for (int j = 0; j < 4; ++j) ss += f[j][0] * f[j][0] + f[j][1] * f[j][1] + f[j][2] * f[j][2] + f[j][3] * f[j][3];
        ss = wave_sum(ss);
        const float rs = rsqrtf(ss * (1.0f / D) + NORM_EPS);
        float ss2 = 0.f;
#pragma unroll
        for (int j = 0; j < 4; ++j) {
            xr[j] = xr[j] + cgt[j] * (f[j] * rs);
            ss2 += xr[j][0] * xr[j][0] + xr[j][1] * xr[j][1] + xr[j][2] * xr[j][2] + xr[j][3] * xr[j][3]; }
        if (MODE == 3) {
#pragma unroll
            for (int j = 0; j < 4; ++j) *(f32x4*)(a.out + (size_t)row * D + 4 * lane + 256 * j) = xr[j];
            continue;
        }
#pragma unroll
        for (int j = 0; j < 4; ++j) { u32x2 w; w.x = cvt_pk_bf16_asm(xr[j][0], xr[j][1]); w.y = cvt_pk_bf16_asm(xr[j][2], xr[j][3]); *(u32x2*)(XR + (size_t)row * D + 4 * lane + 256 * j) = w; }
        ss2 = wave_sum(ss2);
        const float rs2 = rsqrtf(ss2 * (1.0f / D) + NORM_EPS);
        float lg[NE];
#pragma unroll
        for (int e = 0; e < NE; ++e) lg[e] = 0.f;
#pragma unroll
        for (int j = 0; j < 4; ++j) { const int c = 4 * lane + 256 * j;
            const f32x4 hv = xr[j] * rs2 * cgn[j] + csh[j];
            if (MODE == 1) { u32x2 w; w.x = cvt_pk_bf16_asm(hv[0], hv[1]); w.y = cvt_pk_bf16_asm(hv[2], hv[3]); *(u32x2*)(HB + (size_t)row * D + c) = w; }
            else { int w = __builtin_amdgcn_cvt_pk_fp8_f32(hv[0], hv[1], 0, false); w = __builtin_amdgcn_cvt_pk_fp8_f32(hv[2], hv[3], w, true);
                if (MODE == 0) *(int*)((unsigned char*)HB + (size_t)row * D + c) = w; else *(LAS int*)(lds + 40960 + (row - r0) * D + c) = w; }
            if (MODE == 2) {
                const LAS float* wr = lwr + (size_t)c * NE;
#pragma unroll
                for (int i = 0; i < 4; ++i) { const f32x4 wa = *(const LAS f32x4*)(wr + i * NE), wb = *(const LAS f32x4*)(wr + i * NE + 4);
                    lg[0] += hv[i] * wa[0]; lg[1] += hv[i] * wa[1]; lg[2] += hv[i] * wa[2]; lg[3] += hv[i] * wa[3];
                    lg[4] += hv[i] * wb[0]; lg[5] += hv[i] * wb[1]; lg[6] += hv[i] * wb[2]; lg[7] += hv[i] * wb[3]; }
            }
        }
        if (MODE == 2) {
#pragma unroll
            for (int e = 0; e < NE; ++e) lg[e] = wave_sum(lg[e]);
            if (lane == 0) {
                int e1 = 0; float v1 = lg[0];
#pragma unroll
                for (int e = 1; e < NE; ++e) if (lg[e] > v1) { v1 = lg[e]; e1 = e; }
                int e2 = -1; float v2 = -3.0e38f;
#pragma unroll
                for (int e = 0; e < NE; ++e) if (e != e1 && lg[e] > v2) { v2 = lg[e]; e2 = e; }
                const float g1 = 1.0f / (1.0f + __expf(v2 - v1));
                ((int*)(ws + WS_TOPE))[2 * row] = e1; ((int*)(ws + WS_TOPE))[2 * row + 1] = e2;
                ((float*)(ws + WS_TOPG))[2 * row] = g1; ((float*)(ws + WS_TOPG))[2 * row + 1] = 1.0f - g1;
                const int p1 = atomicAdd((int*)(lcnt + e1), 1), p2 = atomicAdd((int*)(lcnt + e2), 1);
                const int lr = row - r0;
                linfo[4 * lr] = e1; linfo[4 * lr + 1] = e2; linfo[4 * lr + 2] = p1; linfo[4 * lr + 3] = p2;
            }
        }
    }
#undef RP_LOAD
    if (MODE == 2) {
        __syncthreads();
        if (tid < NE) lcnt[8 + tid] = atomicAdd(CNT + tid, lcnt[tid]);
        __syncthreads();
        int* TP = (int*)(ws + WS_TPOS);
        for (int lr = tid; lr < r1 - r0; lr += NTHREADS) {
            const int e1 = linfo[4 * lr], e2 = linfo[4 * lr + 1];
            TP[2 * (r0 + lr)] = lcnt[8 + e1] + linfo[4 * lr + 2]; TP[2 * (r0 + lr) + 1] = lcnt[8 + e2] + linfo[4 * lr + 3];
        }
        unsigned char* XS = ws + WS_XS;
        for (int pr = wave; pr < 2 * (r1 - r0); pr += NWAVES) { const int lr = pr >> 1, k = pr & 1;
            const int e = linfo[4 * lr + k], pos = lcnt[8 + e] + linfo[4 * lr + 2 + k];
            *(u32x4*)(XS + ((size_t)e * M + pos) * D + 16 * lane) = *(const LAS u32x4*)(lds + 40960 + lr * D + 16 * lane); }
    }
}

__device__ __forceinline__ void phase_conv(const Args& a, int tid, int G) {
    unsigned char* ws = a.ws;
    const bf16_t* BG = (const bf16_t*)(ws + WS_BG); const bf16_t* Z = (const bf16_t*)(ws + WS_Z); bf16_t* CV = (bf16_t*)(ws + WS_CV);
    const float* cw = a.in[24];
    const int gt = blockIdx.x * NTHREADS + tid, NGT = G * NTHREADS;
    const int c = (gt & 127) * 8;
    float w0[8], w1[8], w2[8];
#pragma unroll
    for (int e = 0; e < 8; ++e) { w0[e] = cw[c + e]; w1[e] = cw[D + c + e]; w2[e] = cw[2 * D + c + e]; }
    u32x4 pz, pp, pn, pb;
#define CV_LOAD(idxv) do { const int row_ = (idxv) >> 7, t_ = row_ % T; \
        pz = *(const u32x4*)(Z + (size_t)row_ * D + c); pb = *(const u32x4*)(BG + (size_t)row_ * D + c); \
        pp = *(const u32x4*)(Z + (size_t)(row_ - (t_ > 0 ? 1 : 0)) * D + c); pn = *(const u32x4*)(Z + (size_t)(row_ + (t_ < T - 1 ? 1 : 0)) * D + c); } while (0)
    if (gt < M * (D / 8)) CV_LOAD(gt);
    for (int idx = gt; idx < M * (D / 8); idx += NGT) {
        const int row = idx >> 7, t = row % T;
        float zc[8], zp[8], zn[8], bg[8], o[8];
        unpack8(pz, zc); unpack8(pb, bg); unpack8(pp, zp); unpack8(pn, zn);
        if (idx + NGT < M * (D / 8)) CV_LOAD(idx + NGT);
        const float mp = t > 0 ? 1.f : 0.f, mn = t < T - 1 ? 1.f : 0.f;
#pragma unroll
        for (int e = 0; e < 8; ++e) o[e] = bg[e] * (zp[e] * (w0[e] * mp) + zc[e] * w1[e] + zn[e] * (w2[e] * mn));
        *(u32x4*)(CV + (size_t)row * D + c) = pack8(o);
    }
#undef CV_LOAD
}

__device__ __forceinline__ void phase_gather(const Args& a, int gw, int NGW, int lane) {
    unsigned char* ws = a.ws;
    const int* CNT = (const int*)(ws + WS_CTL); const int* TE = (const int*)(ws + WS_TOPE); const int* TP = (const int*)(ws + WS_TPOS);
    const bf16_t* HB = (const bf16_t*)(ws + WS_HB); bf16_t* XS = (bf16_t*)(ws + WS_XS);
    int pst[NE]; { int acc = 0;
#pragma unroll
        for (int e = 0; e < NE; ++e) { pst[e] = acc; acc += (CNT[e] + 255) & ~255; } }
    for (int pr = gw; pr < 2 * M; pr += NGW) {
        const int e = TE[pr]; int slot = TP[pr];
#pragma unroll
        for (int q = 0; q < NE; ++q) if (q == e) slot += pst[q];
        const u32x4* src = (const u32x4*)((const unsigned char*)HB + (size_t)(pr >> 1) * D); u32x4* dst = (u32x4*)((unsigned char*)XS + (size_t)slot * D);
        dst[lane] = src[lane];
    }
}

#define XB_TMO      128
#define XB_XCNT(j)  (256  + 64 * (j))
#define XB_XSUB(j)  (1280 + 64 * (j))
#define XB_XGEN(j)  (2304 + 64 * (j))
#define XB_TOP      3328
#define XB_TOPGEN   3392
#define XCD_BAR_WORDS 3456
#define XB_SPIN_CAP (1u << 20)
__device__ __forceinline__ unsigned xb_ld(unsigned* p)              { return __hip_atomic_load(p, __ATOMIC_RELAXED, __HIP_MEMORY_SCOPE_AGENT); }
__device__ __forceinline__ unsigned xb_add(unsigned* p, unsigned v) { return __hip_atomic_fetch_add(p, v, __ATOMIC_RELAXED, __HIP_MEMORY_SCOPE_AGENT); }
__device__ __forceinline__ unsigned xb_xcc_id() { return (unsigned)__builtin_amdgcn_s_getreg((3 << 11) | 20) & 0xFu; }
#define XB_SPIN(cond, bar) do { unsigned _sp = 0; while (cond) { __builtin_amdgcn_s_sleep(1); \
    if ((++_sp & 255u) == 0u) { if (xb_ld(&(bar)[XB_TMO])) break; if (_sp > XB_SPIN_CAP) { atomicAdd(&(bar)[XB_TMO], 1u); break; } } } } while (0)
struct XcdBarrier { unsigned* bar; unsigned x, rank; volatile LAS unsigned* st; };
__device__ __forceinline__ void xb_st(unsigned* p, unsigned v) { __hip_atomic_store(p, v, __ATOMIC_RELAXED, __HIP_MEMORY_SCOPE_AGENT); }
__device__ __forceinline__ XcdBarrier xcd_barrier_post(unsigned* bar, volatile LAS unsigned* st) {
    XcdBarrier b; b.bar = bar; b.x = xb_xcc_id(); b.st = st; b.rank = 0u;
    if (threadIdx.x == 0) b.rank = xb_add(&bar[XB_XCNT(b.x)], 1u);
    b.rank = (unsigned)__builtin_amdgcn_readfirstlane((int)b.rank);
    return b;
}
__device__ __forceinline__ void xcd_barrier_complete(unsigned* bar, unsigned x, unsigned& nloc, unsigned& mask) {
    const unsigned G = gridDim.x * gridDim.y * gridDim.z;
    unsigned sum, mk, mine, sp = 0u;
    for (;;) {
        sum = 0u; mk = 0u; mine = 0u;
#pragma unroll
        for (unsigned j = 0; j < 16; ++j) { const unsigned c = xb_ld(&bar[XB_XCNT(j)]); sum += c; mk |= (c > 0u) ? (1u << j) : 0u; mine = (j == x) ? c : mine; }
        if (sum == G) break;
        __builtin_amdgcn_s_sleep(1);
        if ((++sp & 255u) == 0u) { if (xb_ld(&bar[XB_TMO])) break; if (sp > XB_SPIN_CAP) { atomicAdd(&bar[XB_TMO], 1u); break; } }
    }
    nloc = mine > 0u ? mine : 1u; mask = mk;
}
__device__ __forceinline__ void xcd_barrier(const XcdBarrier& b) {
    asm volatile("s_waitcnt vmcnt(0)" ::: "memory");
    __syncthreads();
    if (threadIdx.x < 64) {
        const unsigned lane = threadIdx.x;
        unsigned* bar = b.bar;
        if (b.st[0] == 0u) { if (lane == 0) { unsigned nl, mk; xcd_barrier_complete(bar, b.x, nl, mk); b.st[0] = nl; b.st[1] = mk; } }
        const unsigned nloc = b.st[0], mask = b.st[1], gen = b.st[2] + 1u;
        if (lane == 0) b.st[2] = gen;
        if (b.rank != 0u) { if (lane == 0) xb_st(&bar[XB_XSUB(b.x) + b.rank], gen); }
        else {
            for (unsigned base = 0; base < nloc; base += 64u) {
                const unsigned r = base + lane; unsigned sp = 0u;
                for (;;) {
                    const unsigned v = (r > 0u && r < nloc) ? xb_ld(&bar[XB_XSUB(b.x) + r]) : gen;
                    if (__builtin_amdgcn_ballot_w64((int)(v - gen) < 0) == 0ull) break;
                    __builtin_amdgcn_s_sleep(1);
                    if ((++sp & 255u) == 0u) { if (xb_ld(&bar[XB_TMO])) break; if (sp > XB_SPIN_CAP) { if (lane == 0) atomicAdd(&bar[XB_TMO], 1u); break; } }
                }
            }
            __builtin_amdgcn_fence(__ATOMIC_RELEASE, "agent");
            asm volatile("s_waitcnt vmcnt(0)" ::: "memory");
            if (lane == 0) xb_st(&bar[XB_TOP + b.x], gen);
        }
        { unsigned sp = 0u;
          for (;;) {
              const unsigned v = (lane < 16u && ((mask >> lane) & 1u)) ? xb_ld(&bar[XB_TOP + lane]) : gen;
              if (__builtin_amdgcn_ballot_w64((int)(v - gen) < 0) == 0ull) break;
              __builtin_amdgcn_s_sleep(1);
              if ((++sp & 255u) == 0u) { if (xb_ld(&bar[XB_TMO])) break; if (sp > XB_SPIN_CAP) { if (lane == 0) atomicAdd(&bar[XB_TMO], 1u); break; } }
          } }
        __builtin_amdgcn_fence(__ATOMIC_ACQUIRE, "agent");
        asm volatile("s_waitcnt vmcnt(0)" ::: "memory");
    }
    __syncthreads();
}

__global__ void __launch_bounds__(NTHREADS, 2) mk_fwd(Args args) {
    extern __shared__ __attribute__((aligned(16))) unsigned char lds_raw[];
    LAS unsigned char* lds = (LAS unsigned char*)lds_raw;
    LAS int* ctl = (LAS int*)(lds + CTL_OFF);
    const int tid = threadIdx.x, lane = tid & 63, wave = __builtin_amdgcn_readfirstlane(tid >> 6);
    const int G = gridDim.x;
    const int gw = blockIdx.x * NWAVES + wave, NGW = G * NWAVES;
    unsigned char* ws = args.ws;
    const int lo = args.ph_lo, hi = args.ph_hi;
    if (tid < 16) ((LAS unsigned*)(lds + CTL_OFF + 4096))[tid] = 0u;
    __syncthreads();
    XcdBarrier xbar; xbar.bar = (unsigned*)(ws + WS_CTL + 4096); xbar.x = 0; xbar.st = (volatile LAS unsigned*)(lds + CTL_OFF + 4096);
    if (blockIdx.x == 0) { for (int i = tid; i < XCD_BAR_WORDS; i += NTHREADS) ((unsigned*)(ws + WS_CTL + 4096))[i] = 0u; }
#ifndef PH_MASK
#define PH_MASK 0x7ffff
#endif
#define PH_ON(k) ((PH_MASK >> (k)) & 1)
#define IN(k) (PH_ON(k) && lo <= (k) && (k) < hi)
#ifndef REP_MASK
#define REP_MASK 0
#endif
#define PHASE(k, ...) if (IN(k)) { __VA_ARGS__ if ((REP_MASK >> (k)) & 1) { __syncthreads(); __VA_ARGS__ } }
#ifndef XB_REP
#define XB_REP 1
#endif
#ifndef CG_SEAM_MASK
#define CG_SEAM_MASK 0x1
#endif
#define SEAM(k) do { if (lo <= (k) && (k) + 1 < hi) { if ((CG_SEAM_MASK >> (k)) & 1) cg::this_grid().sync(); else { for (int _s = 0; _s < XB_REP; ++_s) xcd_barrier(xbar); } } } while (0)
#define RUN_GEMM(KK, LDA, LDB) do { __syncthreads(); pg8::gemm_phase<false>(lds, ctl, (KK), (LDA), (LDB), G, (int)blockIdx.x); } while (0)
#define RUN_GEMM8(KK, LDA, LDB, SW, SA) do { __syncthreads(); pg8::gemm_phase<true>(lds, ctl, (KK) / 2, (LDA) / 2, (LDB) / 2, G, (int)blockIdx.x, (SW), (SA)); } while (0)
    PHASE(0,  phase0(args, lds, tid, lane, wave, G); ) SEAM(0);
    xbar = xcd_barrier_post((unsigned*)(ws + WS_CTL + 4096), (volatile LAS unsigned*)(lds + CTL_OFF + 4096));
    PHASE(1,  phase_mix(args, gw, NGW, lane); ) SEAM(1);
    PHASE(2,
        if (tid == 0) {
            const bf16_t* XN = (const bf16_t*)(ws + WS_XN);
            pg8::set_job(ctl, 0, XN + (size_t)0 * MT * D, ws + WS_WR, ws + WS_R, M / 256, 4, pg8::EPI_BF16_HM, D, 0);
            pg8::set_job(ctl, 1, XN + (size_t)2 * MT * D, ws + WS_WK, ws + WS_KRAW, MT / 256, 4, pg8::EPI_BF16_HM, D, 0);
            pg8::set_job(ctl, 2, XN + (size_t)3 * MT * D, ws + WS_WV, ws + WS_V, MT / 256, 4, pg8::EPI_BF16_HM, D, 0);
            pg8::set_job(ctl, 3, XN + (size_t)5 * MT * D, ws + WS_WG1, ws + WS_L1G, M / 256, 1, pg8::EPI_BF16, 256, 2);
        }
        RUN_GEMM(D, D, D);
        __syncthreads();
        if (tid == 0) { const bf16_t* XN = (const bf16_t*)(ws + WS_XN); ctl[0] = 0; ctl[1] = 0;
            pg8::set_job(ctl, 0, XN + (size_t)1 * MT * D, ws + WS_WW1, ws + WS_L1W, MT / 256, 1, pg8::EPI_BF16, 256, 1);
            pg8::set_job(ctl, 1, XN + (size_t)4 * MT * D, ws + WS_WA1, ws + WS_L1A, MT / 256, 1, pg8::EPI_BF16, 256, 0); }
        __syncthreads();
        if ((int)blockIdx.x >= G / 2) pg8::gemm_phase<true>(lds, ctl, D / 2, D / 2, D / 2, G - G / 2, (int)blockIdx.x - G / 2, 127 - 5, 127);
    ) SEAM(2);
    PHASE(4,  phase_scan_chunked(args, lds, tid, lane, wave, G); ) SEAM(4);
    PHASE(5,  phase_readout(args, gw, NGW, lane); ) SEAM(5);
    PHASE(6,  if (tid == 0) pg8::set_job(ctl, 0, ws + WS_OG, ws + WS_WOUT, ws + WS_Y0, M / 256, 4, pg8::EPI_BF16, D, 0); RUN_GEMM(D, D, D); ) SEAM(6);
    PHASE(7,  phase_rowpass<0>(args, lds, tid, lane, wave, G); ) SEAM(7);
    PHASE(8,  if (tid == 0) pg8::set_job(ctl, 0, ws + WS_HB, ws + WS_WGU, ws + WS_ACT, M / 256, 2 * FF / 256, pg8::EPI_SWIGLU8, FF, 0); RUN_GEMM8(D, D, D, 127 - 5, 127); ) SEAM(8);
    PHASE(9,  if (tid == 0) pg8::set_job(ctl, 0, ws + WS_ACT, ws + WS_WDN, ws + WS_Y0, M / 256, 4, pg8::EPI_BF16, D, 0); RUN_GEMM8(FF, FF, FF, 127 - 6, 127 - 2); ) SEAM(9);
    PHASE(10,  phase_rowpass<1>(args, lds, tid, lane, wave, G); ) SEAM(10);
    PHASE(11,
        if (tid == 0) {
            pg8::set_job(ctl, 0, ws + WS_HB, ws + WS_WCI, ws + WS_BG, M / 256, 4, pg8::EPI_BF16, D, 0);
            pg8::set_job(ctl, 1, ws + WS_HB, ws + WS_WCI + (size_t)D * D * 2, ws + WS_Z, M / 256, 8, pg8::EPI_MUL, D, 0);
        }
        RUN_GEMM(D, D, D);
    ) SEAM(11);
    PHASE(12,  phase_conv(args, tid, G); ) SEAM(12);
    PHASE(13,  if (tid == 0) pg8::set_job(ctl, 0, ws + WS_CV, ws + WS_WCO, ws + WS_Y0, M / 256, 4, pg8::EPI_BF16, D, 0); RUN_GEMM(D, D, D); ) SEAM(13);
    PHASE(14,  phase_rowpass<2>(args, lds, tid, lane, wave, G); ) SEAM(14);
    PHASE(16,
        if (tid == 0) { const int* CNT = (const int*)(ws + WS_CTL); int ps = 0, j = 0; ctl[0] = 0; ctl[1] = 0;
            for (int e = 0; e < NE; ++e) { const int nM = (CNT[e] + 255) >> 8;
                if (nM > 0) { pg8::set_job(ctl, j, ws + WS_XS + (size_t)e * M * D, ws + WS_MGU + (size_t)e * 2 * FF * D, ws + WS_MACT + (size_t)ps * FF, nM, 2 * FF / 256, pg8::EPI_SWIGLU8, FF, 0); ++j; }
                ps += nM * 256; } }
        RUN_GEMM8(D, D, D, 127 - 5, 127);
    ) SEAM(16);
    PHASE(17,
        if (tid == 0) { const int* CNT = (const int*)(ws + WS_CTL); int ps = 0, j = 0; ctl[0] = 0; ctl[1] = 0;
            for (int e = 0; e < NE; ++e) { const int nM = (CNT[e] + 255) >> 8;
                if (nM > 0) { pg8::set_job(ctl, j, ws + WS_MACT + (size_t)ps * FF, ws + WS_MDN + (size_t)e * D * FF, ws + WS_YS + (size_t)ps * D * 2, nM, 4, pg8::EPI_BF16, D, 0); ++j; }
                ps += nM * 256; } }
        RUN_GEMM8(FF, FF, FF, 127 - 6, 127 - 2);
    ) SEAM(17);
    PHASE(18,  phase_rowpass<3>(args, lds, tid, lane, wave, G); )
}

extern "C" void kernel_launch(void* const* d_in, const int* in_sizes, int n_in, void* d_out, int out_size, void* d_ws, size_t ws_size, hipStream_t stream) {
    static int grid = 0;
    if (grid == 0) {
        int dev = 0, cus = 0, per_cu = 0;
        if (n_in != 31 || ws_size < WS_END) { fprintf(stderr, "kernel_launch: unexpected n_in %d or ws_size %zu (< %zu)\n", n_in, ws_size, (size_t)WS_END); grid = -1; return; }
        hipGetDevice(&dev);
        hipDeviceGetAttribute(&cus, hipDeviceAttributeMultiprocessorCount, dev);
        if (hipFuncSetAttribute((const void*)mk_fwd, hipFuncAttributeMaxDynamicSharedMemorySize, LDS_BYTES) != hipSuccess) { fprintf(stderr, "kernel_launch: hipFuncSetAttribute failed\n"); grid = -1; return; }
        if (hipOccupancyMaxActiveBlocksPerMultiprocessor(&per_cu, (const void*)mk_fwd, NTHREADS, LDS_BYTES) != hipSuccess || per_cu < 1) { fprintf(stderr, "kernel_launch: occupancy query says %d\n", per_cu); per_cu = 1; }
        (void)hipGetLastError();
        grid = cus;
        fprintf(stderr, "kernel_launch: cus %d per_cu %d grid %d ws %zu\n", cus, per_cu, grid, ws_size);
    }
    if (grid < 0) return;
    Args a{};
    for (int i = 0; i < 31; ++i) a.in[i] = (const float*)d_in[i];
    a.out = (float*)d_out; a.ws = (unsigned char*)d_ws;
#if MK_ONE_LAUNCH
    a.ph_lo = 0; a.ph_hi = NPH;
    void* kargs[] = {&a};
    hipError_t e = hipLaunchCooperativeKernel((const void*)mk_fwd, dim3(grid), dim3(NTHREADS), kargs, LDS_BYTES, stream);
    if (e != hipSuccess) fprintf(stderr, "cooperative launch failed: %s (grid %d)\n", hipGetErrorString(e), grid);
#else
    for (int p = 0; p < NPH; ++p) {
        a.ph_lo = p; a.ph_hi = p + 1;
        hipLaunchKernelGGL(mk_fwd, dim3(grid), dim3(NTHREADS), LDS_BYTES, stream, a);
    }
#endif
}
```

```cpp
#include <hip/hip_runtime.h>
#include <hip/hip_cooperative_groups.h>
#include <cstdio>
#include <cstdint>
namespace cg = cooperative_groups;

#ifndef MK_ONE_LAUNCH
#define MK_ONE_LAUNCH 1
#endif

#define LAS __attribute__((address_space(3)))
typedef unsigned short bf16_t;
typedef short bf16x8 __attribute__((ext_vector_type(8)));
typedef float f32x4 __attribute__((ext_vector_type(4)));
typedef float f32x2 __attribute__((ext_vector_type(2)));
typedef unsigned u32x4 __attribute__((ext_vector_type(4)));
typedef unsigned u32x2 __attribute__((ext_vector_type(2)));
typedef int i32x8 __attribute__((ext_vector_type(8)));
typedef int i32x4 __attribute__((ext_vector_type(4)));

constexpr int D = 1024, NB = 8, T = 2048, TCX = 256, M = NB * T, MC = NB * TCX, MT = M + MC, NH = 16, HS = 64, FF = 3584, NE = 8;
constexpr float NORM_EPS = 1e-6f, GN_EPS = 64e-5f;
constexpr int NPH = 19;

constexpr size_t MiB = 1u << 20;
constexpr size_t WS_WR = 0, WS_WK = 2 * MiB, WS_WV = 4 * MiB, WS_WW1 = 6 * MiB, WS_WA1 = 6 * MiB + 512 * 1024, WS_WG1 = 7 * MiB;
constexpr size_t WS_W2W = 7 * MiB + 512 * 1024, WS_W2A = WS_W2W + 256 * 1024, WS_W2G = 8 * MiB;
constexpr size_t WS_WOUT = 9 * MiB, WS_WGU = 11 * MiB, WS_WDN = 25 * MiB, WS_WCI = 32 * MiB, WS_WCO = 38 * MiB, WS_MGU = 40 * MiB, WS_MDN = 152 * MiB;
constexpr size_t WS_MODS = 208 * MiB, WS_RSTD = 209 * MiB, WS_BONUS = 210 * MiB, WS_TOPE = 211 * MiB, WS_TOPG = WS_TOPE + 128 * 1024, WS_TPOS = WS_TOPG + 128 * 1024;
constexpr size_t WS_SLOT = 211 * MiB + 512 * 1024, WS_CTL = 212 * MiB;
constexpr size_t WS_XR = 214 * MiB, WS_HB = 278 * MiB, WS_GATE = 310 * MiB, WS_OG = 342 * MiB, WS_YF = 374 * MiB, WS_YB = 406 * MiB, WS_Y0 = 374 * MiB;
constexpr size_t WS_S2 = 438 * MiB, WS_R = WS_S2, WS_KRAW = WS_S2 + 36 * MiB, WS_V = WS_S2 + 72 * MiB, WS_L1W = WS_S2 + 108 * MiB, WS_L1A = WS_S2 + 117 * MiB, WS_L1G = WS_S2 + 126 * MiB;
constexpr size_t WS_BG = WS_S2, WS_Z = WS_S2 + 32 * MiB, WS_CV = WS_S2 + 64 * MiB, WS_XS = WS_S2, WS_YS = WS_S2;
constexpr size_t WS_S1 = 574 * MiB, WS_XN = WS_S1, WS_AT = WS_S1, WS_BT = WS_S1 + 72 * MiB, WS_KT = WS_S1 + 144 * MiB, WS_ACT = WS_S1, WS_MACT = WS_S1;
constexpr size_t WS_BONUS1 = 213 * MiB;
constexpr size_t WS_RT = WS_XR, WS_GC = WS_XR + 72 * MiB;
constexpr size_t HMA = (size_t)NB * NH * (TCX + T) * HS;
constexpr int NPOS = TCX + T, NCHK = NPOS / 16;
constexpr size_t WS_END = 812 * MiB;
constexpr size_t WS_DUMP = 209 * MiB + 512 * 1024;
constexpr size_t WS_YSP = WS_S2 + 72 * MiB;
constexpr int SPL_TILES = 2 * M / 256, SPL_ROWS = 2048, SPL_K = 7;
constexpr int MAXSLOT = 2 * M + NE * 256;

constexpr int LDS_BYTES = 163840;
constexpr int CTL_OFF = 155648;
constexpr int NTHREADS = 512, NWAVES = 8;

struct Args { const float* in[31]; float* out; unsigned char* ws; int ph_lo, ph_hi; };

__device__ __forceinline__ float bf2f(unsigned h) { return __uint_as_float(h << 16); }
typedef __bf16 bf16x2_t __attribute__((ext_vector_type(2)));
__device__ __forceinline__ unsigned cvt_pk_bf16_asm(float lo, float hi) { unsigned r; asm volatile("v_cvt_pk_bf16_f32 %0, %1, %2" : "=v"(r) : "v"(lo), "v"(hi)); return r; }
__device__ __forceinline__ unsigned cvt_pk_bf16(float lo, float hi) { const f32x2 v = {lo, hi}; return __builtin_bit_cast(unsigned, __builtin_convertvector(v, bf16x2_t)); }
__device__ __forceinline__ float sigmoidf_(float x) { return __builtin_amdgcn_rcpf(1.0f + __expf(-x)); }
__device__ __forceinline__ float siluf_(float x) { return x * sigmoidf_(x); }
__device__ __forceinline__ float tanhf_(float x) { return 2.0f * sigmoidf_(2.0f * x) - 1.0f; }
__device__ __forceinline__ float wave_sum(float v) {
#pragma unroll
    for (int o = 1; o < 64; o <<= 1) v += __shfl_xor(v, o);
    return v;
}
__device__ __forceinline__ int rfl(int v) { return __builtin_amdgcn_readfirstlane(v); }
__device__ __forceinline__ f32x4 ld4(const float* p) { return *(const f32x4*)p; }
__device__ __forceinline__ void unpack4(u32x2 w, float* o) { o[0] = bf2f(w.x & 0xffffu); o[1] = bf2f(w.x >> 16); o[2] = bf2f(w.y & 0xffffu); o[3] = bf2f(w.y >> 16); }
__device__ __forceinline__ void unpack8(u32x4 w, float* o) {
    o[0] = bf2f(w.x & 0xffffu); o[1] = bf2f(w.x >> 16); o[2] = bf2f(w.y & 0xffffu); o[3] = bf2f(w.y >> 16);
    o[4] = bf2f(w.z & 0xffffu); o[5] = bf2f(w.z >> 16); o[6] = bf2f(w.w & 0xffffu); o[7] = bf2f(w.w >> 16);
}
__device__ __forceinline__ u32x4 pack8(const float* v) { u32x4 w; w.x = cvt_pk_bf16_asm(v[0], v[1]); w.y = cvt_pk_bf16_asm(v[2], v[3]); w.z = cvt_pk_bf16_asm(v[4], v[5]); w.w = cvt_pk_bf16_asm(v[6], v[7]); return w; }
__device__ __forceinline__ u32x4 pack8v(const float* v) { u32x4 w; w.x = cvt_pk_bf16(v[0], v[1]); w.y = cvt_pk_bf16(v[2], v[3]); w.z = cvt_pk_bf16(v[4], v[5]); w.w = cvt_pk_bf16(v[6], v[7]); return w; }
template <int CTRL> __device__ __forceinline__ float dpp_mov(float v) { return __builtin_bit_cast(float, __builtin_amdgcn_update_dpp(0, __builtin_bit_cast(int, v), CTRL, 0xF, 0xF, true)); }
__device__ __forceinline__ int hm_row(int row) { return row < M ? (row >> 11) * (NH * NPOS) + TCX + (row & (T - 1)) : ((row - M) >> 8) * (NH * NPOS) + ((row - M) & (TCX - 1)); }
__device__ __forceinline__ float red8(float v) {
    v += __builtin_bit_cast(float, __builtin_amdgcn_update_dpp(0, __builtin_bit_cast(int, v), 0xB1, 0xF, 0xF, true));
    v += __builtin_bit_cast(float, __builtin_amdgcn_update_dpp(0, __builtin_bit_cast(int, v), 0x4E, 0xF, 0xF, true));
    v += __builtin_bit_cast(float, __builtin_amdgcn_update_dpp(0, __builtin_bit_cast(int, v), 0x141, 0xF, 0xF, true));
    return v;
}

namespace pg8 {
constexpr int BM = 256, BK = 64, HALF = 128, HTB = HALF * BK * 2, STAGE_BYTES = 8 * HTB, NXCD = 8, WGM = 8;
__device__ __forceinline__ int lds_byte(int r, int c) { const int st = (r >> 4) * 2 + (c >> 5), rr = r & 15, cc = c & 31, ob = rr * 64 + cc * 2; return st * 1024 + (ob ^ (((ob >> 9) & 1) << 5)); }
__device__ __forceinline__ void stage_rc(int b, int& R, int& C) { const int st = b / 1024, sb = b % 1024, swz = sb ^ (((sb >> 9) & 1) << 5); R = (st >> 1) * 16 + swz / 64; C = (st & 1) * 32 + (swz % 64) / 2; }
__device__ __forceinline__ int perm32(int rho) { const int n = rho >> 4, i = rho & 15; return 8 * (i >> 2) + 4 * n + (i & 3); }

enum { EPI_BF16 = 0, EPI_F32 = 1, EPI_SWIGLU = 2, EPI_MUL = 3, EPI_BF16_HM = 4, EPI_SWIGLU8 = 5 };
struct Unit { const char* A; const char* B; int pm, pn, job; };

__device__ __forceinline__ void set_job(LAS int* ctl, int j, const void* A, const void* B, void* O, int nM, int nN, int mode, int ldo, int act) {
    LAS int* jd = ctl + 16 + 16 * j;
    const unsigned long long a = (unsigned long long)A, b = (unsigned long long)B, o = (unsigned long long)O;
    jd[0] = (int)(unsigned)a; jd[1] = (int)(unsigned)(a >> 32); jd[2] = (int)(unsigned)b; jd[3] = (int)(unsigned)(b >> 32); jd[4] = (int)(unsigned)o; jd[5] = (int)(unsigned)(o >> 32);
    jd[6] = nM; jd[7] = nN; jd[9] = mode; jd[10] = ldo; jd[11] = act;
    const int u0 = (j == 0) ? 0 : ctl[16 + 16 * (j - 1) + 8] + ctl[16 + 16 * (j - 1) + 6] * ctl[16 + 16 * (j - 1) + 7];
    jd[8] = u0; ctl[0] = j + 1; ctl[1] = u0 + nM * nN;
}

__device__ __forceinline__ bool sched_next(LAS const int* ctl, int i, int G, int c, size_t tstepA, size_t tstepB, Unit& u) {
    const int total = rfl(ctl[1]), nj = rfl(ctl[0]);
    const long L = (long)i * G + c; if (L >= total) return false;
    int j = 0;
    for (int q = 1; q < nj; ++q) if ((int)L >= rfl(ctl[16 + 16 * q + 8])) j = q;
    LAS const int* jd = ctl + 16 + 16 * j;
    const int nM = rfl(jd[6]), nN = rfl(jd[7]); int wgid = (int)L - rfl(jd[8]);
    const int nwg = nM * nN;
    { const int q = nwg / NXCD, r = nwg % NXCD, xcd = wgid % NXCD, off = wgid / NXCD; wgid = (xcd < r ? xcd * (q + 1) : r * (q + 1) + (xcd - r) * q) + off; }
    const int nig = WGM * nN, gid = wgid / nig, fm = gid * WGM, gsz = (nM - fm) < WGM ? (nM - fm) : WGM;
    u.pm = fm + ((wgid % nig) % gsz); u.pn = (wgid % nig) / gsz; u.job = j;
    const unsigned long long a = ((unsigned long long)(unsigned)rfl(jd[1]) << 32) | (unsigned)rfl(jd[0]);
    const unsigned long long b = ((unsigned long long)(unsigned)rfl(jd[3]) << 32) | (unsigned)rfl(jd[2]);
    u.A = (const char*)a + (size_t)u.pm * tstepA; u.B = (const char*)b + (size_t)u.pn * tstepB;
    return true;
}

__device__ __forceinline__ void epilogue(const f32x4 (&acc)[2][2][4][2], LAS const int* ctl, const Unit& u, int wr, int wc, int fr, int fq) {
    LAS const int* jd = ctl + 16 + 16 * u.job;
    const int mode = rfl(jd[9]), ldo = rfl(jd[10]), act = rfl(jd[11]);
    char* O = (char*)(((unsigned long long)(unsigned)rfl(jd[5]) << 32) | (unsigned)rfl(jd[4]));
    const int row0 = u.pm * BM + wr * 64 + fr;
    if (mode == EPI_BF16) {
        bf16_t* base = (bf16_t*)O; const int col0 = u.pn * BM + wc * 32 + 8 * fq;
#pragma unroll
        for (int ai = 0; ai < 2; ++ai)
#pragma unroll
            for (int m = 0; m < 4; ++m) { bf16_t* rowp = base + (size_t)(row0 + ai * HALF + m * 16) * ldo + col0;
#pragma unroll
                for (int bj = 0; bj < 2; ++bj) { if (bj == 1 && (act & 4)) continue;
                    f32x4 v0 = acc[ai][bj][m][0], v1 = acc[ai][bj][m][1];
                    if ((act & 3) == 1) { _Pragma("unroll") for (int e = 0; e < 4; ++e) { v0[e] = tanhf_(v0[e]); v1[e] = tanhf_(v1[e]); } }
                    else if ((act & 3) == 2) { _Pragma("unroll") for (int e = 0; e < 4; ++e) { v0[e] = sigmoidf_(v0[e]); v1[e] = sigmoidf_(v1[e]); } }
                    u32x4 w; w.x = cvt_pk_bf16_asm(v0[0], v0[1]); w.y = cvt_pk_bf16_asm(v0[2], v0[3]); w.z = cvt_pk_bf16_asm(v1[0], v1[1]); w.w = cvt_pk_bf16_asm(v1[2], v1[3]);
                    *(u32x4*)(rowp + bj * HALF) = w; } }
    } else if (mode == EPI_BF16_HM) {
        bf16_t* base = (bf16_t*)O; const int col0 = u.pn * BM + wc * 32 + 8 * fq;
#pragma unroll
        for (int ai = 0; ai < 2; ++ai)
#pragma unroll
            for (int m = 0; m < 4; ++m) { const int hr = hm_row(row0 + ai * HALF + m * 16);
#pragma unroll
                for (int bj = 0; bj < 2; ++bj) { const int col = col0 + bj * HALF; const f32x4 v0 = acc[ai][bj][m][0], v1 = acc[ai][bj][m][1];
                    u32x4 w; w.x = cvt_pk_bf16_asm(v0[0], v0[1]); w.y = cvt_pk_bf16_asm(v0[2], v0[3]); w.z = cvt_pk_bf16_asm(v1[0], v1[1]); w.w = cvt_pk_bf16_asm(v1[2], v1[3]);
                    *(u32x4*)(base + ((size_t)(hr + (col >> 6) * NPOS)) * 64 + (col & 63)) = w; } }
    } else if (mode == EPI_F32) {
        float* base = (float*)O; const int col0 = u.pn * BM + wc * 32 + 8 * fq;
#pragma unroll
        for (int ai = 0; ai < 2; ++ai)
#pragma unroll
            for (int m = 0; m < 4; ++m) { float* rowp = base + (size_t)(row0 + ai * HALF + m * 16) * ldo + col0;
#pragma unroll
                for (int bj = 0; bj < 2; ++bj) { *(f32x4*)(rowp + bj * HALF) = acc[ai][bj][m][0]; *(f32x4*)(rowp + bj * HALF + 4) = acc[ai][bj][m][1]; } }
    } else if (mode == EPI_SWIGLU8) {
        unsigned char* base = (unsigned char*)O; const int colb = u.pn * HALF + wc * 16;
#pragma unroll
        for (int ai = 0; ai < 2; ++ai)
#pragma unroll
            for (int bj = 0; bj < 2; ++bj) { int w[4];
#pragma unroll
                for (int m = 0; m < 4; ++m) { const f32x4 g = acc[ai][bj][m][0], uu = acc[ai][bj][m][1]; f32x4 r;
                    _Pragma("unroll") for (int e = 0; e < 4; ++e) r[e] = siluf_(g[e]) * uu[e];
                    w[m] = __builtin_amdgcn_cvt_pk_fp8_f32(r[0], r[1], 0, false); w[m] = __builtin_amdgcn_cvt_pk_fp8_f32(r[2], r[3], w[m], true); }
                const auto s02 = __builtin_amdgcn_permlane32_swap(w[0], w[2], false, false), s13 = __builtin_amdgcn_permlane32_swap(w[1], w[3], false, false);
                const auto t01 = __builtin_amdgcn_permlane16_swap(s02[0], s13[0], false, false), t23 = __builtin_amdgcn_permlane16_swap(s02[1], s13[1], false, false);
                const u32x4 o = {(unsigned)t01[0], (unsigned)t01[1], (unsigned)t23[0], (unsigned)t23[1]};
                *(u32x4*)(base + (size_t)(u.pm * BM + wr * 64 + ai * HALF + 16 * fq + fr) * ldo + colb + bj * 64) = o; }
    } else {
        bf16_t* base = (bf16_t*)O; const int col0 = u.pn * HALF + wc * 16 + 4 * (fq & 2);
#pragma unroll
        for (int ai = 0; ai < 2; ++ai)
#pragma unroll
            for (int bj = 0; bj < 2; ++bj) { u32x2 w[4];
#pragma unroll
                for (int m = 0; m < 4; ++m) { const f32x4 g = acc[ai][bj][m][0], uu = acc[ai][bj][m][1]; f32x4 r;
                    if (mode == EPI_SWIGLU) { _Pragma("unroll") for (int e = 0; e < 4; ++e) r[e] = siluf_(g[e]) * uu[e]; } else { r = g * uu; }
                    w[m].x = cvt_pk_bf16(r[0], r[1]); w[m].y = cvt_pk_bf16(r[2], r[3]); }
#pragma unroll
                for (int mp = 0; mp < 4; mp += 2) {
                    const auto sx = __builtin_amdgcn_permlane16_swap((int)w[mp].x, (int)w[mp + 1].x, false, false), sy = __builtin_amdgcn_permlane16_swap((int)w[mp].y, (int)w[mp + 1].y, false, false);
                    const u32x4 o = {(unsigned)sx[0], (unsigned)sy[0], (unsigned)sx[1], (unsigned)sy[1]};
                    *(u32x4*)(base + (size_t)(row0 + ai * HALF + (mp + (fq & 1)) * 16) * ldo + col0 + bj * 64) = o; } }
    }
}

template <bool FP8, bool HALFN = false>
__device__ __forceinline__ void gemm_phase(LAS unsigned char* lds, LAS const int* ctl, int K, int lda, int ldb, int G, int c, int sW = 127, int sA = 127) {
    const int tid = threadIdx.x, wid = __builtin_amdgcn_readfirstlane(tid >> 6), lane = tid & 63, wr = wid >> 2, wc = wid & 3, fr = lane & 15, fq = lane >> 4;
    const int nt = K / BK;
    sW = sW * 0x01010101; sA = sA * 0x01010101;
    unsigned voffA[2], voffB[2];
#pragma unroll
    for (int i = 0; i < 2; ++i) { int R, C; stage_rc(tid * 16 + i * 8192, R, C); const int Rb = (R & ~31) + perm32(R & 31);
        voffA[i] = (unsigned)(R * lda + C) * 2u; voffB[i] = (unsigned)(Rb * ldb + C) * 2u; }
    const size_t kstep = (size_t)(BK * 2);
    const size_t hsA = (size_t)HALF * lda * 2, hsB = (size_t)HALF * ldb * 2;
    const size_t tsA = 2 * hsA, tsB = 2 * hsB;
    const unsigned ldsw = (unsigned)wid * 1024u;
    const int aoff = lds_byte(wr * 64 + fr, fq * 8), boff = lds_byte(wc * 32 + fr, fq * 8);
#define PG8_SA(b, h) (((b) * 2 + (h)) * HTB)
#define PG8_SB(b, h) ((4 + (b) * 2 + (h)) * HTB)
#define PG8_STAGE(bufoff, gbase, voff) do { _Pragma("unroll") for (int _i = 0; _i < 2; ++_i) \
        __builtin_amdgcn_global_load_lds((const unsigned*)((const char*)(gbase) + (voff)[_i]), (LAS unsigned*)(lds + (bufoff) + ldsw + _i * 8192), 16, 0, 0); } while (0)
#define PG8_LDA(dst, b, h) do { _Pragma("unroll") for (int m = 0; m < 4; ++m) { const i32x4 lo_ = *(const LAS i32x4*)(lds + PG8_SA(b, h) + aoff + m * 2048), hi_ = *(const LAS i32x4*)(lds + PG8_SA(b, h) + aoff + m * 2048 + 1024); \
        dst[m] = __builtin_shufflevector(lo_, hi_, 0, 1, 2, 3, 4, 5, 6, 7); } } while (0)
#define PG8_LDB(dst, b, h) do { _Pragma("unroll") for (int n = 0; n < 2; ++n) { const i32x4 lo_ = *(const LAS i32x4*)(lds + PG8_SB(b, h) + boff + n * 2048), hi_ = *(const LAS i32x4*)(lds + PG8_SB(b, h) + boff + n * 2048 + 1024); \
        dst[n] = __builtin_shufflevector(lo_, hi_, 0, 1, 2, 3, 4, 5, 6, 7); } } while (0)
#define PG8_LO(v) __builtin_bit_cast(bf16x8, __builtin_shufflevector(v, v, 0, 1, 2, 3))
#define PG8_HI(v) __builtin_bit_cast(bf16x8, __builtin_shufflevector(v, v, 4, 5, 6, 7))
#define PG8_MMA16(ai, bj, At, Bt) do { __builtin_amdgcn_s_setprio(1); _Pragma("unroll") for (int m = 0; m < 4; ++m) _Pragma("unroll") for (int n = 0; n < 2; ++n) { \
        acc[ai][bj][m][n] = __builtin_amdgcn_mfma_f32_16x16x32_bf16(PG8_LO(Bt[n]), PG8_LO(At[m]), acc[ai][bj][m][n], 0, 0, 0); \
        acc[ai][bj][m][n] = __builtin_amdgcn_mfma_f32_16x16x32_bf16(PG8_HI(Bt[n]), PG8_HI(At[m]), acc[ai][bj][m][n], 0, 0, 0); } __builtin_amdgcn_s_setprio(0); } while (0)
#define PG8_MMA8(ai, bj, At, Bt) do { __builtin_amdgcn_s_setprio(1); _Pragma("unroll") for (int m = 0; m < 4; ++m) _Pragma("unroll") for (int n = 0; n < 2; ++n) \
        asm volatile("v_mfma_scale_f32_16x16x128_f8f6f4 %0, %1, %2, %0, %3, %4 op_sel_hi:[0,0,0]" : "+v"(acc[ai][bj][m][n]) : "v"(Bt[n]), "v"(At[m]), "v"(sW), "v"(sA)); __builtin_amdgcn_s_setprio(0); } while (0)
#define PG8_MMA16Z(ai, bj, At, Bt) do { __builtin_amdgcn_s_setprio(1); _Pragma("unroll") for (int m = 0; m < 4; ++m) _Pragma("unroll") for (int n = 0; n < 2; ++n) { \
        acc[ai][bj][m][n] = __builtin_amdgcn_mfma_f32_16x16x32_bf16(PG8_LO(Bt[n]), PG8_LO(At[m]), (f32x4){0.f, 0.f, 0.f, 0.f}, 0, 0, 0); \
        acc[ai][bj][m][n] = __builtin_amdgcn_mfma_f32_16x16x32_bf16(PG8_HI(Bt[n]), PG8_HI(At[m]), acc[ai][bj][m][n], 0, 0, 0); } __builtin_amdgcn_s_setprio(0); } while (0)
#define PG8_MMA8Z(ai, bj, At, Bt) do { __builtin_amdgcn_s_setprio(1); _Pragma("unroll") for (int m = 0; m < 4; ++m) _Pragma("unroll") for (int n = 0; n < 2; ++n) \
        asm volatile("v_mfma_scale_f32_16x16x128_f8f6f4 %0, %1, %2, 0, %3, %4 op_sel_hi:[0,0,0]" : "=v"(acc[ai][bj][m][n]) : "v"(Bt[n]), "v"(At[m]), "v"(sW), "v"(sA)); __builtin_amdgcn_s_setprio(0); } while (0)
#define PG8_MMA(ai, bj, At, Bt) do { if constexpr (FP8) PG8_MMA8(ai, bj, At, Bt); else PG8_MMA16(ai, bj, At, Bt); } while (0)
#define PG8_MMAF(ai, bj, At, Bt) do { if constexpr (FP8) { if (t == 0) PG8_MMA8Z(ai, bj, At, Bt); else PG8_MMA8(ai, bj, At, Bt); } else PG8_MMA16(ai, bj, At, Bt); } while (0)
#define PG8_WAIT_V(n) asm volatile("s_waitcnt vmcnt(" #n ")" ::: "memory")
#define PG8_WAIT_L(n) asm volatile("s_waitcnt lgkmcnt(" #n ")" ::: "memory")
#define PG8_BAR __builtin_amdgcn_s_barrier()
#define PG8_SCHED __builtin_amdgcn_sched_barrier(0)
    Unit cur, nxt; int ui = 0;
    if (!sched_next(ctl, 0, G, c, tsA, tsB, cur)) return;
    f32x4 acc[2][2][4][2];
#pragma unroll
    for (int a = 0; a < 2; ++a)
#pragma unroll
        for (int b = 0; b < 2; ++b)
#pragma unroll
            for (int m = 0; m < 4; ++m)
#pragma unroll
                for (int n = 0; n < 2; ++n) acc[a][b][m][n] = (f32x4){0.f, 0.f, 0.f, 0.f};
    i32x8 At[4], B0[2], B1[2] = {};
    const char* cA = cur.A; const char* cB = cur.B;
    PG8_STAGE(PG8_SB(0, 0), cB, voffB); PG8_STAGE(PG8_SB(0, 1), cB + hsB, voffB); PG8_STAGE(PG8_SA(0, 0), cA, voffA); PG8_STAGE(PG8_SA(0, 1), cA + hsA, voffA);
    if (wr == 1) PG8_BAR;
    PG8_WAIT_V(2); PG8_BAR;
    PG8_STAGE(PG8_SB(1, 0), cB + kstep, voffB); PG8_STAGE(PG8_SA(1, 0), cA + kstep, voffA); PG8_STAGE(PG8_SB(1, 1), cB + hsB + kstep, voffB);
    PG8_WAIT_V(6); PG8_BAR;
    for (;;) {
        const bool has_next = sched_next(ctl, ui + 1, G, c, tsA, tsB, nxt);
        const char* nA = has_next ? nxt.A : cA; const char* nB = has_next ? nxt.B : cB;
        for (int t = 0; t < nt; t += 2) {
            const bool last = (t == nt - 2);
            const char* a1 = cA + (size_t)(t + 1) * kstep;
            const char* a2 = last ? nA : cA + (size_t)(t + 2) * kstep; const char* b2 = last ? nB : cB + (size_t)(t + 2) * kstep;
            const char* a3 = a2 + kstep; const char* b3 = b2 + kstep;
            PG8_LDB(B0, 0, 0); if constexpr (!HALFN) PG8_LDB(B1, 0, 1); PG8_SCHED; PG8_LDA(At, 0, 0); PG8_STAGE(PG8_SA(1, 1), a1 + hsA, voffA);
            PG8_WAIT_V(8); PG8_WAIT_L(0); PG8_BAR; PG8_MMAF(0, 0, At, B0); if constexpr (!HALFN) PG8_MMAF(0, 1, At, B1); PG8_BAR; PG8_SCHED;
            PG8_LDA(At, 0, 1); PG8_STAGE(PG8_SB(0, 0), b2, voffB); PG8_STAGE(PG8_SB(0, 1), b2 + hsB, voffB); PG8_STAGE(PG8_SA(0, 0), a2, voffA);
            PG8_WAIT_V(8); PG8_WAIT_L(0); PG8_BAR; PG8_MMAF(1, 0, At, B0); if constexpr (!HALFN) PG8_MMAF(1, 1, At, B1); PG8_BAR; PG8_SCHED;
            PG8_LDB(B0, 1, 0); if constexpr (!HALFN) PG8_LDB(B1, 1, 1); PG8_SCHED; PG8_LDA(At, 1, 0); PG8_STAGE(PG8_SA(0, 1), a2 + hsA, voffA);
            PG8_WAIT_V(8); PG8_WAIT_L(0); PG8_BAR; PG8_MMA(0, 0, At, B0); if constexpr (!HALFN) PG8_MMA(0, 1, At, B1); PG8_BAR; PG8_SCHED;
            PG8_LDA(At, 1, 1); PG8_STAGE(PG8_SB(1, 0), b3, voffB); PG8_STAGE(PG8_SB(1, 1), b3 + hsB, voffB); PG8_STAGE(PG8_SA(1, 0), a3, voffA);
            PG8_WAIT_V(8); PG8_WAIT_L(0); PG8_BAR; PG8_MMA(1, 0, At, B0); if constexpr (!HALFN) PG8_MMA(1, 1, At, B1); PG8_BAR; PG8_SCHED;
        }
        if (wr == 0) PG8_BAR;
        if constexpr (FP8) asm volatile("s_nop 15\n\ts_nop 15" ::: "memory");
        epilogue(acc, ctl, cur, wr, wc, fr, fq);
        if (!has_next) break;
        if constexpr (!FP8) {
#pragma unroll
        for (int a = 0; a < 2; ++a)
#pragma unroll
            for (int b = 0; b < 2; ++b)
#pragma unroll
                for (int m = 0; m < 4; ++m)
#pragma unroll
                    for (int n = 0; n < 2; ++n) acc[a][b][m][n] = (f32x4){0.f, 0.f, 0.f, 0.f};
        }
        cur = nxt; cA = nA; cB = nB; ++ui;
        if (wr == 1) PG8_BAR;
    }
    PG8_WAIT_V(0);
    PG8_BAR;
#undef PG8_SA
#undef PG8_SB
#undef PG8_STAGE
#undef PG8_LDA
#undef PG8_LDB
#undef PG8_MMA
#undef PG8_MMA8
#undef PG8_MMA8Z
#undef PG8_MMA16Z
#undef PG8_MMAF
#undef PG8_MMA16
#undef PG8_LO
#undef PG8_HI
#undef PG8_WAIT_V
#undef PG8_WAIT_L
#undef PG8_BAR
#undef PG8_SCHED
}
}

__device__ __forceinline__ int cvt_rowmap(int kind, int n) {
    if (kind == 1) { if (n < FF) return 8 * (n >> 2) + (n & 3); const int j = n - FF; return 8 * (j >> 2) + 4 + (j & 3); }
    if (kind == 2) { if (n < D) return n; if (n < 2 * D) { const int j = n - D; return D + 8 * (j >> 2) + (j & 3); } const int j = n - 2 * D; return D + 8 * (j >> 2) + 4 + (j & 3); }
    return n;
}
struct CvtIt { const float* src; bf16_t* dst; int K, N, ldd, kind, k0, n0; };
__device__ __forceinline__ void cvt_decode(LAS const int* ctl, int it, CvtIt& c) {
    const int nj = rfl(ctl[2]);
    int j = 0;
    for (int q = 1; q < nj; ++q) if (it >= rfl(ctl[256 + 16 * q + 11])) j = q;
    LAS const int* jd = ctl + 256 + 16 * j;
    const int loc = it - rfl(jd[11]), ipb = rfl(jd[12]), nNt = rfl(jd[13]);
    const int bat = loc / ipb, rem = loc % ipb, kb = rem / nNt, nb = rem % nNt;
    c.src = (const float*)(((unsigned long long)(unsigned)rfl(jd[1]) << 32) | (unsigned)rfl(jd[0])) + (size_t)bat * (size_t)(unsigned)rfl(jd[9]);
    c.dst = (bf16_t*)(((unsigned long long)(unsigned)rfl(jd[3]) << 32) | (unsigned)rfl(jd[2])) + (size_t)bat * (size_t)(unsigned)rfl(jd[10]);
    c.K = rfl(jd[4]); c.N = rfl(jd[5]); c.ldd = rfl(jd[6]); c.kind = rfl(jd[7]); c.k0 = 64 * kb; c.n0 = 64 * nb;
}
__device__ __forceinline__ void cvt_load(const CvtIt& c, f32x4 (&v)[16], int lane) {
    const int nn = 4 * (lane & 15);
    const int n = (c.n0 + nn) < c.N ? (c.n0 + nn) : (c.N - 4);
#pragma unroll
    for (int i = 0; i < 16; ++i) { const int k_ = c.k0 + 4 * i + (lane >> 4); const int k = k_ < c.K ? k_ : c.K - 1;
        v[i] = *(const f32x4*)(c.src + (size_t)k * c.N + n); }
}
__device__ __forceinline__ void cvt_to_lds(const f32x4 (&v)[16], LAS float* scr, int lane) {
    const int nn = 4 * (lane & 15);
#pragma unroll
    for (int i = 0; i < 16; ++i) { const int kk = 4 * i + (lane >> 4); LAS float* s = scr + kk * 65 + nn; s[0] = v[i][0]; s[1] = v[i][1]; s[2] = v[i][2]; s[3] = v[i][3]; }
    asm volatile("s_waitcnt lgkmcnt(0)" ::: "memory");
}
__device__ __forceinline__ void cvt_store(const CvtIt& ci, LAS const float* scr, int lane) {
    const int c = lane & 7; const int K = ci.K, N = ci.N, ldd = ci.ldd, kind = ci.kind, k0 = ci.k0, n0 = ci.n0; bf16_t* dst = ci.dst;
    if (kind & 0x100) {
        const float sc = (float)(1 << (kind >> 16));
#pragma unroll
        for (int j = 0; j < 8; ++j) { const int nl = (lane >> 3) + 8 * j; const LAS float* s = scr + (8 * c) * 65 + nl;
            const float scn = ((kind & 15) == 1 && n0 + nl >= FF) ? 4.0f * sc : sc;
            int w0 = __builtin_amdgcn_cvt_pk_fp8_f32(s[0] * scn, s[65] * scn, 0, false); w0 = __builtin_amdgcn_cvt_pk_fp8_f32(s[2 * 65] * scn, s[3 * 65] * scn, w0, true);
            int w1 = __builtin_amdgcn_cvt_pk_fp8_f32(s[4 * 65] * scn, s[5 * 65] * scn, 0, false); w1 = __builtin_amdgcn_cvt_pk_fp8_f32(s[6 * 65] * scn, s[7 * 65] * scn, w1, true);
            const int n = n0 + nl, k = k0 + 8 * c;
            if (n < N && k < K) *(u32x2*)((unsigned char*)dst + (size_t)cvt_rowmap(kind & 15, n) * ldd + k) = (u32x2){(unsigned)w0, (unsigned)w1}; }
    } else {
        const float sc = (kind & 0x200) ? -1.44269504f : 1.0f;
#pragma unroll
        for (int j = 0; j < 8; ++j) { const int nl = (lane >> 3) + 8 * j; const LAS float* s = scr + (8 * c) * 65 + nl;
            u32x4 o; o.x = cvt_pk_bf16_asm(s[0] * sc, s[65] * sc); o.y = cvt_pk_bf16_asm(s[2 * 65] * sc, s[3 * 65] * sc); o.z = cvt_pk_bf16_asm(s[4 * 65] * sc, s[5 * 65] * sc); o.w = cvt_pk_bf16_asm(s[6 * 65] * sc, s[7 * 65] * sc);
            const int n = n0 + nl, k = k0 + 8 * c;
            if (n < N && k < K) *(u32x4*)(dst + (size_t)cvt_rowmap(kind & 15, n) * ldd + k) = o; }
    }
    asm volatile("s_waitcnt lgkmcnt(0)" ::: "memory");
}
__device__ __forceinline__ void cvt_set(LAS int* ctl, int j, const float* src, void* dst, int K, int N, int ldd, int kind, int nb, int sstride, int dstride) {
    LAS int* jd = ctl + 256 + 16 * j;
    const unsigned long long a = (unsigned long long)src, b = (unsigned long long)dst;
    jd[0] = (int)(unsigned)a; jd[1] = (int)(unsigned)(a >> 32); jd[2] = (int)(unsigned)b; jd[3] = (int)(unsigned)(b >> 32);
    jd[4] = K; jd[5] = N; jd[6] = ldd; jd[7] = kind; jd[8] = nb; jd[9] = sstride; jd[10] = dstride;
    const int nKt = (K + 63) / 64, nNt = (N + 63) / 64;
    const int i0 = (j == 0) ? 0 : ctl[256 + 16 * (j - 1) + 11] + ctl[256 + 16 * (j - 1) + 12] * ctl[256 + 16 * (j - 1) + 8];
    jd[11] = i0; jd[12] = nKt * nNt; jd[13] = nNt;
    ctl[2] = j + 1; ctl[3] = i0 + nKt * nNt * nb;
}

template <int PART>
__device__ __forceinline__ void phase0(const Args& a, LAS unsigned char* lds, int tid, int lane, int wave, int G) {
    unsigned char* ws = a.ws;
    LAS int* ctl = (LAS int*)(lds + CTL_OFF);
    if (PART == 0) {
    if (tid == 0) {
        cvt_set(ctl, 0, a.in[8], ws + WS_WR, D, D, D, 0, 3, D * D, D * D);
        cvt_set(ctl, 1, a.in[10], ws + WS_WW1, D, 64, D, 0 | 0x100 | (5 << 16), 2, D * 64, 64 * D / 2);
        cvt_set(ctl, 2, a.in[13], ws + WS_WA1, D, 64, D, 0 | 0x100 | (5 << 16), 2, D * 64, 64 * D / 2);
        cvt_set(ctl, 3, a.in[15], ws + WS_WG1, D, 160, D, 0, 1, 0, 0);
        cvt_set(ctl, 4, a.in[11], ws + WS_W2W, 64, D, 64, 0x200, 2, 64 * D, D * 64);
        cvt_set(ctl, 5, a.in[14], ws + WS_W2A, 64, D, 64, 0x200, 2, 64 * D, D * 64);
        cvt_set(ctl, 6, a.in[16], ws + WS_W2G, 160, D, 160, 0, 1, 0, 0);
        cvt_set(ctl, 7, a.in[22], ws + WS_WOUT, D, D, D, 0, 1, 0, 0);
        cvt_set(ctl, 8, a.in[26], ws + WS_WGU, D, 2 * FF, D, 1 | 0x100 | (5 << 16), 1, 0, 0);
        cvt_set(ctl, 9, a.in[27], ws + WS_WDN, FF, D, FF, 0 | 0x100 | (6 << 16), 1, 0, 0);
        cvt_set(ctl, 10, a.in[23], ws + WS_WCI, D, 3 * D, D, 2, 1, 0, 0);
        cvt_set(ctl, 11, a.in[25], ws + WS_WCO, D, D, D, 0, 1, 0, 0);
        cvt_set(ctl, 12, a.in[29], ws + WS_MGU, D, 2 * FF, D, 1 | 0x100 | (5 << 16), NE, D * 2 * FF, FF * D);
        cvt_set(ctl, 13, a.in[30], ws + WS_MDN, FF, D, FF, 0 | 0x100 | (6 << 16), NE, FF * D, D * FF / 2);
    }
    if (blockIdx.x == 0 && tid < 64) ((int*)(ws + WS_CTL))[tid] = 0;
    {
        LAS float* s = (LAS float*)lds; LAS float* red = (LAS float*)(lds + 36864);
        for (int u = blockIdx.x; u < 256; u += G) {
            const int layer = u >> 7, n0 = (u & 127) * 48;
            for (int idx = tid; idx < 9 * D; idx += NTHREADS) { const int b = idx >> 10, k = idx & 1023; const float cv = b < 8 ? a.in[1][b * D + k] : a.in[3][k]; s[idx] = siluf_(cv); }
            __syncthreads();
            const float* W = a.in[4] + (size_t)layer * D * 6 * D + n0 + (lane < 48 ? lane : 47);
            float acc[9];
#pragma unroll
            for (int b = 0; b < 9; ++b) acc[b] = 0.f;
#pragma unroll 4
            for (int k = 128 * wave; k < 128 * wave + 128; k += 4) {
                const float w0 = W[(size_t)k * 6144], w1 = W[(size_t)(k + 1) * 6144], w2 = W[(size_t)(k + 2) * 6144], w3 = W[(size_t)(k + 3) * 6144];
#pragma unroll
                for (int b = 0; b < 9; ++b) { const f32x4 sv = *(const LAS f32x4*)(s + b * D + k); acc[b] += sv[0] * w0 + sv[1] * w1 + sv[2] * w2 + sv[3] * w3; }
            }
#pragma unroll
            for (int b = 0; b < 9; ++b) red[(wave * 9 + b) * 64 + lane] = acc[b];
            __syncthreads();
            for (int idx = tid; idx < 9 * 64; idx += NTHREADS) { const int b = idx >> 6, l = idx & 63; float t = 0.f;
#pragma unroll
                for (int w = 0; w < 8; ++w) t += red[(w * 9 + b) * 64 + l];
                if (l < 48) ((float*)(ws + WS_MODS))[(size_t)(layer * 9 + b) * 6144 + n0 + l] = t + a.in[5][layer * 6144 + n0 + l]; }
            __syncthreads();
        }
    }
    return; }
    const int gw = blockIdx.x * NWAVES + wave, NGW = G * NWAVES;
    const int rpw_ = (MT + NGW - 1) / NGW, rb_ = gw * rpw_, re_ = (rb_ + rpw_) < MT ? (rb_ + rpw_) : MT;
    for (int row = rb_; row < re_; ++row) {
        const float* xr = row < M ? a.in[0] + (size_t)row * D : a.in[2] + (size_t)(row - M) * D;
        float ss = 0.f;
#pragma unroll
        for (int j = 0; j < 4; ++j) { const f32x4 v = ld4(xr + 4 * lane + 256 * j); ss += v[0] * v[0] + v[1] * v[1] + v[2] * v[2] + v[3] * v[3]; }
        ss = wave_sum(ss);
        if (lane == 0) ((float*)(ws + WS_RSTD))[row] = rsqrtf(ss * (1.0f / D) + NORM_EPS);
    }
    {
        const int gt = blockIdx.x * NTHREADS + tid, NGT = G * NTHREADS;
        const u32x4 z = (u32x4){0u, 0u, 0u, 0u};
        for (int i = gt; i < 128 * D / 16; i += NGT) { ((u32x4*)(ws + WS_WW1 + 128 * D))[i] = z; ((u32x4*)(ws + WS_WA1 + 128 * D))[i] = z; }
        for (int i = gt; i < 96 * D / 8; i += NGT) ((u32x4*)(ws + WS_WG1 + 160 * D * 2))[i] = z;
    }
    __syncthreads();
    {
        LAS float* scr = (LAS float*)(lds + wave * 16640);
        const int nitems = rfl(ctl[3]);
        f32x4 v[16]; CvtIt cur, nxt;
        int it = gw;
        if (it < nitems) { cvt_decode(ctl, it, cur); cvt_load(cur, v, lane); }
        for (; it < nitems; it += NGW) {
            cvt_to_lds(v, scr, lane);
            const bool more = it + NGW < nitems;
            if (more) { cvt_decode(ctl, it + NGW, nxt); cvt_load(nxt, v, lane); }
            cvt_store(cur, scr, lane);
            if (more) cur = nxt;
        }
    }
}

__device__ __forceinline__ void phase_mix(const Args& a, int gw, int NGW, int lane) {
    unsigned char* ws = a.ws;
    const float* g = a.in[6];
    const float* mu = a.in[7];
    const float* mods = (const float*)(ws + WS_MODS);
    const float* rstd = (const float*)(ws + WS_RSTD);
    bf16_t* XN = (bf16_t*)(ws + WS_XN);
    const int rpw = (MT + NGW - 1) / NGW;
    const int rbeg = gw * rpw, rend = (rbeg + rpw) < MT ? (rbeg + rpw) : MT;
    float muv[6][2][8], gs[2][8], sh[2][8];
#pragma unroll
    for (int n = 0; n < 6; ++n)
#pragma unroll
        for (int j = 0; j < 2; ++j) { const f32x4 t0 = ld4(mu + n * D + 512 * j + 8 * lane), t1 = ld4(mu + n * D + 512 * j + 8 * lane + 4);
#pragma unroll
            for (int e = 0; e < 4; ++e) { muv[n][j][e] = t0[e]; muv[n][j][4 + e] = t1[e]; } }
    int curb = -1;
    f32x4 ps[2][2], pn_[2][2]; float prs = 0.f, prn[2] = {0.f, 0.f};
#define MIX_LOAD(rowv) do { const int row_ = (rowv); const bool ic_ = row_ >= M; const int r2_ = ic_ ? row_ - M : row_; const int t_ = ic_ ? r2_ % TCX : r2_ % T; \
        const float* base_ = ic_ ? a.in[2] : a.in[0]; prs = rstd[row_]; \
        _Pragma("unroll") for (int j = 0; j < 2; ++j) { int d_; \
            if (!ic_) { const int col = t_ & 63, gr = t_ >> 6, qd = 2 * j + (lane >> 5); \
                d_ = qd == 0 ? (col > 0 ? -1 : 0) : qd == 1 ? (col < 63 ? 1 : 0) : qd == 2 ? (gr > 0 ? -64 : 0) : (gr < 31 ? 64 : 0); \
            } else d_ = j == 0 ? (t_ > 0 ? -1 : 0) : (t_ < TCX - 1 ? 1 : 0); \
            const int c = 512 * j + 8 * lane; const float* p0_ = base_ + (size_t)r2_ * D + c; const float* p1_ = base_ + (size_t)(r2_ + d_) * D + c; \
            ps[j][0] = ld4(p0_); ps[j][1] = ld4(p0_ + 4); pn_[j][0] = ld4(p1_); pn_[j][1] = ld4(p1_ + 4); prn[j] = d_ != 0 ? rstd[row_ + d_] : 0.f; } } while (0)
    if (rbeg < rend) MIX_LOAD(rbeg);
    for (int row = rbeg; row < rend; ++row) {
        const bool isctx = row >= M;
        const int r2 = isctx ? row - M : row;
        const int b = isctx ? r2 / TCX : r2 / T;
        const int mb = isctx ? 8 : b;
        if (mb != curb) { curb = mb; const float* md = mods + (size_t)mb * 6144;
#pragma unroll
            for (int j = 0; j < 2; ++j) { const int c = 512 * j + 8 * lane;
#pragma unroll
                for (int e = 0; e < 8; e += 4) { const f32x4 gv = ld4(g + c + e), shv = ld4(md + c + e), scv = ld4(md + D + c + e);
#pragma unroll
                    for (int i = 0; i < 4; ++i) { gs[j][e + i] = gv[i] * (1.0f + scv[i]); sh[j][e + i] = shv[i]; } } } }
        f32x4 cs[2][2], cn[2][2]; const float rs = prs; float rn[2];
#pragma unroll
        for (int j = 0; j < 2; ++j) { cs[j][0] = ps[j][0]; cs[j][1] = ps[j][1]; cn[j][0] = pn_[j][0]; cn[j][1] = pn_[j][1]; rn[j] = prn[j]; }
        if (row + 1 < rend) MIX_LOAD(row + 1);
#pragma unroll
        for (int j = 0; j < 2; ++j) {
            const int c = 512 * j + 8 * lane;
            const float msk = rn[j] != 0.f ? 1.0f : 0.0f;
            float hs[8], dx[8];
#pragma unroll
            for (int e = 0; e < 8; ++e) { const float xs_ = cs[j][e >> 2][e & 3], xn_ = cn[j][e >> 2][e & 3];
                hs[e] = xs_ * rs * gs[j][e] + sh[j][e];
                const float hn = xn_ * rn[j] * gs[j][e] + sh[j][e] * msk;
                dx[e] = hn - hs[e]; }
#pragma unroll
            for (int n = 0; n < 6; ++n) { float o[8];
#pragma unroll
                for (int e = 0; e < 8; ++e) o[e] = hs[e] + dx[e] * muv[n][j][e];
                if (n == 1 || n == 4) {
                    int w0 = __builtin_amdgcn_cvt_pk_fp8_f32(o[0], o[1], 0, false); w0 = __builtin_amdgcn_cvt_pk_fp8_f32(o[2], o[3], w0, true);
                    int w1 = __builtin_amdgcn_cvt_pk_fp8_f32(o[4], o[5], 0, false); w1 = __builtin_amdgcn_cvt_pk_fp8_f32(o[6], o[7], w1, true);
                    *(u32x2*)((unsigned char*)(XN + (size_t)n * MT * D) + (size_t)row * D + c) = (u32x2){(unsigned)w0, (unsigned)w1};
                } else *(u32x4*)(XN + ((size_t)n * MT + row) * D + c) = pack8(o); }
        }
    }
#undef MIX_LOAD
}

__device__ __forceinline__ void phase_fin(const Args& a, LAS unsigned char* lds, int tid, int lane, int wave, int G) {
    unsigned char* ws = a.ws;
    const int q = lane >> 4, rho = lane & 15;
    const bf16_t* W2W = (const bf16_t*)(ws + WS_W2W); const bf16_t* W2A = (const bf16_t*)(ws + WS_W2A); const bf16_t* W2G = (const bf16_t*)(ws + WS_W2G);
    const bf16_t* L1W = (const bf16_t*)(ws + WS_L1W); const bf16_t* L1A = (const bf16_t*)(ws + WS_L1A); const bf16_t* L1G = (const bf16_t*)(ws + WS_L1G);
    const bf16_t* KR = (const bf16_t*)(ws + WS_KRAW); const bf16_t* RB = (const bf16_t*)(ws + WS_R);
    bf16_t* AT = (bf16_t*)(ws + WS_AT); bf16_t* BT = (bf16_t*)(ws + WS_BT); bf16_t* KT = (bf16_t*)(ws + WS_KT); bf16_t* RT = (bf16_t*)(ws + WS_RT); float* GC = (float*)(ws + WS_GC); bf16_t* GATE = (bf16_t*)(ws + WS_GATE);
    float* BONUS = (float*)(ws + WS_BONUS);
    const int nparts = G / NH;
    {
        const int h = blockIdx.x % NH;
        const int part = blockIdx.x / NH;
        if (part >= nparts) return;
        __syncthreads();
        for (int f = wave; f < 52; f += NWAVES) {
            int mat, p, n, s;
            if (f < 32) { mat = f >> 3; p = (f >> 2) & 1; n = (f >> 1) & 1; s = f & 1; } else { const int r = f - 32; mat = 4; p = r / 10; n = (r % 10) / 5; s = r % 5; }
            const int ch = h * 64 + p * 32 + 8 * (rho >> 2) + 4 * n + (rho & 3), k = 32 * s + 8 * q;
            const bf16_t* src = mat < 2 ? W2W + ((size_t)mat * D + ch) * 64 + k : mat < 4 ? W2A + ((size_t)(mat - 2) * D + ch) * 64 + k : W2G + (size_t)ch * 160 + k;
            *(LAS u32x4*)(lds + f * 1024 + lane * 16) = *(const u32x4*)src;
        }
        LAS float* PRM = (LAS float*)(lds + 53248);
        if (tid < 448) { const int arr = tid >> 6, c = tid & 63;
            PRM[tid] = arr < 2 ? a.in[9][arr * D + h * 64 + c] : arr < 4 ? a.in[12][(arr - 2) * D + h * 64 + c] : arr == 4 ? a.in[17][h * 64 + c] : arr == 5 ? a.in[18][h * 64 + c] : a.in[19][h * 64 + c]; }
        __syncthreads();
        bf16x8 n_tw[2][2], n_ta[2][2], n_tg[5]; u32x4 n_kv[2], n_rv[2];
#define FIN_LOAD(rbv) do { const int trow_ = (rbv) * 128 + wave * 16 + rho; const bool lat_ = ((rbv) * 128) < M; \
            _Pragma("unroll") for (int z = 0; z < 2; ++z) _Pragma("unroll") for (int s_ = 0; s_ < 2; ++s_) { n_tw[z][s_] = *(const bf16x8*)(L1W + (size_t)trow_ * 256 + z * 64 + 32 * s_ + 8 * q); n_ta[z][s_] = *(const bf16x8*)(L1A + (size_t)trow_ * 256 + z * 64 + 32 * s_ + 8 * q); } \
            if (lat_) { _Pragma("unroll") for (int s_ = 0; s_ < 5; ++s_) n_tg[s_] = *(const bf16x8*)(L1G + (size_t)trow_ * 256 + 32 * s_ + 8 * q); } \
            const size_t hb_ = ((size_t)(hm_row(trow_) + h * NPOS)) * 64; \
            _Pragma("unroll") for (int p_ = 0; p_ < 2; ++p_) { n_kv[p_] = *(const u32x4*)(KR + hb_ + p_ * 32 + 8 * q); if (lat_) n_rv[p_] = *(const u32x4*)(RB + hb_ + p_ * 32 + 8 * q); } } while (0)
        if (part < MT / 128) FIN_LOAD(part);
        for (int rb = part; rb < MT / 128; rb += nparts) {
            const int trow = rb * 128 + wave * 16 + rho;
            const bool lat = (rb * 128) < M;
            f32x4 aw[2][2][2], aa[2][2][2]; u32x4 gpk[2];
#pragma unroll
            for (int p = 0; p < 2; ++p)
#pragma unroll
                for (int n = 0; n < 2; ++n) {
#pragma unroll
                    for (int z = 0; z < 2; ++z) { aw[p][z][n] = (f32x4){0.f, 0.f, 0.f, 0.f}; aa[p][z][n] = (f32x4){0.f, 0.f, 0.f, 0.f};
#pragma unroll
                        for (int s = 0; s < 2; ++s) {
                            const bf16x8 fw = *(const LAS bf16x8*)(lds + ((z) * 8 + p * 4 + n * 2 + s) * 1024 + lane * 16);
                            const bf16x8 fa = *(const LAS bf16x8*)(lds + ((2 + z) * 8 + p * 4 + n * 2 + s) * 1024 + lane * 16);
                            aw[p][z][n] = __builtin_amdgcn_mfma_f32_16x16x32_bf16(fw, n_tw[z][s], aw[p][z][n], 0, 0, 0);
                            aa[p][z][n] = __builtin_amdgcn_mfma_f32_16x16x32_bf16(fa, n_ta[z][s], aa[p][z][n], 0, 0, 0); } }
                    if (lat) {
                        f32x4 ag = (f32x4){0.f, 0.f, 0.f, 0.f};
#pragma unroll
                        for (int s = 0; s < 5; ++s) { const bf16x8 fg = *(const LAS bf16x8*)(lds + (32 + p * 10 + n * 5 + s) * 1024 + lane * 16);
                            ag = __builtin_amdgcn_mfma_f32_16x16x32_bf16(fg, n_tg[s], ag, 0, 0, 0); }
                        if (n == 0) { gpk[p].x = cvt_pk_bf16(ag[0], ag[1]); gpk[p].y = cvt_pk_bf16(ag[2], ag[3]); } else { gpk[p].z = cvt_pk_bf16(ag[0], ag[1]); gpk[p].w = cvt_pk_bf16(ag[2], ag[3]); }
                    }
                }
            const u32x4 c_kv0 = n_kv[0], c_kv1 = n_kv[1], c_rv0 = n_rv[0], c_rv1 = n_rv[1];
            asm volatile("" :: "v"(c_kv0), "v"(c_kv1), "v"(c_rv0), "v"(c_rv1));
            if (rb + nparts < MT / 128) FIN_LOAD(rb + nparts);
            const int hr = hm_row(trow), bb = hr / (NH * NPOS), pos = hr - bb * (NH * NPOS);
            const size_t hbase = ((size_t)(hr + h * NPOS)) * 64;
            float ssq = 0.f, bon = 0.f;
#pragma unroll
            for (int p = 0; p < 2; ++p) { float kvt[8]; unpack8(p ? c_kv1 : c_kv0, kvt);
#pragma unroll
                for (int e = 0; e < 8; ++e) { const float kr = kvt[e] * PRM[4 * 64 + p * 32 + 8 * q + e]; ssq += kr * kr; } }
            ssq += __shfl_xor(ssq, 16); ssq += __shfl_xor(ssq, 32);
            const float inv = rsqrtf(fmaxf(ssq, 1e-24f));
#pragma unroll
            for (int p = 0; p < 2; ++p) {
                const int cl = p * 32 + 8 * q, cb = h * 64 + cl;
                const LAS float* pp = PRM + cl;
                float kv[8], rv[8], kds[8];
                unpack8(p ? c_kv1 : c_kv0, kv);
                if (lat) unpack8(p ? c_rv1 : c_rv0, rv); else { for (int e = 0; e < 8; ++e) rv[e] = 0.f; }
#pragma unroll
                for (int e = 0; e < 8; ++e) kds[e] = 0.f;
#pragma unroll
                for (int z = 0; z < 2; ++z) {
                    float oA[8], oB[8], oK[8], oR[8], gc[8];
#pragma unroll
                    for (int e = 0; e < 8; ++e) {
                        const int n = e >> 2, i = e & 3;
                        const float dl = -0.60653066f * sigmoidf_(aw[p][z][n][i] + pp[z * 64 + e]);
                        const float ic = sigmoidf_(aa[p][z][n][i] + pp[(2 + z) * 64 + e]);
                        float cum = dl, epv;
                        if (z == 0) { cum += dpp_mov<0x111>(cum); cum += dpp_mov<0x112>(cum); cum += dpp_mov<0x114>(cum); cum += dpp_mov<0x118>(cum); }
                        else        { cum += dpp_mov<0x101>(cum); cum += dpp_mov<0x102>(cum); cum += dpp_mov<0x104>(cum); cum += dpp_mov<0x108>(cum); }
                        const float ec = __builtin_amdgcn_exp2f(cum * 1.44269504f), en = __builtin_amdgcn_rcpf(ec);
                        if (z == 0) { epv = dpp_mov<0x111>(ec); if (rho == 0) epv = 1.0f; } else { epv = dpp_mov<0x101>(ec); if (rho == 15) epv = 1.0f; }
                        const float kk = kv[e] * pp[4 * 64 + e] * inv, bq = kk * ic, kd = kv[e] * (1.0f + (ic - 1.0f) * pp[5 * 64 + e]);
                        oA[e] = -kk * epv; oB[e] = bq * en; oK[e] = kd * en; oR[e] = rv[e] * ec; gc[e] = ec; kds[e] += kd;
                    }
                    *(u32x4*)(AT + (size_t)z * HMA + hbase + cl) = pack8(oA); *(u32x4*)(BT + (size_t)z * HMA + hbase + cl) = pack8(oB);
                    *(u32x4*)(KT + (size_t)z * HMA + hbase + cl) = pack8(oK); *(u32x4*)(RT + (size_t)z * HMA + hbase + cl) = pack8(oR);
                    if (rho == (z == 0 ? 15 : 0)) { float* gp = GC + (((size_t)z * NB * NH + bb * NH + h) * NCHK + (pos >> 4)) * 64 + cl;
                        *(f32x4*)gp = (f32x4){gc[0], gc[1], gc[2], gc[3]}; *(f32x4*)(gp + 4) = (f32x4){gc[4], gc[5], gc[6], gc[7]}; }
                }
                if (lat) {
#pragma unroll
                    for (int e = 0; e < 8; ++e) bon += rv[e] * 0.5f * kds[e] * pp[6 * 64 + e];
                    *(u32x4*)(GATE + (size_t)trow * D + cb) = gpk[p];
                }
            }
            if (lat) { bon += __shfl_xor(bon, 16); bon += __shfl_xor(bon, 32); if (q == 0) BONUS[(size_t)trow * NH + h] = bon; }
        }
    }
}

#undef FIN_LOAD
typedef unsigned short u16;
typedef short s16x4 __attribute__((ext_vector_type(4)));
constexpr int SC_PITCHB = 144;
constexpr int SET_R = 0, SET_P = 2304, SET_BH = 4608, SET_KH = 6912, SET_V = 9216, SET_TLM = 11520, SET_G = 13312, SET_BYTES = 13568;
constexpr int TLM_PITCHB = 112;
constexpr int SCR_OFF = 8 * SET_BYTES, SCR_BYTES = 2304;
static_assert(SCR_OFF + 4 * SCR_BYTES <= CTL_OFF, "scan LDS map");

__device__ __forceinline__ f32x4 mfma16(u32x4 a, u32x4 b, f32x4 c) {
    return __builtin_amdgcn_mfma_f32_16x16x32_bf16(__builtin_bit_cast(bf16x8, a), __builtin_bit_cast(bf16x8, b), c, 0, 0, 0);
}
__device__ __forceinline__ u32x4 opnd(f32x4 d) { u32x4 w; w.x = cvt_pk_bf16(d[0], d[1]); w.y = cvt_pk_bf16(d[2], d[3]); w.z = 0u; w.w = 0u; return w; }
__device__ __forceinline__ f32x4 mfma16h(u32x2 a, u32x2 b, f32x4 c) { return __builtin_amdgcn_mfma_f32_16x16x16bf16_1k(__builtin_bit_cast(s16x4, a), __builtin_bit_cast(s16x4, b), c, 0, 0, 0); }
__device__ __forceinline__ u32x2 opnd2(f32x4 d) { u32x2 w; w.x = cvt_pk_bf16(d[0], d[1]); w.y = cvt_pk_bf16(d[2], d[3]); return w; }
__device__ __forceinline__ unsigned tr_addr(unsigned matbase, int pitchb, int r0, int c0, int rho) { return matbase + (unsigned)((r0 + (rho >> 2)) * pitchb + (c0 + 4 * (rho & 3)) * 2); }

__device__ __forceinline__ int scan_row(int b, int dir, int s) {
    if (s < TCX) return M + b * TCX + (dir ? (TCX - 1 - s) : s);
    const int u = s - TCX; return b * T + (dir ? (T - 1 - u) : u);
}

__device__ __forceinline__ void scan_produce_tail(LAS unsigned char* set, LAS unsigned char* scr, int rho, int q) {
                asm volatile("s_waitcnt lgkmcnt(0)" ::: "memory");
                u32x4 fA[2], fB[2], fK[2], fR[2];
#pragma unroll
                for (int ks = 0; ks < 2; ++ks) { const int fo = rho * SC_PITCHB + (32 * ks + 8 * q) * 2;
                    fA[ks] = *(const LAS u32x4*)(scr + fo); fB[ks] = *(const LAS u32x4*)(set + SET_BH + fo); fK[ks] = *(const LAS u32x4*)(set + SET_KH + fo); fR[ks] = *(const LAS u32x4*)(set + SET_R + fo); }
                const f32x4 z4 = (f32x4){0.f, 0.f, 0.f, 0.f};
                f32x4 Lt = mfma16(fB[1], fA[1], mfma16(fB[0], fA[0], z4));
                f32x4 L  = mfma16(fA[1], fB[1], mfma16(fA[0], fB[0], z4));
                f32x4 Lk = mfma16(fA[1], fK[1], mfma16(fA[0], fK[0], z4));
                f32x4 Mb = mfma16(fB[1], fR[1], mfma16(fB[0], fR[0], z4));
                f32x4 Mk = mfma16(fK[1], fR[1], mfma16(fK[0], fR[0], z4));
                f32x4 Tt;
#pragma unroll
                for (int r = 0; r < 4; ++r) { const int rr_ = 4 * q + r;
                    Lt[r] = rr_ < rho ? Lt[r] : 0.f; Mb[r] = rr_ <= rho ? Mb[r] : 0.f; Mk[r] = rr_ <= rho ? Mk[r] : 0.f;
                    L[r] = rho < rr_ ? L[r] : 0.f; Lk[r] = rho < rr_ ? Lk[r] : 0.f;
                    Tt[r] = Lt[r] + (rr_ == rho ? 1.0f : 0.f); }
                { u32x2 w; w.x = cvt_pk_bf16(Mb[0], Mb[1]); w.y = cvt_pk_bf16(Mb[2], Mb[3]); *(LAS u32x2*)(set + SET_TLM + rho * TLM_PITCHB + (16 + 4 * q) * 2) = w;
                  w.x = cvt_pk_bf16(Mk[0], Mk[1]); w.y = cvt_pk_bf16(Mk[2], Mk[3]); *(LAS u32x2*)(set + SET_TLM + rho * TLM_PITCHB + (32 + 4 * q) * 2) = w; }
                const u32x2 oL = opnd2(L), oLt = opnd2(Lt);
                f32x4 X = mfma16h(oLt, oL, z4), Xt = mfma16h(oL, oLt, z4);
                u32x2 oX = opnd2(X), oXt = opnd2(Xt);
                Tt = mfma16h(oX, opnd2(Tt), Tt);
                X = mfma16h(oXt, oX, z4); Xt = mfma16h(oX, oXt, z4);
                oX = opnd2(X); oXt = opnd2(Xt);
                Tt = mfma16h(oX, opnd2(Tt), Tt);
                X = mfma16h(oXt, oX, z4);
                oX = opnd2(X);
                Tt = mfma16h(oX, opnd2(Tt), Tt);
                const u32x2 oT = opnd2(Tt);
                { const f32x4 tl = mfma16h(opnd2(Lk), oT, z4);
                  u32x2 w; w.x = cvt_pk_bf16(tl[0], tl[1]); w.y = cvt_pk_bf16(tl[2], tl[3]); *(LAS u32x2*)(set + SET_TLM + rho * TLM_PITCHB + (4 * q) * 2) = w; }
                {
                    const LAS unsigned char* ab = scr + (4 * q + (rho >> 2)) * SC_PITCHB + (4 * (rho & 3)) * 2;
                    const u32x2 t0 = __builtin_bit_cast(u32x2, __builtin_amdgcn_ds_read_tr16_b64_v4i16((LAS s16x4*)(ab))), t1 = __builtin_bit_cast(u32x2, __builtin_amdgcn_ds_read_tr16_b64_v4i16((LAS s16x4*)(ab + 32))),
                                t2 = __builtin_bit_cast(u32x2, __builtin_amdgcn_ds_read_tr16_b64_v4i16((LAS s16x4*)(ab + 64))), t3 = __builtin_bit_cast(u32x2, __builtin_amdgcn_ds_read_tr16_b64_v4i16((LAS s16x4*)(ab + 96)));
                    const f32x4 p0 = mfma16h(t0, oT, z4), p1 = mfma16h(t1, oT, z4);
                    const f32x4 p2 = mfma16h(t2, oT, z4), p3 = mfma16h(t3, oT, z4);
                    LAS unsigned char* pr = set + SET_P + rho * SC_PITCHB + (4 * q) * 2;
                    u32x2 w;
                    w.x = cvt_pk_bf16(p0[0], p0[1]); w.y = cvt_pk_bf16(p0[2], p0[3]); *(LAS u32x2*)(pr + 0) = w;
                    w.x = cvt_pk_bf16(p1[0], p1[1]); w.y = cvt_pk_bf16(p1[2], p1[3]); *(LAS u32x2*)(pr + 32) = w;
                    w.x = cvt_pk_bf16(p2[0], p2[1]); w.y = cvt_pk_bf16(p2[2], p2[3]); *(LAS u32x2*)(pr + 64) = w;
                    w.x = cvt_pk_bf16(p3[0], p3[1]); w.y = cvt_pk_bf16(p3[2], p3[3]); *(LAS u32x2*)(pr + 96) = w;
                }
                asm volatile("s_waitcnt lgkmcnt(0)" ::: "memory");
}

constexpr int WF_OFF = SCR_OFF + 8 * 2304, GF_OFF = WF_OFF + 16384, PRM_OFF = GF_OFF + 10240, FLG_OFF = PRM_OFF + 5 * 64 * 4;
static_assert(FLG_OFF + 64 <= CTL_OFF, "fused scan LDS map");
template <int DIR>
__device__ __forceinline__ void scan_producer(const Args& a, LAS unsigned char* lds, int lane, int p, int b, int h) {
    unsigned char* ws = a.ws;
    const int rho = lane & 15, q = lane >> 4, nr0 = lane >> 3, cc = lane & 7, bh = b * NH + h;
    constexpr int NR = NCHK / 4;
    const LAS float* PRM = (const LAS float*)(lds + PRM_OFF);
    const bf16_t* L1W = (const bf16_t*)(ws + WS_L1W); const bf16_t* L1A = (const bf16_t*)(ws + WS_L1A); const bf16_t* L1G = (const bf16_t*)(ws + WS_L1G);
    const bf16_t* KR = (const bf16_t*)(ws + WS_KRAW); const bf16_t* RB = (const bf16_t*)(ws + WS_R); const bf16_t* VB = (const bf16_t*)(ws + WS_V);
    bf16_t* GATE = (bf16_t*)(ws + WS_GATE); float* BON = (float*)(ws + (DIR ? WS_BONUS1 : WS_BONUS));
    bf16x8 n_tw[2], n_ta[2]; u32x4 n_kv[2], n_rv[2];
#define FS_NATC(chv) (DIR ? ((chv) < TCX / 16 ? TCX / 16 - 1 - (chv) : NCHK + TCX / 16 - 1 - (chv)) : (chv))
#define FS_TROW(natc) ((natc) < TCX / 16 ? M + b * TCX + 16 * (natc) + rho : b * T + 16 * (natc) - TCX + rho)
#define FS_LD16(T_, wsoff_, off_) (*(const T_*)(ws + (unsigned)((unsigned)(wsoff_) + (off_))))
#define FS_LOAD_A(chv) do { const int natc_ = FS_NATC(chv); const int trow_ = FS_TROW(natc_); \
        const unsigned wo_ = (unsigned)(trow_ * 512 + DIR * 128 + 16 * q); \
        _Pragma("unroll") for (int s_ = 0; s_ < 2; ++s_) { n_tw[s_] = FS_LD16(bf16x8, WS_L1W, wo_ + 64 * s_); n_ta[s_] = FS_LD16(bf16x8, WS_L1A, wo_ + 64 * s_); } } while (0)
#define FS_LOAD_B(chv) do { const int natc_ = FS_NATC(chv); \
        const unsigned hb_ = (unsigned)((bh * NPOS + 16 * natc_ + rho) * 128 + 16 * q); \
        _Pragma("unroll") for (int p_ = 0; p_ < 2; ++p_) { n_kv[p_] = FS_LD16(u32x4, WS_KRAW, hb_ + 64 * p_); n_rv[p_] = FS_LD16(u32x4, WS_R, hb_ + 64 * p_); } } while (0)
    FS_LOAD_A(p); FS_LOAD_B(p);
    for (int n = 0; n < NR; ++n) {
        const int ch = 4 * n + p, natc = FS_NATC(ch); const bool lat = natc >= TCX / 16; const int trow = FS_TROW(natc);
        LAS unsigned char* set = lds + ((n & 1) * 4 + p) * SET_BYTES;
        LAS unsigned char* scr = lds + SCR_OFF + ((n & 1) * 4 + p) * 2304;
        f32x4 aw[2][2], aa[2][2];
#pragma unroll
        for (int pp = 0; pp < 2; ++pp)
#pragma unroll
            for (int nn = 0; nn < 2; ++nn) { aw[pp][nn] = (f32x4){0.f, 0.f, 0.f, 0.f}; aa[pp][nn] = (f32x4){0.f, 0.f, 0.f, 0.f};
#pragma unroll
                for (int s = 0; s < 2; ++s) {
                    const bf16x8 fw = *(const LAS bf16x8*)(lds + WF_OFF + (pp * 4 + nn * 2 + s) * 1024 + lane * 16);
                    const bf16x8 fa = *(const LAS bf16x8*)(lds + WF_OFF + (8 + pp * 4 + nn * 2 + s) * 1024 + lane * 16);
                    aw[pp][nn] = __builtin_amdgcn_mfma_f32_16x16x32_bf16(fw, n_tw[s], aw[pp][nn], 0, 0, 0);
                    aa[pp][nn] = __builtin_amdgcn_mfma_f32_16x16x32_bf16(fa, n_ta[s], aa[pp][nn], 0, 0, 0); } }
        const int chn = n + 1 < NR ? ch + 4 : ch;
        FS_LOAD_A(chn);
        float ssq = 0.f, bon = 0.f;
#pragma unroll
        for (int pp = 0; pp < 2; ++pp) { float kvt[8]; unpack8(pp ? n_kv[1] : n_kv[0], kvt);
#pragma unroll
            for (int e = 0; e < 8; ++e) { const float kr = kvt[e] * PRM[2 * 64 + pp * 32 + 8 * q + e]; ssq += kr * kr; } }
        ssq += __shfl_xor(ssq, 16); ssq += __shfl_xor(ssq, 32);
        const float inv = rsqrtf(fmaxf(ssq, 1e-24f));
        const int tau = DIR ? 15 - rho : rho;
#pragma unroll
        for (int pp = 0; pp < 2; ++pp) {
            const int cl = pp * 32 + 8 * q;
            const LAS float* pr = PRM + cl;
            float kv[8], rv[8], oA[8], oB[8], oK[8], oR[8], gc[8];
            unpack8(pp ? n_kv[1] : n_kv[0], kv);
            if (lat) unpack8(pp ? n_rv[1] : n_rv[0], rv); else { for (int e = 0; e < 8; ++e) rv[e] = 0.f; }
#pragma unroll
            for (int e = 0; e < 8; ++e) {
                const int nn = e >> 2, i = e & 3;
                const float dl = -0.87503877f * __builtin_amdgcn_rcpf(1.0f + __builtin_amdgcn_exp2f(aw[pp][nn][i] + pr[e]));
                const float ic = __builtin_amdgcn_rcpf(1.0f + __builtin_amdgcn_exp2f(aa[pp][nn][i] + pr[64 + e]));
                float cum = dl, epv;
                if (DIR == 0) { cum += dpp_mov<0x111>(cum); cum += dpp_mov<0x112>(cum); cum += dpp_mov<0x114>(cum); cum += dpp_mov<0x118>(cum); }
                else          { cum += dpp_mov<0x101>(cum); cum += dpp_mov<0x102>(cum); cum += dpp_mov<0x104>(cum); cum += dpp_mov<0x108>(cum); }
                const float ec = __builtin_amdgcn_exp2f(cum), en = __builtin_amdgcn_rcpf(ec);
                if (DIR == 0) { epv = dpp_mov<0x111>(ec); if (rho == 0) epv = 1.0f; } else { epv = dpp_mov<0x101>(ec); if (rho == 15) epv = 1.0f; }
                const float kk = kv[e] * pr[2 * 64 + e] * inv, bq = kk * ic, kd = kv[e] * (1.0f + (ic - 1.0f) * pr[3 * 64 + e]);
                oA[e] = -kk * epv; oB[e] = bq * en; oK[e] = kd * en; oR[e] = rv[e] * ec; gc[e] = ec;
                bon += rv[e] * kd * pr[4 * 64 + e];
            }
            const int ro = tau * SC_PITCHB + cl * 2;
            *(LAS u32x4*)(scr + ro) = pack8v(oA); *(LAS u32x4*)(set + SET_BH + ro) = pack8v(oB); *(LAS u32x4*)(set + SET_KH + ro) = pack8v(oK); *(LAS u32x4*)(set + SET_R + ro) = pack8v(oR);
            if (rho == (DIR ? 0 : 15)) { *(LAS f32x4*)(set + SET_G + cl * 4) = (f32x4){gc[0], gc[1], gc[2], gc[3]}; *(LAS f32x4*)(set + SET_G + cl * 4 + 16) = (f32x4){gc[4], gc[5], gc[6], gc[7]}; }
            asm volatile("" ::: "memory");
        }
        FS_LOAD_B(chn);
        {
            bon += __shfl_xor(bon, 16); bon += __shfl_xor(bon, 32);
            const unsigned bo = (lat && q == 0) ? (unsigned)((DIR ? WS_BONUS1 : WS_BONUS) + (size_t)(trow * NH + h) * 4) : (unsigned)(WS_DUMP + 1024 + 4 * lane);
            *(float*)(ws + bo) = bon;
        }
        asm volatile("s_waitcnt lgkmcnt(0)" ::: "memory");
        __syncthreads();
    }
#undef FS_LOAD_A
#undef FS_LD16
#undef FS_LOAD_B
#undef FS_TROW
#undef FS_NATC
}

__device__ __forceinline__ void phase_scan_chunked(const Args& a, LAS unsigned char* lds, int tid, int lane, int wave, int G) {
    unsigned char* ws = a.ws;
    const bf16_t* VB = (const bf16_t*)(ws + WS_V);
    const int rho = lane & 15, q = lane >> 4;
    const unsigned ldsb = (unsigned)(size_t)lds;
    constexpr int NCH = NPOS / 16, NR = NCH / 4;
    for (int unit = blockIdx.x; unit < 2 * NB * NH; unit += G) {
        const int b = unit & 7, h = (unit >> 3) & 15, dir = unit >> 7, bh = b * NH + h;
        bf16_t* Yout = (bf16_t*)(ws + (dir ? WS_YB : WS_YF));
        __syncthreads();
        {
            const bf16_t* W2W = (const bf16_t*)(ws + WS_W2W); const bf16_t* W2A = (const bf16_t*)(ws + WS_W2A); const bf16_t* W2G = (const bf16_t*)(ws + WS_W2G);
            for (int f = wave; f < 26; f += NWAVES) {
                const bf16_t* src;
                if (f < 16) { const int mat = f >> 3, pp = (f >> 2) & 1, nn = (f >> 1) & 1, sx = f & 1; const int chn = h * 64 + pp * 32 + 8 * (rho >> 2) + 4 * nn + (rho & 3);
                    src = (mat ? W2A : W2W) + ((size_t)dir * D + chn) * 64 + 32 * sx + 8 * q; }
                else { const int r = f - 16, nn = r / 5, sx = r % 5; const int chn = h * 64 + dir * 32 + 8 * (rho >> 2) + 4 * nn + (rho & 3); src = W2G + (size_t)chn * 160 + 32 * sx + 8 * q; }
                *(LAS u32x4*)(lds + WF_OFF + f * 1024 + lane * 16) = *(const u32x4*)src;
            }
            if (tid < 4) ((LAS int*)(lds + FLG_OFF))[tid] = 0;
            if (tid < 320) { const int arr = tid >> 6, c = tid & 63;
                ((LAS float*)(lds + PRM_OFF))[tid] = arr == 0 ? -1.44269504f * a.in[9][dir * D + h * 64 + c] : arr == 1 ? -1.44269504f * a.in[12][dir * D + h * 64 + c] : arr == 2 ? a.in[17][h * 64 + c] : arr == 3 ? a.in[18][h * 64 + c] : 0.5f * a.in[19][h * 64 + c]; }
            __syncthreads();
        }
        if (wave >= 4) {
            if (dir == 0) scan_producer<0>(a, lds, lane, wave - 4, b, h); else scan_producer<1>(a, lds, lane, wave - 4, b, h);
            __syncthreads();
        } else {
            f32x4 S[4];
#pragma unroll
            for (int jb = 0; jb < 4; ++jb) S[jb] = (f32x4){0.f, 0.f, 0.f, 0.f};
            const f32x4 z4 = (f32x4){0.f, 0.f, 0.f, 0.f};
            const int trb = (4 * q + (rho >> 2)) * SC_PITCHB + (4 * (rho & 3)) * 2;
            const int rowb = rho * SC_PITCHB + (4 * q) * 2, tlmb = SET_TLM + rho * TLM_PITCHB + (4 * q) * 2;
#define TRRD(p) __builtin_bit_cast(u32x2, __builtin_amdgcn_ds_read_tr16_b64_v4i16((LAS s16x4*)(p)))
#define C_LOAD(X, st) \
            LAS unsigned char* const X##bptr = (st); \
            const u32x2 X##tv = TRRD((st) + SET_V + trb + 32 * wave); \
            const u32x2 X##tb0 = TRRD((st) + SET_BH + trb), X##tb1 = TRRD((st) + SET_BH + trb + 32), X##tb2 = TRRD((st) + SET_BH + trb + 64), X##tb3 = TRRD((st) + SET_BH + trb + 96); \
            const u32x2 X##tk0 = TRRD((st) + SET_KH + trb), X##tk1 = TRRD((st) + SET_KH + trb + 32), X##tk2 = TRRD((st) + SET_KH + trb + 64), X##tk3 = TRRD((st) + SET_KH + trb + 96); \
            const u32x2 X##pa = *(const LAS u32x2*)((st) + SET_P + rowb), X##pb = *(const LAS u32x2*)((st) + SET_P + rowb + 32), X##pc = *(const LAS u32x2*)((st) + SET_P + rowb + 64), X##pd = *(const LAS u32x2*)((st) + SET_P + rowb + 96); \
            const u32x2 X##tl = *(const LAS u32x2*)((st) + tlmb);
#define C_COMPUTE(X, chv) do { const int ch_ = (chv); \
            const f32x4 X##g0 = *(const LAS f32x4*)(X##bptr + SET_G + 16 * q), X##g1 = *(const LAS f32x4*)(X##bptr + SET_G + 16 * q + 64), X##g2 = *(const LAS f32x4*)(X##bptr + SET_G + 16 * q + 128), X##g3 = *(const LAS f32x4*)(X##bptr + SET_G + 16 * q + 192); \
            u32x4 bs0, bs1; \
            bs0.x = cvt_pk_bf16(S[0][0], S[0][1]); bs0.y = cvt_pk_bf16(S[0][2], S[0][3]); bs0.z = cvt_pk_bf16(S[1][0], S[1][1]); bs0.w = cvt_pk_bf16(S[1][2], S[1][3]); \
            bs1.x = cvt_pk_bf16(S[2][0], S[2][1]); bs1.y = cvt_pk_bf16(S[2][2], S[2][3]); bs1.z = cvt_pk_bf16(S[3][0], S[3][1]); bs1.w = cvt_pk_bf16(S[3][2], S[3][3]); \
            f32x4 U = mfma16h(X##tl, X##tv, z4); \
            U = mfma16((u32x4){X##pa.x, X##pa.y, X##pb.x, X##pb.y}, bs0, U); \
            U = mfma16((u32x4){X##pc.x, X##pc.y, X##pd.x, X##pd.y}, bs1, U); \
            u32x4 buv; buv.x = cvt_pk_bf16(U[0], U[1]); buv.y = cvt_pk_bf16(U[2], U[3]); buv.z = X##tv.x; buv.w = X##tv.y; \
            S[0] = mfma16((u32x4){X##tb0.x, X##tb0.y, X##tk0.x, X##tk0.y}, buv, S[0]) * X##g0; \
            S[1] = mfma16((u32x4){X##tb1.x, X##tb1.y, X##tk1.x, X##tk1.y}, buv, S[1]) * X##g1; \
            S[2] = mfma16((u32x4){X##tb2.x, X##tb2.y, X##tk2.x, X##tk2.y}, buv, S[2]) * X##g2; \
            S[3] = mfma16((u32x4){X##tb3.x, X##tb3.y, X##tk3.x, X##tk3.y}, buv, S[3]) * X##g3; \
            if (ch_ >= TCX / 16) { \
                const u32x2 X##ra = *(const LAS u32x2*)(X##bptr + SET_R + rowb), X##rb = *(const LAS u32x2*)(X##bptr + SET_R + rowb + 32), X##rc = *(const LAS u32x2*)(X##bptr + SET_R + rowb + 64), X##rd = *(const LAS u32x2*)(X##bptr + SET_R + rowb + 96); \
                const u32x2 X##mrb = *(const LAS u32x2*)(X##bptr + tlmb + 32), X##mrk = *(const LAS u32x2*)(X##bptr + tlmb + 64); \
                f32x4 Yv = mfma16((u32x4){X##ra.x, X##ra.y, X##rb.x, X##rb.y}, bs0, z4); \
                Yv = mfma16((u32x4){X##rc.x, X##rc.y, X##rd.x, X##rd.y}, bs1, Yv); \
                Yv = mfma16((u32x4){X##mrb.x, X##mrb.y, X##mrk.x, X##mrk.y}, buv, Yv); \
                const unsigned yo_ = (unsigned)(ybase + (16 * (ch_ - TCX / 16) + 4 * q) * ysign);        \
                _Pragma("unroll") for (int r = 0; r < 4; ++r) *(bf16_t*)((unsigned char*)Yout + (yo_ + (unsigned)(r * ysign))) = (bf16_t)(cvt_pk_bf16(Yv[r], 0.f) & 0xffffu); } } while (0)
            volatile LAS int* flg = (volatile LAS int*)(lds + FLG_OFF);
            bf16x8 c_tg[5];
#define CG_NATC(chv) (dir ? ((chv) < TCX / 16 ? TCX / 16 - 1 - (chv) : NCH + TCX / 16 - 1 - (chv)) : (chv))
#define CG_LOAD(chv) do { const int natg_ = CG_NATC(chv); const int trg_ = natg_ >= TCX / 16 ? b * T + 16 * natg_ - TCX + rho : rho; \
                _Pragma("unroll") for (int s_ = 0; s_ < 5; ++s_) c_tg[s_] = *(const bf16x8*)(ws + (unsigned)(WS_L1G + (size_t)trg_ * 512 + 16 * q + 64 * s_)); } while (0)
            CG_LOAD(wave);
            const int nr0 = lane >> 3, cc8 = lane & 7;
            u32x4 c_vv[2];
#define CV_LD(chv) do { const int natv_ = CG_NATC(chv); const unsigned vo_ = (unsigned)(WS_V + (size_t)(bh * NPOS + 16 * natv_ + nr0) * 128 + 16 * cc8); \
                c_vv[0] = *(const u32x4*)(ws + vo_); c_vv[1] = *(const u32x4*)(ws + vo_ + 1024); } while (0)
#define CV_ST(setp) do { const int t0_ = dir ? 15 - nr0 : nr0, t1_ = dir ? 7 - nr0 : nr0 + 8; \
                *(LAS u32x4*)((setp) + SET_V + t0_ * SC_PITCHB + 16 * cc8) = c_vv[0]; *(LAS u32x4*)((setp) + SET_V + t1_ * SC_PITCHB + 16 * cc8) = c_vv[1]; } while (0)
            CV_LD(wave); CV_ST(lds + wave * SET_BYTES);
            CV_LD(4 + wave);
            const int ysign = dir ? -2 * D : 2 * D, ybase = 2 * ((b * T + (dir ? T - 1 : 0)) * D + h * 64 + 16 * wave + rho);
            __syncthreads();
            for (int n = 1; n <= NR; ++n) {
                LAS unsigned char* sbase = lds + (((n - 1) & 1) * 4) * SET_BYTES;
                const int ch0 = 4 * (n - 1);
                { const int chg = ch0 + wave, natg = CG_NATC(chg); const bool latg = natg >= TCX / 16; u32x4 gpk = (u32x4){0u, 0u, 0u, 0u};
                  if (latg) {
#pragma unroll
                      for (int nn = 0; nn < 2; ++nn) { f32x4 ag = (f32x4){0.f, 0.f, 0.f, 0.f};
#pragma unroll
                          for (int s_ = 0; s_ < 5; ++s_) { const bf16x8 fg = *(const LAS bf16x8*)(lds + GF_OFF + (nn * 5 + s_) * 1024 + lane * 16);
                              ag = __builtin_amdgcn_mfma_f32_16x16x32_bf16(fg, c_tg[s_], ag, 0, 0, 0); }
                          if (nn == 0) { gpk.x = cvt_pk_bf16(ag[0], ag[1]); gpk.y = cvt_pk_bf16(ag[2], ag[3]); } else { gpk.z = cvt_pk_bf16(ag[0], ag[1]); gpk.w = cvt_pk_bf16(ag[2], ag[3]); } } }
                  const int trg = b * T + 16 * natg - TCX + rho;
                  const unsigned go = latg ? (unsigned)(WS_GATE + (size_t)(trg * D + h * 64 + dir * 32 + 8 * q) * 2) : (unsigned)(WS_DUMP + 16 * lane);
                  { const int chq_ = n < NR ? ch0 + 4 + wave : chg; CG_LOAD(chq_); }
                  *(u32x4*)(ws + go) = gpk; }
                if (n < NR) { CV_ST(lds + ((n & 1) * 4 + wave) * SET_BYTES); CV_LD(n + 1 < NR ? ch0 + 8 + wave : ch0 + 4 + wave); }
                scan_produce_tail(sbase + wave * SET_BYTES, lds + SCR_OFF + (((n - 1) & 1) * 4 + wave) * 2304, rho, q);
                asm volatile("s_waitcnt lgkmcnt(0)" ::: "memory");
                if (lane == 0) flg[wave] = n;
                asm volatile("s_waitcnt lgkmcnt(0)" ::: "memory");
#define C_WAIT(c) do { while (flg[(c)] < n) __builtin_amdgcn_s_sleep(1); asm volatile("" ::: "memory"); } while (0)
#pragma unroll 1
                for (int cc = 0; cc < 4; ++cc) { C_WAIT(cc); { C_LOAD(a_, sbase + cc * SET_BYTES) C_COMPUTE(a_, ch0 + cc); } }
                __syncthreads();
            }
#undef C_WAIT
#undef C_LOAD
#undef C_COMPUTE
#undef TRRD
#undef CG_LOAD
#undef CV_LD
#undef CV_ST
#undef CG_NATC
        }
    }
}

__device__ __forceinline__ void phase_readout(const Args& a, int gw, int NGW, int lane) {
    unsigned char* ws = a.ws;
    const bf16_t* YF = (const bf16_t*)(ws + WS_YF); const bf16_t* YB = (const bf16_t*)(ws + WS_YB); const bf16_t* VB = (const bf16_t*)(ws + WS_V); const bf16_t* GATE = (const bf16_t*)(ws + WS_GATE);
    const float* BONUS = (const float*)(ws + WS_BONUS); const float* BONUS1 = (const float*)(ws + WS_BONUS1); bf16_t* OG = (bf16_t*)(ws + WS_OG);
    float lw[16], lb[16];
#pragma unroll
    for (int e = 0; e < 16; e += 4) { const f32x4 w4 = ld4(a.in[20] + 16 * lane + e), b4 = ld4(a.in[21] + 16 * lane + e);
#pragma unroll
        for (int i = 0; i < 4; ++i) { lw[e + i] = w4[i]; lb[e + i] = b4[i]; } }
    u32x4 pyf[2], pyb[2], pv[2], pg[2]; float pbon = 0.f;
#define RO_LOAD(rowv) do { const int row_ = (rowv); const size_t off_ = (size_t)row_ * D + 16 * lane; \
        const size_t vo_ = ((size_t)(hm_row(row_) + (lane >> 2) * NPOS)) * 64 + 16 * (lane & 3); \
        pyf[0] = *(const u32x4*)(YF + off_); pyf[1] = *(const u32x4*)(YF + off_ + 8); pyb[0] = *(const u32x4*)(YB + off_); pyb[1] = *(const u32x4*)(YB + off_ + 8); \
        pv[0] = *(const u32x4*)(VB + vo_); pv[1] = *(const u32x4*)(VB + vo_ + 8); pg[0] = *(const u32x4*)(GATE + off_); pg[1] = *(const u32x4*)(GATE + off_ + 8); \
        pbon = BONUS[(size_t)row_ * NH + (lane >> 2)] + BONUS1[(size_t)row_ * NH + (lane >> 2)]; } while (0)
    if (gw < M) RO_LOAD(gw);
    for (int row = gw; row < M; row += NGW) {
        const size_t off = (size_t)row * D + 16 * lane;
        float y[16], t8[8], vv[16], gg[16], o[16];
        unpack8(pyf[0], y); unpack8(pyf[1], y + 8);
        unpack8(pyb[0], t8);
#pragma unroll
        for (int e = 0; e < 8; ++e) y[e] += t8[e];
        unpack8(pyb[1], t8);
#pragma unroll
        for (int e = 0; e < 8; ++e) y[8 + e] += t8[e];
        unpack8(pv[0], vv); unpack8(pv[1], vv + 8); unpack8(pg[0], gg); unpack8(pg[1], gg + 8);
        const float bon = pbon;
        if (row + NGW < M) RO_LOAD(row + NGW);
        float sm = 0.f;
#pragma unroll
        for (int e = 0; e < 16; ++e) sm += y[e];
        sm += __shfl_xor(sm, 1); sm += __shfl_xor(sm, 2);
        const float mean = sm * (1.0f / 64.0f);
        float vr = 0.f;
#pragma unroll
        for (int e = 0; e < 16; ++e) { y[e] -= mean; vr += y[e] * y[e]; }
        vr += __shfl_xor(vr, 1); vr += __shfl_xor(vr, 2);
        const float rs = rsqrtf(vr * (1.0f / 64.0f) + GN_EPS);
#pragma unroll
        for (int e = 0; e < 16; ++e) o[e] = (y[e] * rs * lw[e] + lb[e] + bon * vv[e]) * gg[e];
        *(u32x4*)(OG + off) = pack8(o); *(u32x4*)(OG + off + 8) = pack8(o + 8);
    }
#undef RO_LOAD
}

__device__ __forceinline__ int moe_split_row(const int* CNT) {
    int RT = 0, la = 0, lb = 0;
#pragma unroll
    for (int e = 0; e < NE; ++e) { const int nM = (CNT[e] + 255) >> 8; RT += nM; if (nM > 0) { la = lb; lb = nM; } }
    const int t = RT - (la + lb);
    return 256 * (t > SPL_TILES ? t : SPL_TILES);
}

template <int MODE>
__device__ __forceinline__ void phase_rowpass(const Args& a, LAS unsigned char* lds, int tid, int lane, int wave, int G) {
    unsigned char* ws = a.ws;
    const float* mods = (const float*)(ws + WS_MODS);
    const float* ng = a.in[6];
    const bf16_t* Y0 = (const bf16_t*)(ws + WS_Y0); bf16_t* XR = (bf16_t*)(ws + WS_XR); bf16_t* HB = (bf16_t*)(ws + WS_HB);
    const bf16_t* YS = (const bf16_t*)(ws + WS_YS); const bf16_t* YSP = (const bf16_t*)(ws + WS_YSP);
    const int splrow = MODE == 3 ? moe_split_row((const int*)(ws + WS_CTL)) : 0;
    const int lpost = MODE < 2 ? 0 : 1, gtoff = (MODE == 0 || MODE == 2) ? 2048 : 5120, gpost = (MODE == 0 || MODE == 2) ? 1 : 3;
    const int lpre = MODE == 0 ? 0 : 1, gpre = MODE == 0 ? 2 : (MODE == 1 ? 0 : 2), shoff = MODE == 1 ? 0 : 3072, scoff = MODE == 1 ? 1024 : 4096;
    LAS int* lcnt = (LAS int*)lds;
    LAS int* linfo = (LAS int*)(lds + 256);
    LAS float* lwr = (LAS float*)(lds + 4096);
    int* CNT = (int*)(ws + WS_CTL);
    if (MODE == 2) {
        if (tid < 16) lcnt[tid] = 0;
        for (int i = tid; i < D * NE / 4; i += NTHREADS) *(LAS f32x4*)(lwr + 4 * i) = ld4(a.in[28] + 4 * i);
        __syncthreads();
    }
    const int rpb = (M + G - 1) / G;
    const int r0 = blockIdx.x * rpb, r1 = (r0 + rpb) < M ? (r0 + rpb) : M;
    const int nrw = (r1 - r0 - wave + NWAVES - 1) / NWAVES;
    const int bt = r0 / T;
    const float* mdp = mods + (size_t)(lpost * 9 + bt) * 6144;
    const float* mdn = mods + (size_t)(lpre * 9 + bt) * 6144;
    f32x4 cgt[4], cgp[4], cgn[4], csh[4];
#pragma unroll
    for (int j = 0; j < 4; ++j) { const int c = 4 * lane + 256 * j;
        cgt[j] = ld4(mdp + gtoff + c) * ld4(ng + (lpost * 4 + gpost) * D + c);
        if (MODE != 3) { cgn[j] = ld4(ng + (lpre * 4 + gpre) * D + c) * (1.0f + ld4(mdn + scoff + c)); csh[j] = ld4(mdn + shoff + c); } }
    int sl1 = 0, sl2 = 0; float gg1 = 0.f, gg2 = 0.f;
    if (MODE == 3) {
        int pst[NE]; int acc = 0;
#pragma unroll
        for (int e = 0; e < NE; ++e) { pst[e] = acc; acc += (CNT[e] + 255) & ~255; }
        if (lane < nrw) { const int row = r0 + wave + NWAVES * lane;
            const int* TP = (const int*)(ws + WS_TPOS); const int* TE = (const int*)(ws + WS_TOPE); const float* TG = (const float*)(ws + WS_TOPG);
            const int e1 = TE[2 * row], e2 = TE[2 * row + 1]; sl1 = TP[2 * row]; sl2 = TP[2 * row + 1];
#pragma unroll
            for (int e = 0; e < NE; ++e) { if (e == e1) sl1 += pst[e]; if (e == e2) sl2 += pst[e]; }
            gg1 = TG[2 * row]; gg2 = TG[2 * row + 1]; }
    }
    u32x2 pf[4], pf2[4], pxb[4]; f32x4 pxf[4];
#define RP_LOAD(k) do { const int row_ = r0 + wave + NWAVES * (k); \
        if (MODE == 3) { const int s1_ = __builtin_amdgcn_readlane(sl1, (k)), s2_ = __builtin_amdgcn_readlane(sl2, (k)); \
            const bf16_t* p1_ = s1_ < splrow ? YS + (size_t)s1_ * D : YSP + (size_t)(s1_ - splrow) * D; const bf16_t* p2_ = s2_ < splrow ? YS + (size_t)s2_ * D : YSP + (size_t)(s2_ - splrow) * D; \
            _Pragma("unroll") for (int j = 0; j < 4; ++j) { pf[j] = *(const u32x2*)(p1_ + 4 * lane + 256 * j); pf2[j] = *(const u32x2*)(p2_ + 4 * lane + 256 * j); } } \
        else { _Pragma("unroll") for (int j = 0; j < 4; ++j) pf[j] = *(const u32x2*)(Y0 + (size_t)row_ * D + 4 * lane + 256 * j); } \
        if (MODE == 0) { _Pragma("unroll") for (int j = 0; j < 4; ++j) pxf[j] = ld4(a.in[0] + (size_t)row_ * D + 4 * lane + 256 * j); } \
        else { _Pragma("unroll") for (int j = 0; j < 4; ++j) pxb[j] = *(const u32x2*)(XR + (size_t)row_ * D + 4 * lane + 256 * j); } } while (0)
    if (nrw > 0) RP_LOAD(0);
    for (int k = 0; k < nrw; ++k) {
        const int row = r0 + wave + NWAVES * k;
        f32x4 f[4], xr[4];
#pragma unroll
        for (int j = 0; j < 4; ++j) { float y1[4]; unpack4(pf[j], y1);
            if (MODE == 3) { float y2[4]; unpack4(pf2[j], y2);
                const int s1c = __builtin_amdgcn_readlane(sl1, k), s2c = __builtin_amdgcn_readlane(sl2, k);
                if (s1c >= splrow) { for (int sl = 1; sl < SPL_K; ++sl) { float t4[4]; unpack4(*(const u32x2*)(YSP + ((size_t)sl * SPL_ROWS + (s1c - splrow)) * D + 4 * lane + 256 * j), t4); y1[0] += t4[0]; y1[1] += t4[1]; y1[2] += t4[2]; y1[3] += t4[3]; } }
                if (s2c >= splrow) { for (int sl = 1; sl < SPL_K; ++sl) { float t4[4]; unpack4(*(const u32x2*)(YSP + ((size_t)sl * SPL_ROWS + (s2c - splrow)) * D + 4 * lane + 256 * j), t4); y2[0] += t4[0]; y2[1] += t4[1]; y2[2] += t4[2]; y2[3] += t4[3]; } }
                const float g1 = __builtin_bit_cast(float, __builtin_amdgcn_readlane(__builtin_bit_cast(int, gg1), k)), g2 = __builtin_bit_cast(float, __builtin_amdgcn_readlane(__builtin_bit_cast(int, gg2), k));
                f[j] = (f32x4){g1 * y1[0] + g2 * y2[0], g1 * y1[1] + g2 * y2[1], g1 * y1[2] + g2 * y2[2], g1 * y1[3] + g2 * y2[3]}; }
            else f[j] = (f32x4){y1[0], y1[1], y1[2], y1[3]};
            if (MODE == 0) xr[j] = pxf[j]; else { float x1[4]; unpack4(pxb[j], x1); xr[j] = (f32x4){x1[0], x1[1], x1[2], x1[3]}; } }
        if (k + 1 < nrw) RP_LOAD(k + 1);
        float ss = 0.f;
#pragma unroll
        for (int j = 0; j < 4; ++j) ss += f[j][0] * f[j][0] + f[j][1] * f[j][1] + f[j][2] * f[j][2] + f[j][3] * f[j][3];
        ss = wave_sum(ss);
        const float rs = rsqrtf(ss * (1.0f / D) + NORM_EPS);
        float ss2 = 0.f;
#pragma unroll
        for (int j = 0; j < 4; ++j) {
            xr[j] = xr[j] + cgt[j] * (f[j] * rs);
            ss2 += xr[j][0] * xr[j][0] + xr[j][1] * xr[j][1] + xr[j][2] * xr[j][2] + xr[j][3] * xr[j][3]; }
        if (MODE == 3) {
#pragma unroll
            for (int j = 0; j < 4; ++j) *(f32x4*)(a.out + (size_t)row * D + 4 * lane + 256 * j) = xr[j];
            continue;
        }
#pragma unroll
        for (int j = 0; j < 4; ++j) { u32x2 w; w.x = cvt_pk_bf16_asm(xr[j][0], xr[j][1]); w.y = cvt_pk_bf16_asm(xr[j][2], xr[j][3]); *(u32x2*)(XR + (size_t)row * D + 4 * lane + 256 * j) = w; }
        ss2 = wave_sum(ss2);
        const float rs2 = rsqrtf(ss2 * (1.0f / D) + NORM_EPS);
        float lg[NE];
#pragma unroll
        for (int e = 0; e < NE; ++e) lg[e] = 0.f;
#pragma unroll
        for (int j = 0; j < 4; ++j) { const int c = 4 * lane + 256 * j;
            const f32x4 hv = xr[j] * rs2 * cgn[j] + csh[j];
            if (MODE == 1) { u32x2 w; w.x = cvt_pk_bf16_asm(hv[0], hv[1]); w.y = cvt_pk_bf16_asm(hv[2], hv[3]); *(u32x2*)(HB + (size_t)row * D + c) = w; }
            else { int w = __builtin_amdgcn_cvt_pk_fp8_f32(hv[0], hv[1], 0, false); w = __builtin_amdgcn_cvt_pk_fp8_f32(hv[2], hv[3], w, true);
                if (MODE == 0) *(int*)((unsigned char*)HB + (size_t)row * D + c) = w; else *(LAS int*)(lds + 40960 + (row - r0) * D + c) = w; }
            if (MODE == 2) {
                const LAS float* wr = lwr + (size_t)c * NE;
#pragma unroll
                for (int i = 0; i < 4; ++i) { const f32x4 wa = *(const LAS f32x4*)(wr + i * NE), wb = *(const LAS f32x4*)(wr + i * NE + 4);
                    lg[0] += hv[i] * wa[0]; lg[1] += hv[i] * wa[1]; lg[2] += hv[i] * wa[2]; lg[3] += hv[i] * wa[3];
                    lg[4] += hv[i] * wb[0]; lg[5] += hv[i] * wb[1]; lg[6] += hv[i] * wb[2]; lg[7] += hv[i] * wb[3]; }
            }
        }
        if (MODE == 2) {
#pragma unroll
            for (int e = 0; e < NE; ++e) lg[e] = wave_sum(lg[e]);
            if (lane == 0) {
                int e1 = 0; float v1 = lg[0];
#pragma unroll
                for (int e = 1; e < NE; ++e) if (lg[e] > v1) { v1 = lg[e]; e1 = e; }
                int e2 = -1; float v2 = -3.0e38f;
#pragma unroll
                for (int e = 0; e < NE; ++e) if (e != e1 && lg[e] > v2) { v2 = lg[e]; e2 = e; }
                const float g1 = 1.0f / (1.0f + __expf(v2 - v1));
                ((int*)(ws + WS_TOPE))[2 * row] = e1; ((int*)(ws + WS_TOPE))[2 * row + 1] = e2;
                ((float*)(ws + WS_TOPG))[2 * row] = g1; ((float*)(ws + WS_TOPG))[2 * row + 1] = 1.0f - g1;
                const int p1 = atomicAdd((int*)(lcnt + e1), 1), p2 = atomicAdd((int*)(lcnt + e2), 1);
                const int lr = row - r0;
                linfo[4 * lr] = e1; linfo[4 * lr + 1] = e2; linfo[4 * lr + 2] = p1; linfo[4 * lr + 3] = p2;
            }
        }
    }
#undef RP_LOAD
    if (MODE == 2) {
        __syncthreads();
        if (tid < NE) lcnt[8 + tid] = atomicAdd(CNT + tid, lcnt[tid]);
        __syncthreads();
        int* TP = (int*)(ws + WS_TPOS);
        for (int lr = tid; lr < r1 - r0; lr += NTHREADS) {
            const int e1 = linfo[4 * lr], e2 = linfo[4 * lr + 1];
            TP[2 * (r0 + lr)] = lcnt[8 + e1] + linfo[4 * lr + 2]; TP[2 * (r0 + lr) + 1] = lcnt[8 + e2] + linfo[4 * lr + 3];
        }
        unsigned char* XS = ws + WS_XS;
        for (int pr = wave; pr < 2 * (r1 - r0); pr += NWAVES) { const int lr = pr >> 1, k = pr & 1;
            const int e = linfo[4 * lr + k], pos = lcnt[8 + e] + linfo[4 * lr + 2 + k];
            *(u32x4*)(XS + ((size_t)e * M + pos) * D + 16 * lane) = *(const LAS u32x4*)(lds + 40960 + lr * D + 16 * lane); }
    }
}

__device__ __forceinline__ void phase_conv(const Args& a, int tid, int G) {
    unsigned char* ws = a.ws;
    const bf16_t* BG = (const bf16_t*)(ws + WS_BG); const bf16_t* Z = (const bf16_t*)(ws + WS_Z); bf16_t* CV = (bf16_t*)(ws + WS_CV);
    const float* cw = a.in[24];
    const int gt = blockIdx.x * NTHREADS + tid, NGT = G * NTHREADS;
    const int c = (gt & 127) * 8;
    float w0[8], w1[8], w2[8];
#pragma unroll
    for (int e = 0; e < 8; ++e) { w0[e] = cw[c + e]; w1[e] = cw[D + c + e]; w2[e] = cw[2 * D + c + e]; }
    u32x4 pz, pp, pn, pb;
#define CV_LOAD(idxv) do { const int row_ = (idxv) >> 7, t_ = row_ % T; \
        pz = *(const u32x4*)(Z + (size_t)row_ * D + c); pb = *(const u32x4*)(BG + (size_t)row_ * D + c); \
        pp = *(const u32x4*)(Z + (size_t)(row_ - (t_ > 0 ? 1 : 0)) * D + c); pn = *(const u32x4*)(Z + (size_t)(row_ + (t_ < T - 1 ? 1 : 0)) * D + c); } while (0)
    if (gt < M * (D / 8)) CV_LOAD(gt);
    for (int idx = gt; idx < M * (D / 8); idx += NGT) {
        const int row = idx >> 7, t = row % T;
        float zc[8], zp[8], zn[8], bg[8], o[8];
        unpack8(pz, zc); unpack8(pb, bg); unpack8(pp, zp); unpack8(pn, zn);
        if (idx + NGT < M * (D / 8)) CV_LOAD(idx + NGT);
        const float mp = t > 0 ? 1.f : 0.f, mn = t < T - 1 ? 1.f : 0.f;
#pragma unroll
        for (int e = 0; e < 8; ++e) o[e] = bg[e] * (zp[e] * (w0[e] * mp) + zc[e] * w1[e] + zn[e] * (w2[e] * mn));
        *(u32x4*)(CV + (size_t)row * D + c) = pack8(o);
    }
#undef CV_LOAD
}

__device__ __forceinline__ void phase_gather(const Args& a, int gw, int NGW, int lane) {
    unsigned char* ws = a.ws;
    const int* CNT = (const int*)(ws + WS_CTL); const int* TE = (const int*)(ws + WS_TOPE); const int* TP = (const int*)(ws + WS_TPOS);
    const bf16_t* HB = (const bf16_t*)(ws + WS_HB); bf16_t* XS = (bf16_t*)(ws + WS_XS);
    int pst[NE]; { int acc = 0;
#pragma unroll
        for (int e = 0; e < NE; ++e) { pst[e] = acc; acc += (CNT[e] + 255) & ~255; } }
    for (int pr = gw; pr < 2 * M; pr += NGW) {
        const int e = TE[pr]; int slot = TP[pr];
#pragma unroll
        for (int q = 0; q < NE; ++q) if (q == e) slot += pst[q];
        const u32x4* src = (const u32x4*)((const unsigned char*)HB + (size_t)(pr >> 1) * D); u32x4* dst = (u32x4*)((unsigned char*)XS + (size_t)slot * D);
        dst[lane] = src[lane];
    }
}

#define XB_TMO      128
#define XB_INIT     64
#define XB_INIT_TOKEN 0x5EED1E57u
#define XB_XCNT(j)  (256  + 64 * (j))
#define XB_XSUB(j)  (1280 + 64 * (j))
#define XB_XGEN(j)  (2304 + 64 * (j))
#define XB_TOP      3328
#define XB_TOPGEN   3392
#define XCD_BAR_WORDS 3456
#define XB_SPIN_CAP (1u << 20)
__device__ __forceinline__ unsigned xb_ld(unsigned* p)              { return __hip_atomic_load(p, __ATOMIC_RELAXED, __HIP_MEMORY_SCOPE_AGENT); }
__device__ __forceinline__ unsigned xb_add(unsigned* p, unsigned v) { return __hip_atomic_fetch_add(p, v, __ATOMIC_RELAXED, __HIP_MEMORY_SCOPE_AGENT); }
__device__ __forceinline__ unsigned xb_xcc_id() { return (unsigned)__builtin_amdgcn_s_getreg((3 << 11) | 20) & 0xFu; }
#define XB_SPIN(cond, bar) do { unsigned _sp = 0; while (cond) { __builtin_amdgcn_s_sleep(1); \
    if ((++_sp & 255u) == 0u) { if (xb_ld(&(bar)[XB_TMO])) break; if (_sp > XB_SPIN_CAP) { atomicAdd(&(bar)[XB_TMO], 1u); break; } } } } while (0)
struct XcdBarrier { unsigned* bar; unsigned x, rank; volatile LAS unsigned* st; };
__device__ __forceinline__ void xb_st(unsigned* p, unsigned v) { __hip_atomic_store(p, v, __ATOMIC_RELAXED, __HIP_MEMORY_SCOPE_AGENT); }
__device__ __forceinline__ XcdBarrier xcd_barrier_post(unsigned* bar, volatile LAS unsigned* st) {
    XcdBarrier b; b.bar = bar; b.x = xb_xcc_id(); b.st = st; b.rank = 0u;
    if (threadIdx.x == 0) b.rank = xb_add(&bar[XB_XCNT(b.x)], 1u);
    b.rank = (unsigned)__builtin_amdgcn_readfirstlane((int)b.rank);
    return b;
}
__device__ __forceinline__ void xcd_barrier_complete(unsigned* bar, unsigned x, unsigned& nloc, unsigned& mask) {
    const unsigned G = gridDim.x * gridDim.y * gridDim.z;
    unsigned sum, mk, mine, sp = 0u;
    for (;;) {
        sum = 0u; mk = 0u; mine = 0u;
#pragma unroll
        for (unsigned j = 0; j < 16; ++j) { const unsigned c = xb_ld(&bar[XB_XCNT(j)]); sum += c; mk |= (c > 0u) ? (1u << j) : 0u; mine = (j == x) ? c : mine; }
        if (sum == G) break;
        __builtin_amdgcn_s_sleep(1);
        if ((++sp & 255u) == 0u) { if (xb_ld(&bar[XB_TMO])) break; if (sp > XB_SPIN_CAP) { atomicAdd(&bar[XB_TMO], 1u); break; } }
    }
    nloc = mine > 0u ? mine : 1u; mask = mk;
}
__device__ __forceinline__ void xcd_barrier(const XcdBarrier& b) {
    asm volatile("s_waitcnt vmcnt(0)" ::: "memory");
    __syncthreads();
    if (threadIdx.x < 64) {
        const unsigned lane = threadIdx.x;
        unsigned* bar = b.bar;
        if (b.st[0] == 0u) { if (lane == 0) { unsigned nl, mk; xcd_barrier_complete(bar, b.x, nl, mk); b.st[0] = nl; b.st[1] = mk; } }
        const unsigned nloc = b.st[0], mask = b.st[1], gen = b.st[2] + 1u;
        if (lane == 0) b.st[2] = gen;
        if (b.rank != 0u) {
            if (lane == 0) xb_st(&bar[XB_XSUB(b.x) + b.rank], gen);
            asm volatile("buffer_inv sc1" ::: "memory");
        } else {
            asm volatile("buffer_inv sc1" ::: "memory");
            for (unsigned base = 0; base < nloc; base += 64u) {
                const unsigned r = base + lane; unsigned sp = 0u;
                for (;;) {
                    const unsigned v = (r > 0u && r < nloc) ? xb_ld(&bar[XB_XSUB(b.x) + r]) : gen;
                    if (__builtin_amdgcn_ballot_w64((int)(v - gen) < 0) == 0ull) break;
                    __builtin_amdgcn_s_sleep(1);
                    if ((++sp & 255u) == 0u) { if (xb_ld(&bar[XB_TMO])) break; if (sp > XB_SPIN_CAP) { if (lane == 0) atomicAdd(&bar[XB_TMO], 1u); break; } }
                }
            }
            __builtin_amdgcn_fence(__ATOMIC_RELEASE, "agent");
            asm volatile("s_waitcnt vmcnt(0)" ::: "memory");
            if (lane < 16u && ((mask >> lane) & 1u)) xb_st(&bar[XB_XGEN(lane) + b.x], gen);
        }
        { unsigned sp = 0u;
          for (;;) {
              const unsigned v = (lane < 16u && ((mask >> lane) & 1u)) ? xb_ld(&bar[XB_XGEN(b.x) + lane]) : gen;
              if (__builtin_amdgcn_ballot_w64((int)(v - gen) < 0) == 0ull) break;
              __builtin_amdgcn_s_sleep(1);
              if ((++sp & 255u) == 0u) { if (xb_ld(&bar[XB_TMO])) break; if (sp > XB_SPIN_CAP) { if (lane == 0) atomicAdd(&bar[XB_TMO], 1u); break; } }
          } }
        asm volatile("s_waitcnt vmcnt(0)" ::: "memory");
        __builtin_amdgcn_fence(__ATOMIC_ACQUIRE, "workgroup");
    }
    __syncthreads();
}

__global__ void __launch_bounds__(NTHREADS, 2) mk_fwd(Args args) {
    extern __shared__ __attribute__((aligned(16))) unsigned char lds_raw[];
    LAS unsigned char* lds = (LAS unsigned char*)lds_raw;
    LAS int* ctl = (LAS int*)(lds + CTL_OFF);
    const int tid = threadIdx.x, lane = tid & 63, wave = __builtin_amdgcn_readfirstlane(tid >> 6);
    const int G = gridDim.x;
    const int gw = blockIdx.x * NWAVES + wave, NGW = G * NWAVES;
    unsigned char* ws = args.ws;
    const int lo = args.ph_lo, hi = args.ph_hi;
    if (tid < 16) ((LAS unsigned*)(lds + CTL_OFF + 4096))[tid] = 0u;
    __syncthreads();
    XcdBarrier xbar; xbar.bar = (unsigned*)(ws + WS_CTL + 4096); xbar.x = 0; xbar.rank = 0; xbar.st = (volatile LAS unsigned*)(lds + CTL_OFF + 4096);
    if (blockIdx.x == 0) {
        for (int i = tid; i < XCD_BAR_WORDS; i += NTHREADS) ((unsigned*)(ws + WS_CTL + 4096))[i] = 0u;
        asm volatile("s_waitcnt vmcnt(0)" ::: "memory");
        __syncthreads();
        if (tid == 0) { __builtin_amdgcn_fence(__ATOMIC_RELEASE, "agent"); asm volatile("s_waitcnt vmcnt(0)" ::: "memory"); xb_st(&xbar.bar[XB_INIT], XB_INIT_TOKEN); }
    }
#ifndef PH_MASK
#define PH_MASK 0x7ffff
#endif
#define PH_ON(k) ((PH_MASK >> (k)) & 1)
#define IN(k) (PH_ON(k) && lo <= (k) && (k) < hi)
#ifndef REP_MASK
#define REP_MASK 0
#endif
#define PHASE(k, ...) if (IN(k)) { __VA_ARGS__ if ((REP_MASK >> (k)) & 1) { __syncthreads(); __VA_ARGS__ } }
#ifndef XB_REP
#define XB_REP 1
#endif
#ifndef CG_SEAM_MASK
#define CG_SEAM_MASK 0x0
#endif
#define SEAM(k) do { if (lo <= (k) && (k) + 1 < hi) { if ((CG_SEAM_MASK >> (k)) & 1) cg::this_grid().sync(); else { for (int _s = 0; _s < XB_REP; ++_s) xcd_barrier(xbar); } } } while (0)
#define RUN_GEMM(KK, LDA, LDB) do { __syncthreads(); pg8::gemm_phase<false>(lds, ctl, (KK), (LDA), (LDB), G, (int)blockIdx.x); } while (0)
#define RUN_GEMM8(KK, LDA, LDB, SW, SA) do { __syncthreads(); pg8::gemm_phase<true>(lds, ctl, (KK) / 2, (LDA) / 2, (LDB) / 2, G, (int)blockIdx.x, (SW), (SA)); } while (0)
    PHASE(0,  phase0<0>(args, lds, tid, lane, wave, G); )
    if (lo <= 0 && 1 < hi) {
        if (tid == 0) { unsigned sp_ = 0u; while (xb_ld(&xbar.bar[XB_INIT]) != XB_INIT_TOKEN) { __builtin_amdgcn_s_sleep(1); if (++sp_ > (1u << 26)) break; } }
        __syncthreads();
        xbar = xcd_barrier_post((unsigned*)(ws + WS_CTL + 4096), (volatile LAS unsigned*)(lds + CTL_OFF + 4096));
    }
    PHASE(0,  phase0<1>(args, lds, tid, lane, wave, G); )
    if (lo <= 0 && 1 < hi) {
        xcd_barrier(xbar);
        if (blockIdx.x == 0 && tid == 0) xb_st(&xbar.bar[XB_INIT], 0u);
    }
    PHASE(1,  phase_mix(args, gw, NGW, lane); ) SEAM(1);
    PHASE(2,
        if (tid == 0) {
            const bf16_t* XN = (const bf16_t*)(ws + WS_XN);
            pg8::set_job(ctl, 0, XN + (size_t)0 * MT * D, ws + WS_WR, ws + WS_R, M / 256, 4, pg8::EPI_BF16_HM, D, 0);
            pg8::set_job(ctl, 1, XN + (size_t)2 * MT * D, ws + WS_WK, ws + WS_KRAW, MT / 256, 4, pg8::EPI_BF16_HM, D, 0);
            pg8::set_job(ctl, 2, XN + (size_t)3 * MT * D, ws + WS_WV, ws + WS_V, MT / 256, 4, pg8::EPI_BF16_HM, D, 0);
            pg8::set_job(ctl, 3, XN + (size_t)5 * MT * D, ws + WS_WG1, ws + WS_L1G, M / 256, 1, pg8::EPI_BF16, 256, 2);
        }
        RUN_GEMM(D, D, D);
        __syncthreads();
        if (tid == 0) { const bf16_t* XN = (const bf16_t*)(ws + WS_XN); ctl[0] = 0; ctl[1] = 0;
            pg8::set_job(ctl, 0, XN + (size_t)1 * MT * D, ws + WS_WW1, ws + WS_L1W, MT / 256, 1, pg8::EPI_BF16, 256, 1 | 4);
            pg8::set_job(ctl, 1, XN + (size_t)4 * MT * D, ws + WS_WA1, ws + WS_L1A, MT / 256, 1, pg8::EPI_BF16, 256, 0 | 4); }
        __syncthreads();
        if ((int)blockIdx.x >= G / 2) pg8::gemm_phase<true, true>(lds, ctl, D / 2, D / 2, D / 2, G - G / 2, (int)blockIdx.x - G / 2, 127 - 5, 127);
    ) SEAM(2);
    PHASE(4,  phase_scan_chunked(args, lds, tid, lane, wave, G); ) SEAM(4);
    PHASE(5,  phase_readout(args, gw, NGW, lane); ) SEAM(5);
    PHASE(6,  if (tid == 0) pg8::set_job(ctl, 0, ws + WS_OG, ws + WS_WOUT, ws + WS_Y0, M / 256, 4, pg8::EPI_BF16, D, 0); RUN_GEMM(D, D, D); ) SEAM(6);
    PHASE(7,  phase_rowpass<0>(args, lds, tid, lane, wave, G); ) SEAM(7);
    PHASE(8,  if (tid == 0) pg8::set_job(ctl, 0, ws + WS_HB, ws + WS_WGU, ws + WS_ACT, M / 256, 2 * FF / 256, pg8::EPI_SWIGLU8, FF, 0); RUN_GEMM8(D, D, D, 127 - 5, 127); ) SEAM(8);
    PHASE(9,  if (tid == 0) pg8::set_job(ctl, 0, ws + WS_ACT, ws + WS_WDN, ws + WS_Y0, M / 256, 4, pg8::EPI_BF16, D, 0); RUN_GEMM8(FF, FF, FF, 127 - 6, 127 - 2); ) SEAM(9);
    PHASE(10,  phase_rowpass<1>(args, lds, tid, lane, wave, G); ) SEAM(10);
    PHASE(11,
        if (tid == 0) {
            pg8::set_job(ctl, 0, ws + WS_HB, ws + WS_WCI, ws + WS_BG, M / 256, 4, pg8::EPI_BF16, D, 0);
            pg8::set_job(ctl, 1, ws + WS_HB, ws + WS_WCI + (size_t)D * D * 2, ws + WS_Z, M / 256, 8, pg8::EPI_MUL, D, 0);
        }
        RUN_GEMM(D, D, D);
    ) SEAM(11);
    PHASE(12,  phase_conv(args, tid, G); ) SEAM(12);
    PHASE(13,  if (tid == 0) pg8::set_job(ctl, 0, ws + WS_CV, ws + WS_WCO, ws + WS_Y0, M / 256, 4, pg8::EPI_BF16, D, 0); RUN_GEMM(D, D, D); ) SEAM(13);
    PHASE(14,  phase_rowpass<2>(args, lds, tid, lane, wave, G); ) SEAM(14);
    PHASE(16,
        if (tid == 0) { const int* CNT = (const int*)(ws + WS_CTL); int ps = 0, j = 0; ctl[0] = 0; ctl[1] = 0;
            for (int e = 0; e < NE; ++e) { const int nM = (CNT[e] + 255) >> 8;
                if (nM > 0) { pg8::set_job(ctl, j, ws + WS_XS + (size_t)e * M * D, ws + WS_MGU + (size_t)e * 2 * FF * D, ws + WS_MACT + (size_t)ps * FF, nM, 2 * FF / 256, pg8::EPI_SWIGLU8, FF, 0); ++j; }
                ps += nM * 256; } }
        RUN_GEMM8(D, D, D, 127 - 5, 127);
    ) SEAM(16);
    PHASE(17,
        const int splrow = moe_split_row((const int*)(ws + WS_CTL));
        if (tid == 0) { const int* CNT = (const int*)(ws + WS_CTL); int ps = 0, j = 0; ctl[0] = 0; ctl[1] = 0;
            for (int e = 0; e < NE; ++e) { const int nM = (CNT[e] + 255) >> 8;
                int nfull = (splrow - ps) >> 8; nfull = nfull < 0 ? 0 : (nfull > nM ? nM : nfull);
                if (nfull > 0) { pg8::set_job(ctl, j, ws + WS_MACT + (size_t)ps * FF, ws + WS_MDN + (size_t)e * D * FF, ws + WS_YS + (size_t)ps * D * 2, nfull, 4, pg8::EPI_BF16, D, 0); ++j; }
                ps += nM * 256; } }
        RUN_GEMM8(FF, FF, FF, 127 - 6, 127 - 2);
        __syncthreads();
        if (tid == 0) { const int* CNT = (const int*)(ws + WS_CTL); int ps = 0, j = 0; ctl[0] = 0; ctl[1] = 0;
            for (int e = 0; e < NE; ++e) { const int nM = (CNT[e] + 255) >> 8;
                int nfull = (splrow - ps) >> 8; nfull = nfull < 0 ? 0 : (nfull > nM ? nM : nfull);
                const int nsp = nM - nfull, r0s = ps + nfull * 256;
                if (nsp > 0 && j + SPL_K <= 14) { for (int sl = 0; sl < SPL_K; ++sl) { pg8::set_job(ctl, j, ws + WS_MACT + (size_t)r0s * FF + sl * 512, ws + WS_MDN + (size_t)e * D * FF + sl * 512,
                                                     ws + WS_YSP + ((size_t)sl * SPL_ROWS + (r0s - splrow)) * D * 2, nsp, 4, pg8::EPI_BF16, D, 0); ++j; } }
                ps += nM * 256; } }
        __syncthreads();
        pg8::gemm_phase<true>(lds, ctl, 256, FF / 2, FF / 2, G, (int)blockIdx.x, 127 - 6, 127 - 2);
    ) SEAM(17);
    PHASE(18,  phase_rowpass<3>(args, lds, tid, lane, wave, G); )
}

extern "C" void kernel_launch(void* const* d_in, const int* in_sizes, int n_in, void* d_out, int out_size, void* d_ws, size_t ws_size, hipStream_t stream) {
    static int grid = 0;
    if (grid == 0) {
        int dev = 0, cus = 0, per_cu = 0;
        if (n_in != 31 || ws_size < WS_END) { fprintf(stderr, "kernel_launch: unexpected n_in %d or ws_size %zu (< %zu)\n", n_in, ws_size, (size_t)WS_END); grid = -1; return; }
        hipGetDevice(&dev);
        hipDeviceGetAttribute(&cus, hipDeviceAttributeMultiprocessorCount, dev);
        if (hipFuncSetAttribute((const void*)mk_fwd, hipFuncAttributeMaxDynamicSharedMemorySize, LDS_BYTES) != hipSuccess) { fprintf(stderr, "kernel_launch: hipFuncSetAttribute failed\n"); grid = -1; return; }
        if (hipOccupancyMaxActiveBlocksPerMultiprocessor(&per_cu, (const void*)mk_fwd, NTHREADS, LDS_BYTES) != hipSuccess || per_cu < 1) { fprintf(stderr, "kernel_launch: occupancy query says %d\n", per_cu); per_cu = 1; }
        (void)hipGetLastError();
        grid = cus;
        fprintf(stderr, "kernel_launch: cus %d per_cu %d grid %d ws %zu\n", cus, per_cu, grid, ws_size);
    }
    if (grid < 0) return;
    Args a{};
    for (int i = 0; i < 31; ++i) a.in[i] = (const float*)d_in[i];
    a.out = (float*)d_out; a.ws = (unsigned char*)d_ws;
#if MK_ONE_LAUNCH
    a.ph_lo = 0; a.ph_hi = NPH;
    void* kargs[] = {&a};
    hipError_t e = hipLaunchCooperativeKernel((const void*)mk_fwd, dim3(grid), dim3(NTHREADS), kargs, LDS_BYTES, stream);
    if (e != hipSuccess) fprintf(stderr, "cooperative launch failed: %s (grid %d)\n", hipGetErrorString(e), grid);
#else
    for (int p = 0; p < NPH; ++p) {
        a.ph_lo = p; a.ph_hi = p + 1;
        hipLaunchKernelGGL(mk_fwd, dim3(grid), dim3(NTHREADS), LDS_BYTES, stream, a);
    }
#endif
}
```
